# Optimizing an MI355X kernel written in HIP

```python
import math
import jax, jax.numpy as jnp
from jax import lax
import numpy as np

D_MODEL = 1024
BATCH = 8
SEQ = 8192
DEPTH = 4

CHUNK = 64
Q_BLOCK = 128
RET_HEADS = 4
RET_QK_DIM = 128
RET_V_DIM = 256
DIFF_HEADS = 8
DIFF_HEAD_DIM = 64
DIFF_V_DIM = 2 * DIFF_HEAD_DIM
D_FF = 2816
N_SUB = 3
NORM_EPS = 1e-6

RET_QK = RET_HEADS * RET_QK_DIM
RET_V = RET_HEADS * RET_V_DIM
DIFF_QK = DIFF_HEADS * 2 * DIFF_HEAD_DIM
DIFF_V = DIFF_HEADS * DIFF_V_DIM
SPLITS = (RET_QK, RET_QK, RET_V, RET_V, DIFF_QK, DIFF_QK, DIFF_V, D_MODEL, D_MODEL)
IN_WIDTH = sum(SPLITS)
SPLIT_IDX = [int(i) for i in np.cumsum(SPLITS)[:-1]]

kernel_name = "hybrid_retention_diffattn_macaron_adaln"


def rmsnorm(x, w):
    xf = x.astype(jnp.float32)
    y = xf * lax.rsqrt(jnp.mean(xf * xf, axis=-1, keepdims=True) + NORM_EPS)
    return (y * w.astype(jnp.float32)).astype(x.dtype)


def modulate(h, shift, scale):
    return h * (1 + scale[:, None, :]) + shift[:, None, :]


def swiglu(h, w_up, w_down):
    a, b = jnp.split(h @ w_up, 2, axis=-1)
    return (jax.nn.silu(a) * b) @ w_down


def retention(q, k, v):
    B, S, H, dk = q.shape
    dv = v.shape[-1]
    n_chunks = S // CHUNK
    f32 = jnp.float32
    gamma = 1.0 - 2.0 ** (-5.0 - jnp.arange(H, dtype=f32))
    log_g = jnp.log(gamma)
    r = jnp.arange(CHUNK, dtype=f32)
    intra = jnp.exp(log_g[:, None, None] * jnp.abs(r[:, None] - r[None, :]))
    q_dec = jnp.exp(log_g[:, None] * r[None, :])
    k_dec = jnp.exp(log_g[:, None] * (CHUNK - r)[None, :])
    chunk_dec = jnp.exp(log_g * CHUNK)

    def to_chunks(t):
        return t.astype(f32).reshape(B, n_chunks, CHUNK, H, t.shape[-1]).transpose(1, 0, 3, 2, 4)

    qc, kc, vc = to_chunks(q), to_chunks(k) * (dk ** -0.5), to_chunks(v)

    def step(state, inp):
        qi, ki, vi = inp
        scores = jnp.einsum('bhqd,bhkd->bhqk', qi, ki) * intra
        y = jnp.einsum('bhqk,bhkv->bhqv', scores, vi)
        y = y + jnp.einsum('bhqd,bhdv->bhqv', qi * q_dec[:, :, None], state)
        state = state * chunk_dec[:, None, None] + jnp.einsum('bhkd,bhkv->bhdv', ki * k_dec[:, :, None], vi)
        return state, y

    state0 = jnp.zeros((B, H, dk, dv), f32)
    _, y = lax.scan(step, state0, (qc, kc, vc))
    return y.transpose(1, 0, 3, 2, 4).reshape(B, S, H, dv)


def alibi_slopes(n_heads):
    return 2.0 ** (-8.0 * jnp.arange(1, n_heads + 1, dtype=jnp.float32) / n_heads)


def diff_attention(q, k, v, lam):
    B, S, H, _, d = q.shape
    nb = S // Q_BLOCK
    f32 = jnp.float32
    qb = q.reshape(B, nb, Q_BLOCK, H, 2, d).transpose(1, 0, 3, 4, 2, 5)
    kt = k.transpose(0, 2, 3, 1, 4)
    vt = v.transpose(0, 2, 1, 3)
    slopes = alibi_slopes(H)
    key_pos = jnp.arange(S)
    scale = d ** -0.5

    def block(inp):
        qi, bi = inp
        q_pos = bi * Q_BLOCK + jnp.arange(Q_BLOCK)
        allowed = (key_pos[None, :] // CHUNK) <= (q_pos[:, None] // CHUNK)
        dist = jnp.abs(q_pos[:, None] - key_pos[None, :]).astype(f32)
        bias = jnp.where(allowed[None], -slopes[:, None, None] * dist[None], -jnp.inf)
        s = jnp.einsum('bhiqd,bhikd->bhiqk', qi, kt).astype(f32) * scale + bias[None, :, None]
        p = jax.nn.softmax(s, axis=-1)
        a = p[:, :, 0] - lam * p[:, :, 1]
        return jnp.einsum('bhqk,bhkv->bhqv', a.astype(vt.dtype), vt)

    out = lax.map(block, (qb, jnp.arange(nb)))
    return out.transpose(1, 0, 3, 2, 4).reshape(B, S, H, 2 * d)


def hybrid_mixer(h, w_in, ret_gn, lam_q1, lam_k1, lam_q2, lam_k2, subln, w_ret_branch, w_diff_branch, w_out, layer_idx):
    B, S, _ = h.shape
    f32 = jnp.float32
    proj = h @ w_in
    rq, rk, rv, rg, dq, dk, dv, g_ret, g_diff = jnp.split(proj, SPLIT_IDX, axis=-1)

    y_ret = retention(rq.reshape(B, S, RET_HEADS, RET_QK_DIM),
                      rk.reshape(B, S, RET_HEADS, RET_QK_DIM),
                      rv.reshape(B, S, RET_HEADS, RET_V_DIM))
    y_ret = rmsnorm(y_ret, ret_gn.reshape(RET_HEADS, RET_V_DIM)).reshape(B, S, RET_V).astype(h.dtype)
    y_ret = y_ret * jax.nn.silu(rg)

    lam_init = 0.8 - 0.6 * math.exp(-0.3 * layer_idx)
    lam = (jnp.exp(jnp.sum(lam_q1.astype(f32) * lam_k1.astype(f32)))
           - jnp.exp(jnp.sum(lam_q2.astype(f32) * lam_k2.astype(f32))) + lam_init)
    y_diff = diff_attention(dq.reshape(B, S, DIFF_HEADS, 2, DIFF_HEAD_DIM),
                            dk.reshape(B, S, DIFF_HEADS, 2, DIFF_HEAD_DIM),
                            dv.reshape(B, S, DIFF_HEADS, DIFF_V_DIM), lam)
    y_diff = (rmsnorm(y_diff, subln) * (1.0 - lam_init)).reshape(B, S, DIFF_V)

    merged = (jax.nn.sigmoid(g_ret) * (y_ret @ w_ret_branch)
              + jax.nn.sigmoid(g_diff) * (y_diff @ w_diff_branch))
    return merged @ w_out


def setup_inputs(seed: int = 0) -> dict:
    key = jax.random.key(seed)
    ks = jax.random.split(key, 20)
    nrm = jax.random.normal
    f32 = jnp.float32
    return {
        "x": nrm(ks[0], (BATCH, SEQ, D_MODEL), f32),
        "c": nrm(ks[1], (BATCH, D_MODEL), f32),
        "w_ada": nrm(ks[2], (DEPTH, D_MODEL, N_SUB * 3 * D_MODEL), f32) * (0.5 * D_MODEL ** -0.5),
        "b_ada": nrm(ks[3], (DEPTH, N_SUB * 3 * D_MODEL), f32) * 0.02,
        "norm_w": 1.0 + 0.02 * nrm(ks[4], (DEPTH, N_SUB, D_MODEL), f32),
        "w_ffn_up": nrm(ks[5], (DEPTH, 2, D_MODEL, 2 * D_FF), f32) * D_MODEL ** -0.5,
        "w_ffn_down": nrm(ks[6], (DEPTH, 2, D_FF, D_MODEL), f32) * D_FF ** -0.5,
        "w_in": nrm(ks[7], (DEPTH, D_MODEL, IN_WIDTH), f32) * D_MODEL ** -0.5,
        "ret_gn": 1.0 + 0.02 * nrm(ks[8], (DEPTH, RET_V), f32),
        "lambda_q1": 0.1 * nrm(ks[9], (DEPTH, DIFF_HEAD_DIM), f32),
        "lambda_k1": 0.1 * nrm(ks[10], (DEPTH, DIFF_HEAD_DIM), f32),
        "lambda_q2": 0.1 * nrm(ks[11], (DEPTH, DIFF_HEAD_DIM), f32),
        "lambda_k2": 0.1 * nrm(ks[12], (DEPTH, DIFF_HEAD_DIM), f32),
        "diff_subln": 1.0 + 0.02 * nrm(ks[13], (DEPTH, DIFF_V_DIM), f32),
        "w_ret_branch": nrm(ks[14], (DEPTH, RET_V, D_MODEL), f32) * RET_V ** -0.5,
        "w_diff_branch": nrm(ks[15], (DEPTH, DIFF_V, D_MODEL), f32) * DIFF_V ** -0.5,
        "w_out": nrm(ks[16], (DEPTH, D_MODEL, D_MODEL), f32) * D_MODEL ** -0.5,
        "final_norm": 1.0 + 0.02 * nrm(ks[17], (D_MODEL,), f32),
    }


def reference(x, c, w_ada, b_ada, norm_w, w_ffn_up, w_ffn_down, w_in, ret_gn, lambda_q1, lambda_k1, lambda_q2, lambda_k2, diff_subln, w_ret_branch, w_diff_branch, w_out, final_norm):
    B = x.shape[0]
    cond = jax.nn.silu(c)
    for l in range(DEPTH):
        mod = (cond @ w_ada[l] + b_ada[l]).reshape(B, N_SUB, 3, D_MODEL)
        shift, scale, gate = mod[:, :, 0], mod[:, :, 1], mod[:, :, 2]
        h = modulate(rmsnorm(x, norm_w[l, 0]), shift[:, 0], scale[:, 0])
        x = x + 0.5 * gate[:, 0, None, :] * swiglu(h, w_ffn_up[l, 0], w_ffn_down[l, 0])
        h = modulate(rmsnorm(x, norm_w[l, 1]), shift[:, 1], scale[:, 1])
        x = x + gate[:, 1, None, :] * hybrid_mixer(h, w_in[l], ret_gn[l], lambda_q1[l], lambda_k1[l],
                                                    lambda_q2[l], lambda_k2[l], diff_subln[l],
                                                    w_ret_branch[l], w_diff_branch[l], w_out[l], l)
        h = modulate(rmsnorm(x, norm_w[l, 2]), shift[:, 2], scale[:, 2])
        x = x + 0.5 * gate[:, 2, None, :] * swiglu(h, w_ffn_up[l, 1], w_ffn_down[l, 1])
    return rmsnorm(x, final_norm)
```

```cpp
#define GATE_LOGITS 1
#include <hip/hip_runtime.h>
#include <hip/hip_cooperative_groups.h>
#include <cstdio>
#include <cstdint>
namespace cg = cooperative_groups;
#define USE_RSB 1
__device__ __forceinline__ int hw_lane() { int l = (int)__builtin_amdgcn_mbcnt_hi(~0u, __builtin_amdgcn_mbcnt_lo(~0u, 0u)); asm volatile("" : "+v"(l)); return l; }
namespace pg8 {
#define PG8_LAS __attribute__((address_space(3)))
typedef unsigned short bf16_t;
typedef short bf16x8 __attribute__((ext_vector_type(8)));
typedef float f32x4 __attribute__((ext_vector_type(4)));
typedef unsigned u32x4 __attribute__((ext_vector_type(4)));
constexpr int BM = 256, BK = 64, HALF = 128, HTB = HALF * BK * 2  , STAGE_BYTES = 8 * HTB, NXCD = 8, WGM = 8;

__host__ __device__ __forceinline__ int lds_byte(int r, int c) { const int st = (r >> 4) * 2 + (c >> 5), rr = r & 15, cc = c & 31, ob = rr * 64 + cc * 2; return st * 1024 + (ob ^ (((ob >> 9) & 1) << 5)); }
__host__ __device__ __forceinline__ void stage_rc(int b, int& R, int& C) { const int st = b / 1024, sb = b % 1024, swz = sb ^ (((sb >> 9) & 1) << 5); R = (st >> 1) * 16 + swz / 64; C = (st & 1) * 32 + (swz % 64) / 2; }
__host__ __device__ __forceinline__ int perm32(int rho) { const int n = rho >> 4, i = rho & 15; return 8 * (i >> 2) + 4 * n + (i & 3); }

struct Unit { int pm, pn; };
struct Gemm { const bf16_t* A; const bf16_t* Bt; int M, N, K; };

struct StaticOrder {
    int nM, nN, nwg, G, c;
    __host__ __device__ void init(int M, int N, int G_, int c_) { nM = M / BM; nN = N / BM; nwg = nM * nN; G = G_; c = c_; }
    __host__ __device__ bool next(int i, Unit& u) const {
        const long L = (long)i * G + c; if (L >= nwg) return false;
        int wgid = (int)L; { const int q = nwg / NXCD, r = nwg % NXCD, xcd = wgid % NXCD, off = wgid / NXCD; wgid = (xcd < r ? xcd * (q + 1) : r * (q + 1) + (xcd - r) * q) + off; }
        const int nig = WGM * nN, gid = wgid / nig, fm = gid * WGM, gsz = (nM - fm) < WGM ? (nM - fm) : WGM;
        u.pm = fm + ((wgid % nig) % gsz); u.pn = (wgid % nig) / gsz; return true;
    }
    __device__ __forceinline__ void a_ready(const Unit&) const {}
    __device__ __forceinline__ void done(const Unit&) const {}
};

__device__ __forceinline__ unsigned cvt_pk_bf16(float lo, float hi) { unsigned r; asm volatile("v_cvt_pk_bf16_f32 %0, %1, %2" : "=v"(r) : "v"(lo), "v"(hi)); return r; }
typedef float f32x2 __attribute__((ext_vector_type(2)));

__device__ __forceinline__ float sigmoid_f(float v) { return __builtin_amdgcn_rcpf(1.0f + __builtin_amdgcn_exp2f(-1.4426950408889634f * v)); }
__device__ __forceinline__ float bf_lo(unsigned w) { return __uint_as_float(w << 16); }
__device__ __forceinline__ float bf_hi(unsigned w) { return __uint_as_float(w & 0xffff0000u); }

struct EpiSwiGLU {
    static constexpr bool PERM = true, AFTER_DRAIN = false;
    bf16_t* O; int ldc;
    __device__ __forceinline__ void operator()(const f32x4 (&acc)[2][2][4][2], const Unit& u, int wr, int wc, int fr, int fq) const {
        const int row0 = u.pm * BM + wr * 64 + fr, col0 = u.pn * HALF + wc * 32 + 8 * fq;
#pragma unroll
        for (int ai = 0; ai < 2; ++ai)
#pragma unroll
            for (int m = 0; m < 4; ++m) {
                bf16_t* rowp = O + (size_t)(row0 + ai * HALF + m * 16) * ldc + col0;
                float v[8];
#pragma unroll
                for (int n = 0; n < 2; ++n)
#pragma unroll
                    for (int e = 0; e < 4; ++e) { const float a = acc[ai][0][m][n][e], b = acc[ai][1][m][n][e]; v[4 * n + e] = a * sigmoid_f(a) * b; }
                u32x4 w; w.x = cvt_pk_bf16(v[0], v[1]); w.y = cvt_pk_bf16(v[2], v[3]); w.z = cvt_pk_bf16(v[4], v[5]); w.w = cvt_pk_bf16(v[6], v[7]);
                *(u32x4*)rowp = w;
            }
    }
};
struct EpiResid {
    static constexpr bool PERM = false, AFTER_DRAIN = false;
    const float* base; float* out; const float* gate; int gate_bstride; float coef; int ldc;
    __device__ __forceinline__ void operator()(const f32x4 (&acc)[2][2][4][2], const Unit& u, int wr, int wc, int fr, int fq) const {
        const int col0 = u.pn * BM + wc * 32 + 4 * fq;
        const float* g = gate + (size_t)(u.pm >> 5) * gate_bstride;
        f32x4 gv[2][2];
#pragma unroll
        for (int bj = 0; bj < 2; ++bj)
#pragma unroll
            for (int n = 0; n < 2; ++n) gv[bj][n] = *(const f32x4*)(g + col0 + bj * HALF + n * 16) * coef;
#pragma unroll
        for (int ai = 0; ai < 2; ++ai)
#pragma unroll
            for (int m = 0; m < 4; ++m) { const size_t off = (size_t)(u.pm * BM + ai * HALF + wr * 64 + m * 16 + fr) * ldc + col0;
#pragma unroll
                for (int bj = 0; bj < 2; ++bj)
#pragma unroll
                    for (int n = 0; n < 2; ++n) { const f32x4 bs = *(const f32x4*)(base + off + bj * HALF + n * 16); *(f32x4*)(out + off + bj * HALF + n * 16) = bs + gv[bj][n] * acc[ai][bj][m][n]; } }
    }
};
#ifdef GATE_LOGITS
#define GSIG(x) sigmoid_f(x)
#else
#define GSIG(x) (x)
#endif
template <int MODE> struct EpiBf {
    static constexpr bool PERM = true, AFTER_DRAIN = false;
    bf16_t* O; int ldc; int split_cols; size_t split_stride; int qt; float qscale; const bf16_t* G;
    __device__ __forceinline__ void operator()(const f32x4 (&acc)[2][2][4][2], const Unit& u, int wr, int wc, int fr, int fq) const {
        const int row0 = u.pm * BM + wr * 64 + fr; int colt = u.pn * BM; bf16_t* base = O; float sc = 1.f;
        if (MODE <= 1) { const int t = colt / split_cols; base += (size_t)t * split_stride; colt -= t * split_cols; if (MODE == 0 && t == qt) sc = qscale; }
        const int col0 = colt + wc * 32 + 8 * fq;
#pragma unroll
        for (int ai = 0; ai < 2; ++ai)
#pragma unroll
            for (int m = 0; m < 4; ++m) { const size_t roff = (size_t)(row0 + ai * HALF + m * 16) * ldc + col0;
#pragma unroll
                for (int bj = 0; bj < 2; ++bj) {
                    f32x4 v0 = acc[ai][bj][m][0], v1 = acc[ai][bj][m][1];
                    if (MODE == 0) { v0 = v0 * sc; v1 = v1 * sc; }
                    if (MODE == 1) {
#pragma unroll
                        for (int e = 0; e < 4; ++e) { v0[e] = sigmoid_f(v0[e]); v1[e] = sigmoid_f(v1[e]); } }
                    if (MODE >= 2) { const u32x4 g = *(const u32x4*)(G + roff + bj * HALF);
                        v0[0] *= GSIG(bf_lo(g.x)); v0[1] *= GSIG(bf_hi(g.x)); v0[2] *= GSIG(bf_lo(g.y)); v0[3] *= GSIG(bf_hi(g.y)); v1[0] *= GSIG(bf_lo(g.z)); v1[1] *= GSIG(bf_hi(g.z)); v1[2] *= GSIG(bf_lo(g.w)); v1[3] *= GSIG(bf_hi(g.w)); }
                    if (MODE == 3) { const u32x4 t = *(const u32x4*)(base + roff + bj * HALF);
                        v0[0] += bf_lo(t.x); v0[1] += bf_hi(t.x); v0[2] += bf_lo(t.y); v0[3] += bf_hi(t.y); v1[0] += bf_lo(t.z); v1[1] += bf_hi(t.z); v1[2] += bf_lo(t.w); v1[3] += bf_hi(t.w); }
                    u32x4 w; w.x = cvt_pk_bf16(v0[0], v0[1]); w.y = cvt_pk_bf16(v0[2], v0[3]); w.z = cvt_pk_bf16(v1[0], v1[1]); w.w = cvt_pk_bf16(v1[2], v1[3]);
                    *(u32x4*)(base + roff + bj * HALF) = w; } }
    }
};

template <class Epi, class Sched, bool ALIGN_EPI = false, bool SP2 = false>
__device__ __forceinline__ void gemm_phase(PG8_LAS unsigned char* lds, const Gemm g, const Sched& S, const Epi& E, const int wave_s) {
    const int lane = hw_lane(), wid = wave_s, tid = wave_s * 64 + lane, wr = wid >> 2, wc = wid & 3, fr = lane & 15, fq = lane >> 4;
    const int K = g.K, nt = K / BK;
    unsigned voffA[2], voffB[2];
#pragma unroll
    for (int i = 0; i < 2; ++i) { int R, C; stage_rc(tid * 16 + i * 8192, R, C); const int Rb = Epi::PERM ? ((R & ~31) + perm32(R & 31)) : R;
        voffA[i] = (unsigned)(R * K + C) * 2u; voffB[i] = (unsigned)(Rb * K + C) * 2u; }
    const size_t kstep = (size_t)(BK * 2);
    const size_t hstep = (size_t)HALF * K * 2;
    const size_t tstep = 2 * hstep;
    const unsigned ldsw = (unsigned)wid * 1024u;
    const int aoff = lds_byte(wr * 64 + fr, fq * 8), boff = lds_byte(wc * 32 + fr, fq * 8);
#define PG8_SA(b, h) (((b) * 2 + (h)) * HTB)
#define PG8_SB(b, h) ((4 + (b) * 2 + (h)) * HTB)
#define PG8_STAGE(bufoff, gbase, voff) do { _Pragma("unroll") for (int _i = 0; _i < 2; ++_i) \
        __builtin_amdgcn_global_load_lds((const unsigned*)((const char*)(gbase) + (voff)[_i]), (PG8_LAS unsigned*)(lds + (bufoff) + ldsw + _i * 8192), 16, 0, 0); } while (0)
#define PG8_LDA(dst, b, h) do { _Pragma("unroll") for (int m = 0; m < 4; ++m) _Pragma("unroll") for (int k = 0; k < 2; ++k) dst[m][k] = *(const PG8_LAS bf16x8*)(lds + PG8_SA(b, h) + aoff + m * 2048 + k * 1024); } while (0)
#define PG8_LDB(dst, b, h) do { _Pragma("unroll") for (int n = 0; n < 2; ++n) _Pragma("unroll") for (int k = 0; k < 2; ++k) dst[n][k] = *(const PG8_LAS bf16x8*)(lds + PG8_SB(b, h) + boff + n * 2048 + k * 1024); } while (0)
#define PG8_MMA(ai, bj, At, Bt) do { __builtin_amdgcn_s_setprio(1); _Pragma("unroll") for (int m = 0; m < 4; ++m) _Pragma("unroll") for (int n = 0; n < 2; ++n) _Pragma("unroll") for (int k = 0; k < 2; ++k) \
        acc[ai][bj][m][n] = __builtin_amdgcn_mfma_f32_16x16x32_bf16(Bt[n][k], At[m][k], acc[ai][bj][m][n], 0, 0, 0); __builtin_amdgcn_s_setprio(0); } while (0)
#define PG8_WAIT_V(n) asm volatile("s_waitcnt vmcnt(" #n ")" ::: "memory")
#define PG8_WAIT_L(n) asm volatile("s_waitcnt lgkmcnt(" #n ")" ::: "memory")
#define PG8_BAR __builtin_amdgcn_s_barrier()
#define PG8_SCHED __builtin_amdgcn_sched_barrier(0)
    Unit cur, nxt; int ui = 0;
    if (!S.next(0, cur)) return;
    f32x4 acc[2][2][4][2];
#pragma unroll
    for (int a = 0; a < 2; ++a)
#pragma unroll
        for (int b = 0; b < 2; ++b)
#pragma unroll
            for (int m = 0; m < 4; ++m)
#pragma unroll
                for (int n = 0; n < 2; ++n) acc[a][b][m][n] = (f32x4){0.f, 0.f, 0.f, 0.f};
    bf16x8 At[4][2], B0[2][2], B1[2][2];
    const char* cA = (const char*)g.A + (size_t)cur.pm * tstep; const char* cB = (const char*)g.Bt + (size_t)cur.pn * tstep;
    S.a_ready(cur);
    if constexpr (SP2) {
        PG8_STAGE(PG8_SB(0, 0), cB, voffB); PG8_STAGE(PG8_SB(0, 1), cB + hstep, voffB); PG8_STAGE(PG8_SA(0, 0), cA, voffA); PG8_STAGE(PG8_SA(0, 1), cA + hstep, voffA);
        if (wr == 1) PG8_BAR;
        PG8_WAIT_V(2); PG8_BAR;
        PG8_STAGE(PG8_SB(1, 0), cB + kstep, voffB); PG8_STAGE(PG8_SA(1, 0), cA + kstep, voffA); PG8_STAGE(PG8_SB(1, 1), cB + hstep + kstep, voffB);
        PG8_WAIT_V(6); PG8_BAR;
    } else {
        PG8_STAGE(PG8_SB(0, 0), cB, voffB); PG8_STAGE(PG8_SA(0, 0), cA, voffA); PG8_STAGE(PG8_SB(0, 1), cB + hstep, voffB); PG8_STAGE(PG8_SA(0, 1), cA + hstep, voffA);
        if (wr == 1) PG8_BAR;
        PG8_WAIT_V(4); PG8_BAR;
        PG8_STAGE(PG8_SB(1, 0), cB + kstep, voffB); PG8_STAGE(PG8_SA(1, 0), cA + kstep, voffA); PG8_STAGE(PG8_SB(1, 1), cB + hstep + kstep, voffB);
        PG8_WAIT_V(6); PG8_BAR;
    }
    for (;;) {
        const bool has_next = S.next(ui + 1, nxt);
        const char* nA = has_next ? (const char*)g.A + (size_t)nxt.pm * tstep : cA; const char* nB = has_next ? (const char*)g.Bt + (size_t)nxt.pn * tstep : cB;
        for (int t = 0; t < nt; t += 2) {
            const bool last = (t == nt - 2);
            const char* a1 = cA + (size_t)(t + 1) * kstep;
            const char* a2 = last ? nA : cA + (size_t)(t + 2) * kstep; const char* b2 = last ? nB : cB + (size_t)(t + 2) * kstep;
            const char* a3 = a2 + kstep; const char* b3 = b2 + kstep;
            if (last && has_next) S.a_ready(nxt);
            if constexpr (SP2) {
            PG8_LDB(B0, 0, 0); PG8_LDB(B1, 0, 1); PG8_SCHED; PG8_LDA(At, 0, 0); PG8_STAGE(PG8_SA(1, 1), a1 + hstep, voffA);
            PG8_WAIT_V(8); PG8_WAIT_L(0); PG8_BAR; PG8_MMA(0, 0, At, B0); PG8_MMA(0, 1, At, B1); PG8_BAR; PG8_SCHED;
            PG8_LDA(At, 0, 1); PG8_STAGE(PG8_SB(0, 0), b2, voffB); PG8_STAGE(PG8_SB(0, 1), b2 + hstep, voffB); PG8_STAGE(PG8_SA(0, 0), a2, voffA);
            PG8_WAIT_V(8); PG8_WAIT_L(0); PG8_BAR; PG8_MMA(1, 0, At, B0); PG8_MMA(1, 1, At, B1); PG8_BAR; PG8_SCHED;
            PG8_LDB(B0, 1, 0); PG8_LDB(B1, 1, 1); PG8_SCHED; PG8_LDA(At, 1, 0); PG8_STAGE(PG8_SA(0, 1), a2 + hstep, voffA);
            PG8_WAIT_V(8); PG8_WAIT_L(0); PG8_BAR; PG8_MMA(0, 0, At, B0); PG8_MMA(0, 1, At, B1); PG8_BAR; PG8_SCHED;
            PG8_LDA(At, 1, 1); PG8_STAGE(PG8_SB(1, 0), b3, voffB); PG8_STAGE(PG8_SB(1, 1), b3 + hstep, voffB); PG8_STAGE(PG8_SA(1, 0), a3, voffA);
            PG8_WAIT_V(8); PG8_WAIT_L(0); PG8_BAR; PG8_MMA(1, 0, At, B0); PG8_MMA(1, 1, At, B1); PG8_BAR; PG8_SCHED;
            } else {
            PG8_LDB(B0, 0, 0); PG8_SCHED; PG8_LDA(At, 0, 0); PG8_STAGE(PG8_SA(1, 1), a1 + hstep, voffA);
            PG8_WAIT_L(8); PG8_BAR; PG8_WAIT_L(0); PG8_MMA(0, 0, At, B0); PG8_BAR; PG8_SCHED;
            PG8_LDB(B1, 0, 1); PG8_STAGE(PG8_SB(0, 0), b2, voffB);
            PG8_BAR; PG8_WAIT_L(0); PG8_MMA(0, 1, At, B1); PG8_BAR;
            PG8_LDA(At, 0, 1); PG8_STAGE(PG8_SA(0, 0), a2, voffA);
            PG8_BAR; PG8_WAIT_L(0); PG8_MMA(1, 0, At, B0); PG8_BAR; PG8_SCHED;
            PG8_STAGE(PG8_SB(0, 1), b2 + hstep, voffB);
            PG8_WAIT_V(6); PG8_BAR; PG8_MMA(1, 1, At, B1); PG8_BAR;
            PG8_LDB(B0, 1, 0); PG8_SCHED; PG8_LDA(At, 1, 0); PG8_STAGE(PG8_SA(0, 1), a2 + hstep, voffA);
            PG8_WAIT_L(8); PG8_BAR; PG8_WAIT_L(0); PG8_MMA(0, 0, At, B0); PG8_BAR; PG8_SCHED;
            PG8_LDB(B1, 1, 1); PG8_STAGE(PG8_SB(1, 0), b3, voffB);
            PG8_BAR; PG8_WAIT_L(0); PG8_MMA(0, 1, At, B1); PG8_BAR;
            PG8_LDA(At, 1, 1); PG8_STAGE(PG8_SA(1, 0), a3, voffA);
            PG8_BAR; PG8_WAIT_L(0); PG8_MMA(1, 0, At, B0); PG8_BAR; PG8_SCHED;
            PG8_STAGE(PG8_SB(1, 1), b3 + hstep, voffB);
            PG8_WAIT_V(6); PG8_BAR; PG8_MMA(1, 1, At, B1); PG8_BAR;
            }
        }
        if constexpr (ALIGN_EPI) { if (wr == 0) PG8_BAR; }
        if constexpr (!Epi::AFTER_DRAIN) { E(acc, cur, wr, wc, fr, fq); S.done(cur); }
        if (!has_next) break;
#pragma unroll
        for (int a = 0; a < 2; ++a)
#pragma unroll
            for (int b = 0; b < 2; ++b)
#pragma unroll
                for (int m = 0; m < 4; ++m)
#pragma unroll
                    for (int n = 0; n < 2; ++n) acc[a][b][m][n] = (f32x4){0.f, 0.f, 0.f, 0.f};
        cur = nxt; cA = nA; cB = nB; ++ui;
        if constexpr (ALIGN_EPI) { if (wr == 1) PG8_BAR; }
    }
    PG8_WAIT_V(0);
    if constexpr (!ALIGN_EPI) { if (wr == 0) PG8_BAR; }
    PG8_BAR;
    if constexpr (Epi::AFTER_DRAIN) { E.fused(acc, cur, wr, wc, fr, fq, lds, wid, lane); S.done(cur); }
#undef PG8_SA
#undef PG8_SB
#undef PG8_STAGE
#undef PG8_LDA
#undef PG8_LDB
#undef PG8_MMA
#undef PG8_WAIT_V
#undef PG8_WAIT_L
#undef PG8_BAR
#undef PG8_SCHED
}
}

#define LAS __attribute__((address_space(3)))
typedef unsigned short bf16;
typedef float f32x4 __attribute__((ext_vector_type(4)));
typedef float f32x16 __attribute__((ext_vector_type(16)));
typedef short bf16x8 __attribute__((ext_vector_type(8)));
typedef short s16x4 __attribute__((ext_vector_type(4)));
typedef unsigned u32x4 __attribute__((ext_vector_type(4)));
typedef unsigned u32x2 __attribute__((ext_vector_type(2)));

constexpr int DM = 1024, NB = 8, SEQ = 8192, DEPTH = 4, MROWS = NB * SEQ, DFF = 2816, INW = 8192, NMOD = 9 * DM;
constexpr int NWAVES = 8, NTHR = 512;
constexpr float NORM_EPS = 1e-6f, LOG2E = 1.4426950408889634f;
constexpr size_t MiB = 1u << 20;
constexpr size_t WS_CTL = 0;
constexpr size_t WS_MOD = 1 * MiB;
constexpr size_t WS_WT = 4 * MiB;
constexpr size_t W_UPA = 0, W_DNA = W_UPA + (size_t)2 * DFF * DM, W_UPB = W_DNA + (size_t)DM * DFF, W_DNB = W_UPB + (size_t)2 * DFF * DM,
                 W_IN = W_DNB + (size_t)DM * DFF, W_RET = W_IN + (size_t)INW * DM, W_DIF = W_RET + (size_t)DM * DM, W_OUT = W_DIF + (size_t)DM * DM, W_END = W_OUT + (size_t)DM * DM;
constexpr size_t WS_H = 64 * MiB;
constexpr size_t ACT = (size_t)MROWS * DM * 2;
constexpr size_t WS_B0 = 192 * MiB;
constexpr size_t WS_HID = WS_B0;
constexpr size_t WS_END = WS_B0 + 6 * ACT;
static_assert(WS_WT + W_END * 2 <= WS_H && WS_END <= 1024 * MiB, "d_ws map");

struct Args { const float* in[18]; float* out; unsigned char* ws; };

__device__ __forceinline__ float shx(float v, int m, int lane) { return __int_as_float(__builtin_amdgcn_ds_bpermute((lane ^ m) << 2, __float_as_int(v))); }
__device__ __forceinline__ float wave_sum(float v, int lane) {
#pragma unroll
    for (int o = 1; o < 64; o <<= 1) v += shx(v, o, lane);
    return v;
}
__device__ __forceinline__ unsigned f2bf(float f) { unsigned u = __float_as_uint(f); return (u + 0x7fffu + ((u >> 16) & 1u)) >> 16; }
__device__ __forceinline__ unsigned pk2(float lo, float hi) { return pg8::cvt_pk_bf16(lo, hi); }
typedef __bf16 bf16x2_cv __attribute__((ext_vector_type(2))); typedef float f32x2_cv __attribute__((ext_vector_type(2)));
__device__ __forceinline__ unsigned pk2v(float lo, float hi) { f32x2_cv v = {lo, hi}; bf16x2_cv b = __builtin_convertvector(v, bf16x2_cv); return __builtin_bit_cast(unsigned, b); }
__device__ __forceinline__ float bflo(unsigned w) { return __uint_as_float(w << 16); }
__device__ __forceinline__ float bfhi(unsigned w) { return __uint_as_float(w & 0xffff0000u); }
__device__ __forceinline__ float sgpr_f(float v) { return __int_as_float(__builtin_amdgcn_readfirstlane(__float_as_int(v))); }
__device__ __forceinline__ int launder(int v) { asm volatile("" : "+v"(v)); return v; }
#define LDS_WAIT() asm volatile("s_waitcnt lgkmcnt(0)" ::: "memory")
#define LDS_BARRIER() do { asm volatile("s_waitcnt lgkmcnt(0)" ::: "memory"); __builtin_amdgcn_s_barrier(); asm volatile("" ::: "memory"); } while (0)
#define MFMA32(a, b, c) __builtin_amdgcn_mfma_f32_32x32x16_bf16((a), (b), (c), 0, 0, 0)
__device__ __forceinline__ int crow(int r, int hi) { return (r & 3) + 8 * (r >> 2) + 4 * hi; }
typedef short v4i16_t __attribute__((ext_vector_type(4)));
__device__ __forceinline__ s16x4 tr_read(const LAS unsigned char* p) { return __builtin_bit_cast(s16x4, __builtin_amdgcn_ds_read_tr16_b64_v4i16((LAS v4i16_t*)p)); }
__device__ __forceinline__ bf16x8 cat8(s16x4 lo, s16x4 hi) { return (bf16x8){lo[0], lo[1], lo[2], lo[3], hi[0], hi[1], hi[2], hi[3]}; }
__device__ __forceinline__ bf16x8 pack8v(const f32x16& x, int s) {
    u32x4 p; p.x = pk2v(x[8 * s], x[8 * s + 1]); p.y = pk2v(x[8 * s + 2], x[8 * s + 3]); p.z = pk2v(x[8 * s + 4], x[8 * s + 5]); p.w = pk2v(x[8 * s + 6], x[8 * s + 7]);
    return __builtin_bit_cast(bf16x8, p);
}
__device__ __forceinline__ bf16x8 pack8(const f32x16& x, int s) {
    u32x4 p; p.x = pk2(x[8 * s], x[8 * s + 1]); p.y = pk2(x[8 * s + 2], x[8 * s + 3]); p.z = pk2(x[8 * s + 4], x[8 * s + 5]); p.w = pk2(x[8 * s + 6], x[8 * s + 7]);
    return __builtin_bit_cast(bf16x8, p);
}

template <bool UPPERM>
__device__ __forceinline__ void transpose_item(const float* W, int K, int N, bf16* WT, LAS float* scr, int item, int lane) {
    const int nblk = N / 32, kb = item / nblk, nb = item % nblk, k0 = 64 * kb, n0 = 32 * nb;
#pragma unroll 8
    for (int i = 0; i < 32; ++i) { const int kk = 2 * i + (lane >> 5); scr[kk * 33 + (lane & 31)] = W[(size_t)(k0 + kk) * N + n0 + (lane & 31)]; }
    LDS_WAIT(); asm volatile("" ::: "memory");
    int d0 = n0;
    if (UPPERM) { const int half = n0 / DFF, j = n0 % DFF; d0 = (j / 128) * 256 + half * 128 + (j % 128); }
    const int c = lane & 7;
#pragma unroll
    for (int j = 0; j < 4; ++j) { const int n = (lane >> 3) + 8 * j; const LAS float* s = scr + (8 * c) * 33 + n;
        u32x4 o; o.x = pk2(s[0 * 33], s[1 * 33]); o.y = pk2(s[2 * 33], s[3 * 33]); o.z = pk2(s[4 * 33], s[5 * 33]); o.w = pk2(s[6 * 33], s[7 * 33]);
        *(u32x4*)(WT + (size_t)(d0 + n) * K + k0 + 8 * c) = o; }
    LDS_WAIT(); asm volatile("" ::: "memory");
}
__device__ __forceinline__ void convert_weights(const Args& a, int l, LAS unsigned char* lds, int gw, int ngw, int wave, int lane) {
    lane = launder(lane);
    LAS float* scr = (LAS float*)(lds + wave * 16384);
    bf16* WT = (bf16*)(a.ws + WS_WT);
    const float* up = a.in[5] + (size_t)l * 2 * DM * 2 * DFF; const float* dn = a.in[6] + (size_t)l * 2 * DFF * DM;
    const float* win = a.in[7] + (size_t)l * DM * INW; const float* wr = a.in[14] + (size_t)l * DM * DM; const float* wd = a.in[15] + (size_t)l * DM * DM; const float* wo = a.in[16] + (size_t)l * DM * DM;
    constexpr int I_UP = (DM / 64) * (2 * DFF / 32), I_DN = (DFF / 64) * (DM / 32), I_IN = (DM / 64) * (INW / 32), I_SQ = (DM / 64) * (DM / 32);
    constexpr int NITEMS = 2 * I_UP + 2 * I_DN + I_IN + 3 * I_SQ;
    for (int it = gw; it < NITEMS; it += ngw) {
        int r = it;
        if (r < I_UP) { transpose_item<true>(up, DM, 2 * DFF, WT + W_UPA, scr, r, lane); continue; } r -= I_UP;
        if (r < I_UP) { transpose_item<true>(up + (size_t)DM * 2 * DFF, DM, 2 * DFF, WT + W_UPB, scr, r, lane); continue; } r -= I_UP;
        if (r < I_DN) { transpose_item<false>(dn, DFF, DM, WT + W_DNA, scr, r, lane); continue; } r -= I_DN;
        if (r < I_DN) { transpose_item<false>(dn + (size_t)DFF * DM, DFF, DM, WT + W_DNB, scr, r, lane); continue; } r -= I_DN;
        if (r < I_IN) { transpose_item<false>(win, DM, INW, WT + W_IN, scr, r, lane); continue; } r -= I_IN;
        if (r < I_SQ) { transpose_item<false>(wr, DM, DM, WT + W_RET, scr, r, lane); continue; } r -= I_SQ;
        if (r < I_SQ) { transpose_item<false>(wd, DM, DM, WT + W_DIF, scr, r, lane); continue; } r -= I_SQ;
        transpose_item<false>(wo, DM, DM, WT + W_OUT, scr, r, lane);
    }
}
__device__ __forceinline__ void ada_phase(const Args& a, LAS unsigned char* lds, int wave, int lane) {
    lane = launder(lane);
    LAS float* sc = (LAS float*)lds; LAS float* part = (LAS float*)(lds + 32768);
    const float* c = a.in[1];
    for (int i = wave * 64 + lane; i < NB * DM; i += NTHR) { const float v = c[i]; sc[i] = v * pg8::sigmoid_f(v); }
    __syncthreads();
    float* mod = (float*)(a.ws + WS_MOD);
    constexpr int NIT = DEPTH * (NMOD / 64);
    for (int it = blockIdx.x; it < NIT; it += gridDim.x) {
        const int l = it / (NMOD / 64), j = (it % (NMOD / 64)) * 64 + lane;
        const float* w = a.in[2] + (size_t)l * DM * NMOD + j;
        float acc[NB];
#pragma unroll
        for (int b = 0; b < NB; ++b) acc[b] = 0.f;
        const int k0 = wave * 128;
#pragma unroll 8
        for (int k = 0; k < 128; ++k) { const float wv = w[(size_t)(k0 + k) * NMOD];
#pragma unroll
            for (int b = 0; b < NB; ++b) acc[b] += sc[b * DM + k0 + k] * wv; }
#pragma unroll
        for (int b = 0; b < NB; ++b) part[(wave * NB + b) * 64 + lane] = acc[b];
        __syncthreads();
        { const int b = wave; float s = a.in[3][(size_t)l * NMOD + j];
#pragma unroll
            for (int w8 = 0; w8 < 8; ++w8) s += part[(w8 * NB + b) * 64 + lane];
            mod[((size_t)l * NB + b) * NMOD + j] = s; }
        __syncthreads();
    }
}
template <int NR>
__device__ __forceinline__ void norm_mod_rows(const float* x, bf16* Hout, const float* const* mbp, const float* nw, const int* rows, int lane) {
    f32x4 v[NR][4]; float ss[NR];
#pragma unroll
    for (int r = 0; r < NR; ++r) { const f32x4* xr = (const f32x4*)(x + (size_t)rows[r] * DM) + lane;
#pragma unroll
        for (int j = 0; j < 4; ++j) v[r][j] = xr[64 * j]; }
#pragma unroll
    for (int r = 0; r < NR; ++r) { float s = 0.f;
#pragma unroll
        for (int j = 0; j < 4; ++j) s += (v[r][j].x * v[r][j].x + v[r][j].y * v[r][j].y) + (v[r][j].z * v[r][j].z + v[r][j].w * v[r][j].w);
        ss[r] = s; }
#pragma unroll
    for (int o = 1; o < 64; o <<= 1)
#pragma unroll
        for (int r = 0; r < NR; ++r) ss[r] += shx(ss[r], o, lane);
#pragma unroll
    for (int r = 0; r < NR; ++r) { const float rstd = 1.0f / sqrtf(ss[r] * (1.f / DM) + NORM_EPS); const float* shift = mbp[r]; const float* scale = mbp[r] + DM;
        u32x2* o8 = (u32x2*)(Hout + (size_t)rows[r] * DM) + lane;
#pragma unroll
        for (int j = 0; j < 4; ++j) { const int c4 = lane + 64 * j; const f32x4 w = ((const f32x4*)nw)[c4], sc = ((const f32x4*)scale)[c4], sh = ((const f32x4*)shift)[c4];
            const f32x4 o = v[r][j] * rstd * w * (sc + 1.0f) + sh; u32x2 p; p.x = pk2(o.x, o.y); p.y = pk2(o.z, o.w); o8[64 * j] = p; } }
}
__device__ __forceinline__ void norm_phase(const Args& a, const float* x, int l, int sub, int gw, int ngw, int lane) {
    lane = launder(lane);
    bf16* H = (bf16*)(a.ws + WS_H); const float* mod = (const float*)(a.ws + WS_MOD); const float* nw = a.in[4] + ((size_t)l * 3 + sub) * DM;
    constexpr int NR = 4;
    for (int m = gw; m < MROWS; m += NR * ngw) { int rows[NR]; const float* mbp[NR];
#pragma unroll
        for (int r = 0; r < NR; ++r) { rows[r] = m + r * ngw; if (rows[r] >= MROWS) rows[r] = m; mbp[r] = mod + ((size_t)l * NB + (rows[r] >> 13)) * NMOD + sub * 3 * DM; }
        norm_mod_rows<NR>(x, H, mbp, nw, rows, lane); }
}
__device__ __forceinline__ void final_norm_phase(const Args& a, int gw, int ngw, int lane) {
    lane = launder(lane);
    const float* fw = a.in[17];
#ifdef DBG_CHECK
    const float dbgs = 1.0f + (float)((const unsigned*)(a.ws + WS_CTL))[32];
#else
    const float dbgs = 1.0f;
#endif
    for (int m = gw; m < MROWS; m += ngw) { f32x4* xr = (f32x4*)(a.out + (size_t)m * DM) + lane;
        f32x4 v[4]; float s = 0.f;
#pragma unroll
        for (int j = 0; j < 4; ++j) { v[j] = xr[64 * j]; s += (v[j].x * v[j].x + v[j].y * v[j].y) + (v[j].z * v[j].z + v[j].w * v[j].w); }
        const float rstd = 1.0f / sqrtf(wave_sum(s, lane) * (1.f / DM) + NORM_EPS);
#pragma unroll
        for (int j = 0; j < 4; ++j) xr[64 * j] = v[j] * (rstd * dbgs) * ((const f32x4*)fw)[lane + 64 * j]; }
}

constexpr int R_Q = 0, R_K = R_Q + 64 * 272, R_QD = R_K + 64 * 272, R_KD = R_QD + 64 * 272, R_SC = R_KD + 64 * 320, R_V = R_SC + 64 * 144, R_DEC = R_V + 64 * 576, R_END = R_DEC + 256;
static_assert(R_END <= 131072 && 64 * 1040 <= R_DEC, "retention LDS");
__device__ __forceinline__ void retention_unit(const Args& a, int l, int b, int h, LAS unsigned char* lds, const int wave_s, const bool dummy = false) {
    asm volatile("" : "+s"(h));
    const int lane = hw_lane(), wave = wave_s, tid = wave_s * 64 + lane, r32 = lane & 31, hh = lane >> 5;
    const int q4 = (lane & 15) >> 2, p4 = lane & 3, g1 = (lane >> 4) & 1;
    const bf16* RQK = (const bf16*)(a.ws + WS_B0); const bf16* RV = (const bf16*)(a.ws + WS_B0 + ACT); bf16* RG = (bf16*)(a.ws + WS_B0 + 2 * ACT);
    const float* gn = a.in[8] + (size_t)l * DM + h * 256;
    const float lg = sgpr_f(log2f(1.0f - exp2f(-5.0f - (float)h)));
    const float sc_qk = 0.08838834764831845f;
    const float cdec = sgpr_f(exp2f(lg * 64.f));
    const size_t row0 = (size_t)b * SEQ;
    f32x16 S[4];
#pragma unroll
    for (int i = 0; i < 4; ++i) S[i] = f32x16{};
    u32x4 pq[2], pk[2], pv[4]; u32x2 prg[8];
    const int er = tid >> 3, es = tid & 7;
#ifdef USE_RSB
#define RSB() __builtin_amdgcn_sched_barrier(0)
#else
#define RSB() do {} while (0)
#endif
#define R_PREFETCH(ci) do { const size_t t0 = row0 + (size_t)(ci) * 64; \
        _Pragma("unroll") for (int i = 0; i < 2; ++i) { const int idx = tid + 512 * i, rr = idx >> 4, ch = idx & 15; \
            pq[i] = *(const u32x4*)(RQK + (t0 + rr) * DM + h * 128 + ch * 8); pk[i] = *(const u32x4*)(RQK + (t0 + rr) * DM + 512 + h * 128 + ch * 8); } \
        _Pragma("unroll") for (int i = 0; i < 4; ++i) { const int idx = tid + 512 * i, rr = idx >> 5, ch = idx & 31; pv[i] = *(const u32x4*)(RV + (t0 + rr) * DM + h * 256 + ch * 8); } } while (0)
#define R_STORE() do { \
        _Pragma("unroll") for (int i = 0; i < 2; ++i) { const int idx = tid + 512 * i, rr = idx >> 4, ch = idx & 15; \
            *(LAS u32x4*)(lds + R_Q + rr * 272 + ch * 16) = pq[i]; *(LAS u32x4*)(lds + R_K + rr * 272 + ch * 16) = pk[i]; \
            const float fqd = exp2f(lg * (float)rr); u32x4 qd; \
            qd.x = pk2(bflo(pq[i].x) * fqd, bfhi(pq[i].x) * fqd); qd.y = pk2(bflo(pq[i].y) * fqd, bfhi(pq[i].y) * fqd); qd.z = pk2(bflo(pq[i].z) * fqd, bfhi(pq[i].z) * fqd); qd.w = pk2(bflo(pq[i].w) * fqd, bfhi(pq[i].w) * fqd); \
            *(LAS u32x4*)(lds + R_QD + rr * 272 + ch * 16) = qd; \
            const float f = sc_qk * exp2f(lg * (float)(64 - rr)); u32x4 kd; \
            kd.x = pk2(bflo(pk[i].x) * f, bfhi(pk[i].x) * f); kd.y = pk2(bflo(pk[i].y) * f, bfhi(pk[i].y) * f); kd.z = pk2(bflo(pk[i].z) * f, bfhi(pk[i].z) * f); kd.w = pk2(bflo(pk[i].w) * f, bfhi(pk[i].w) * f); \
            *(LAS u32x4*)(lds + R_KD + rr * 320 + ch * 16) = kd; } \
        _Pragma("unroll") for (int i = 0; i < 4; ++i) { const int idx = tid + 512 * i, rr = idx >> 5, ch = idx & 31; *(LAS u32x4*)(lds + R_V + rr * 576 + ch * 16) = pv[i]; } } while (0)
    R_PREFETCH(0);
    if (tid < 64) *(LAS float*)(lds + R_DEC + tid * 4) = sc_qk * exp2f(lg * (float)tid);
    R_STORE();
    LDS_BARRIER();
    for (int ci = 0; ci < SEQ / 64; ++ci) {
        const size_t t0 = row0 + (size_t)ci * 64;
        float lgl = lg;
#ifdef LGL
        asm volatile("" : "+v"(lgl));
#endif
        if (ci + 1 < SEQ / 64) R_PREFETCH(ci + 1);
#ifndef RG_LATE
#pragma unroll
        for (int j = 0; j < 8; ++j) prg[j] = *(const u32x2*)(RG + (t0 + er) * DM + h * 256 + 4 * (es + 8 * j));
#endif
        RSB();
        if (wave < 4) {
            const int qb = wave >> 1, kb = wave & 1; f32x16 x = f32x16{};
#pragma unroll
            for (int ks = 0; ks < 8; ++ks) { const bf16x8 af = *(const LAS bf16x8*)(lds + R_Q + (32 * qb + r32) * 272 + (16 * ks + 8 * hh) * 2);
                const bf16x8 bfr = *(const LAS bf16x8*)(lds + R_K + (32 * kb + r32) * 272 + (16 * ks + 8 * hh) * 2); x = MFMA32(af, bfr, x); }
#pragma unroll
            for (int i = 0; i < 16; ++i) { const int q = 32 * qb + crow(i, hh), k = 32 * kb + r32; const int d = q > k ? q - k : k - q;
                const float v = x[i] * *(const LAS float*)(lds + R_DEC + d * 4); *(LAS unsigned short*)(lds + R_SC + q * 144 + k * 2) = (unsigned short)f2bf(v); }
        }
        RSB();
        f32x16 y[2]; y[0] = f32x16{}; y[1] = f32x16{};
#pragma unroll
        for (int dkb = 0; dkb < 4; ++dkb)
#pragma unroll
            for (int s = 0; s < 2; ++s) { const bf16x8 sp = pack8(S[dkb], s);
#pragma unroll
                for (int qb = 0; qb < 2; ++qb) { const LAS unsigned char* qp = lds + R_QD + (32 * qb + r32) * 272 + (32 * dkb + 16 * s + 4 * hh) * 2;
                    const s16x4 lo = *(const LAS s16x4*)qp, hi = *(const LAS s16x4*)(qp + 16); y[qb] = MFMA32(cat8(lo, hi), sp, y[qb]); } }
        RSB();
        LDS_BARRIER();
        bf16x8 vf[4];
#pragma unroll
        for (int ks = 0; ks < 4; ++ks) { const LAS unsigned char* vp = lds + R_V + (16 * ks + 8 * hh + q4) * 576 + (32 * wave + 16 * g1) * 2 + 8 * p4; vf[ks] = cat8(tr_read(vp), tr_read(vp + 4 * 576)); }
#pragma unroll
        for (int ks = 0; ks < 4; ++ks)
#pragma unroll
            for (int qb = 0; qb < 2; ++qb) { const bf16x8 af = *(const LAS bf16x8*)(lds + R_SC + (32 * qb + r32) * 144 + (16 * ks + 8 * hh) * 2); y[qb] = MFMA32(af, vf[ks], y[qb]); }
        RSB();
#pragma unroll
        for (int dkb = 0; dkb < 4; ++dkb) {
#pragma unroll
            for (int i = 0; i < 16; ++i) S[dkb][i] *= cdec;
#pragma unroll
            for (int ks = 0; ks < 4; ++ks) { const LAS unsigned char* kp = lds + R_KD + (16 * ks + 8 * hh + q4) * 320 + (32 * dkb + 16 * g1) * 2 + 8 * p4;
                S[dkb] = MFMA32(cat8(tr_read(kp), tr_read(kp + 4 * 320)), vf[ks], S[dkb]); } }
        LDS_BARRIER();
#ifdef RG_LATE
#pragma unroll
        for (int j = 0; j < 8; ++j) prg[j] = *(const u32x2*)(RG + (t0 + er) * DM + h * 256 + 4 * (es + 8 * j));
#endif
#pragma unroll
        for (int qb = 0; qb < 2; ++qb)
#pragma unroll
            for (int i = 0; i < 16; ++i) *(LAS float*)(lds + (32 * qb + crow(i, hh)) * 1040 + (32 * wave + r32) * 4) = y[qb][i];
        LDS_BARRIER();
        { f32x4 yv[8]; float ss = 0.f;
#pragma unroll
            for (int j = 0; j < 8; ++j) { yv[j] = *(const LAS f32x4*)(lds + er * 1040 + 16 * (es + 8 * j)); ss += (yv[j].x * yv[j].x + yv[j].y * yv[j].y) + (yv[j].z * yv[j].z + yv[j].w * yv[j].w); }
            ss += shx(ss, 1, lane); ss += shx(ss, 2, lane); ss += shx(ss, 4, lane);
            const float rstd = 1.0f / sqrtf(ss * (1.f / 256.f) + NORM_EPS);
#pragma unroll
            for (int j = 0; j < 8; ++j) { const int c = 4 * (es + 8 * j); const f32x4 w = *(const f32x4*)(gn + c);
                const float g0 = bflo(prg[j].x), g1v = bfhi(prg[j].x), g2 = bflo(prg[j].y), g3 = bfhi(prg[j].y);
                u32x2 o; o.x = pk2(yv[j].x * rstd * w.x * g0 * pg8::sigmoid_f(g0), yv[j].y * rstd * w.y * g1v * pg8::sigmoid_f(g1v));
                o.y = pk2(yv[j].z * rstd * w.z * g2 * pg8::sigmoid_f(g2), yv[j].w * rstd * w.w * g3 * pg8::sigmoid_f(g3));
                if (!dummy || rstd == -12345.f) *(u32x2*)(RG + (t0 + er) * DM + h * 256 + c) = o; } }
        LDS_BARRIER();
        if (ci + 1 < SEQ / 64) R_STORE();
        LDS_BARRIER();
    }
#undef R_PREFETCH
#undef R_STORE
}

constexpr int A_KS = 272, A_VS = 320, A_KB = 64 * A_KS, A_VB = 64 * A_VS, A_BUF = A_KB + A_VB, A_X = 0;
static_assert(2 * A_BUF <= 131072 && 4 * 64 * 64 * 4 <= 131072, "attention LDS");
__device__ __forceinline__ void attn_unit(const Args& a, int l, int b, int h, int qb, float lam, float post, LAS unsigned char* lds, const int wave_s, const bool dummy = false) {
    asm volatile("" : "+s"(h));
    const int lane = hw_lane(), wave = wave_s, tid = wave_s * 64 + lane, r32 = lane & 31, hh = lane >> 5;
    const int q4 = (lane & 15) >> 2, p4 = lane & 3, g1 = (lane >> 4) & 1;
    const int sub = wave >> 2, wq = wave & 3;
    bf16* DQ = (bf16*)(a.ws + WS_B0 + 3 * ACT); const bf16* DK = (const bf16*)(a.ws + WS_B0 + 4 * ACT); const bf16* DV = (const bf16*)(a.ws + WS_B0 + 5 * ACT);
    const size_t row0 = (size_t)b * SEQ; const int q0 = qb * 128;
    const int NT = 2 * qb + 2;
    const float sl2 = sgpr_f(exp2f(-(float)(h + 1)) * LOG2E);
    bf16x8 qf[4];
    { const bf16* qp = DQ + (row0 + q0 + 32 * wq + r32) * DM + h * 128 + sub * 64 + 8 * hh;
#pragma unroll
        for (int ks = 0; ks < 4; ++ks) qf[ks] = *(const bf16x8*)(qp + 16 * ks); }
    u32x4 pk[2], pv[2];
#define A_PREFETCH(t) do { const size_t t0 = row0 + (size_t)(t) * 64; \
        _Pragma("unroll") for (int i = 0; i < 2; ++i) { const int idx = tid + 512 * i, rr = idx >> 4, ch = idx & 15; \
            pk[i] = *(const u32x4*)(DK + (t0 + rr) * DM + h * 128 + ch * 8); pv[i] = *(const u32x4*)(DV + (t0 + rr) * DM + h * 128 + ch * 8); } } while (0)
#define A_STORE(bufo) do { \
        _Pragma("unroll") for (int i = 0; i < 2; ++i) { const int idx = tid + 512 * i, rr = idx >> 4, ch = idx & 15; \
            *(LAS u32x4*)(lds + (bufo) + rr * A_KS + ch * 16) = pk[i]; *(LAS u32x4*)(lds + (bufo) + A_KB + rr * A_VS + ch * 16) = pv[i]; } } while (0)
    f32x16 o[4];
#pragma unroll
    for (int i = 0; i < 4; ++i) o[i] = f32x16{};
    float mrun = -1e30f, lrun = 0.f;
    f32x16 cb;
#pragma unroll
    for (int i = 0; i < 16; ++i) cb[i] = sl2 * (float)((i & 3) + 8 * (i >> 2) + 4 * hh);
    const float c32 = sgpr_f(32.f * sl2);
    const int tq = NT - 2 + (wq >> 1);
    const float qin = (float)(32 * (wq & 1) + r32), qs = sl2 * qin;
    const int tmin = max(0, (int)ceilf((128.f * (float)qb - 63.f - 280.f / sl2) * (1.f / 64.f)));
    A_PREFETCH(NT - 1);
    A_STORE(0);
    LDS_BARRIER();
    for (int it = 0; it < NT - tmin; ++it) {
        const int t = NT - 1 - it, bufo = (it & 1) * A_BUF;
        if (t > tmin) A_PREFETCH(t - 1);
        if (t <= tq) {
            f32x16 s[2];
            s[0] = cb;
#pragma unroll
            for (int i = 0; i < 16; ++i) s[1][i] = cb[i] + c32;
#pragma unroll
            for (int kb = 0; kb < 2; ++kb)
#pragma unroll
                for (int ks = 0; ks < 4; ++ks) { const bf16x8 kf = *(const LAS bf16x8*)(lds + bufo + (32 * kb + r32) * A_KS + (sub * 64 + 16 * ks + 8 * hh) * 2); s[kb] = MFMA32(kf, qf[ks], s[kb]); }
            float ut = -sl2 * (qin + 64.f * (float)(tq - t));
            if (t == tq) {
                ut = 0.f;
#pragma unroll
                for (int i = 0; i < 16; ++i) { const float c0 = cb[i], c1 = cb[i] + c32; s[0][i] = s[0][i] - c0 - fabsf(qs - c0); s[1][i] = s[1][i] - c1 - fabsf(qs - c1); }
            }
            float mt = fmaxf(s[0][0], s[1][0]);
#pragma unroll
            for (int i = 1; i < 16; ++i) mt = fmaxf(fmaxf(mt, s[0][i]), s[1][i]);
            mt = fmaxf(mt, shx(mt, 32, lane)) + ut;
            if (__any(mt > mrun)) {
                const float mnew = fmaxf(mrun, mt), alpha = __builtin_amdgcn_exp2f(mrun - mnew); mrun = mnew; lrun *= alpha;
#pragma unroll
                for (int d4 = 0; d4 < 4; ++d4)
#pragma unroll
                    for (int i = 0; i < 16; ++i) o[d4][i] *= alpha;
            }
            const float ml = mrun - ut;
            float ps = 0.f;
#pragma unroll
            for (int kb = 0; kb < 2; ++kb)
#pragma unroll
                for (int i = 0; i < 16; ++i) { s[kb][i] = __builtin_amdgcn_exp2f(s[kb][i] - ml); ps += s[kb][i]; }
            lrun += ps;
            __builtin_amdgcn_sched_barrier(0);
            {
                const LAS unsigned char* vbase = lds + bufo + A_KB + (4 * hh + q4) * A_VS + (16 * g1) * 2 + 8 * p4;
                bf16x8 vcur[4], vnxt[4];
#pragma unroll
                for (int d4 = 0; d4 < 4; ++d4) vcur[d4] = cat8(tr_read(vbase + 64 * d4), tr_read(vbase + 64 * d4 + 8 * A_VS));
#pragma unroll
                for (int g = 0; g < 4; ++g) {
                    if (g < 3) {
#pragma unroll
                        for (int d4 = 0; d4 < 4; ++d4) vnxt[d4] = cat8(tr_read(vbase + (g + 1) * 16 * A_VS + 64 * d4), tr_read(vbase + (g + 1) * 16 * A_VS + 64 * d4 + 8 * A_VS)); }
                    const bf16x8 pf = pack8v(s[g >> 1], g & 1);
#pragma unroll
                    for (int d4 = 0; d4 < 4; ++d4) o[d4] = MFMA32(vcur[d4], pf, o[d4]);
                    __builtin_amdgcn_sched_barrier(0);
#pragma unroll
                    for (int d4 = 0; d4 < 4; ++d4) vcur[d4] = vnxt[d4];
                }
            }
        }
        if (t > tmin) A_STORE(((it + 1) & 1) * A_BUF);
        LDS_BARRIER();
    }
    lrun += shx(lrun, 32, lane);
    const float rl = 1.0f / lrun;
    if (sub == 1) {
#pragma unroll
        for (int d4 = 0; d4 < 4; ++d4)
#pragma unroll
            for (int i = 0; i < 16; ++i) *(LAS float*)(lds + A_X + ((wq * 64 + d4 * 16 + i) * 64 + lane) * 4) = o[d4][i] * rl;
    }
    __syncthreads();
    if (sub == 0) {
        float ss = 0.f;
#pragma unroll
        for (int d4 = 0; d4 < 4; ++d4)
#pragma unroll
            for (int i = 0; i < 16; ++i) { const float v = o[d4][i] * rl - lam * *(const LAS float*)(lds + A_X + ((wq * 64 + d4 * 16 + i) * 64 + lane) * 4); o[d4][i] = v; ss += v * v; }
        ss += shx(ss, 32, lane);
        const float rstd = post / sqrtf(ss * (1.f / 128.f) + NORM_EPS);
        const float* sw = a.in[13] + (size_t)l * 128;
        bf16* op = DQ + (row0 + q0 + 32 * wq + r32) * DM + h * 128;
#pragma unroll
        for (int d4 = 0; d4 < 4; ++d4)
#pragma unroll
            for (int g = 0; g < 4; ++g) { const int dv = 32 * d4 + 8 * g + 4 * hh; const f32x4 w = *(const f32x4*)(sw + dv);
                u32x2 pkd; pkd.x = pk2(o[d4][4 * g] * rstd * w.x, o[d4][4 * g + 1] * rstd * w.y); pkd.y = pk2(o[d4][4 * g + 2] * rstd * w.z, o[d4][4 * g + 3] * rstd * w.w);
                if (!dummy || rstd == -12345.f) *(u32x2*)(op + dv) = pkd; }
    }
    __syncthreads();
#undef A_PREFETCH
#undef A_STORE
}


#define XB_TMO      128
#define XB_XCNT(j)  (256  + 64 * (j))
#define XB_XSUB(j)  (1280 + 64 * (j))
#define XB_XGEN(j)  (2304 + 64 * (j))
#define XB_TOP      3328
#define XB_TOPGEN   3392
#define XCD_BAR_WORDS 3456
#define XB_SPIN_CAP (1u << 24)

__device__ __forceinline__ unsigned xb_ld(unsigned* p)              { return __hip_atomic_load(p, __ATOMIC_RELAXED, __HIP_MEMORY_SCOPE_AGENT); }
__device__ __forceinline__ unsigned xb_add(unsigned* p, unsigned v) { return __hip_atomic_fetch_add(p, v, __ATOMIC_RELAXED, __HIP_MEMORY_SCOPE_AGENT); }
__device__ __forceinline__ unsigned xb_xcc_id() { return (unsigned)__builtin_amdgcn_s_getreg((3 << 11) | 20) & 0xFu; }
#define XB_SPIN(cond, bar) do { unsigned _sp = 0; while (cond) { __builtin_amdgcn_s_sleep(1); \
    if ((++_sp & 255u) == 0u) { if (xb_ld(&(bar)[XB_TMO])) break; if (_sp > XB_SPIN_CAP) { atomicAdd(&(bar)[XB_TMO], 1u); break; } } } } while (0)

struct XcdBarrier {
    unsigned* bar; unsigned x;
    volatile LAS unsigned* st;
};

__device__ __forceinline__ XcdBarrier xcd_barrier_post(unsigned* bar, volatile LAS unsigned* st, bool first) {
    XcdBarrier b; b.bar = bar; b.x = xb_xcc_id(); b.st = st;
    if (first) (void)xb_add(&bar[XB_XCNT(b.x)], 1u);
    return b;
}
__device__ __forceinline__ void xcd_barrier_complete(unsigned* bar, unsigned x, unsigned& nloc, unsigned& nx) {
    const unsigned G = gridDim.x * gridDim.y * gridDim.z;
    unsigned sum, cnt, mine, sp = 0u;
    for (;;) {
        sum = 0u; cnt = 0u; mine = 0u;
#pragma unroll
        for (unsigned j = 0; j < 16; ++j) { const unsigned c = xb_ld(&bar[XB_XCNT(j)]); sum += c; cnt += (c > 0u) ? 1u : 0u; mine = (j == x) ? c : mine; }
        if (sum == G) break;
        __builtin_amdgcn_s_sleep(1);
        if ((++sp & 255u) == 0u) { if (xb_ld(&bar[XB_TMO])) break; if (sp > XB_SPIN_CAP) { atomicAdd(&bar[XB_TMO], 1u); break; } }
    }
    nloc = mine > 0u ? mine : 1u; nx = cnt > 0u ? cnt : 1u;
}

__device__ __forceinline__ void xcd_barrier(const XcdBarrier& b, const bool first) {
    asm volatile("s_waitcnt vmcnt(0)" ::: "memory");
    __syncthreads();
    if (first) {
        unsigned* bar = b.bar;
        __builtin_amdgcn_s_waitcnt(0);
        unsigned nloc = b.st[0], nx = b.st[1];
        if (nloc == 0u) { xcd_barrier_complete(bar, b.x, nloc, nx); b.st[0] = nloc; b.st[1] = nx; }
        const unsigned old = xb_add(&bar[XB_XSUB(b.x)], 1u);
        const unsigned gen = old / nloc;
        if (old + 1u == (gen + 1u) * nloc) {
            __builtin_amdgcn_fence(__ATOMIC_RELEASE, "agent");
            asm volatile("s_waitcnt vmcnt(0)" ::: "memory");
            const unsigned og = xb_add(&bar[XB_TOP], 1u);
            const unsigned tg = og / nx;
            if (og + 1u == (tg + 1u) * nx) xb_add(&bar[XB_TOPGEN], 1u);
            else XB_SPIN(xb_ld(&bar[XB_TOPGEN]) == tg, bar);
            __builtin_amdgcn_fence(__ATOMIC_ACQUIRE, "agent");
            xb_add(&bar[XB_XGEN(b.x)], 1u);
            asm volatile("s_waitcnt vmcnt(0)" ::: "memory");
        } else {
            XB_SPIN(xb_ld(&bar[XB_XGEN(b.x)]) == gen, bar);
            __builtin_amdgcn_fence(__ATOMIC_ACQUIRE, "agent");
            asm volatile("s_waitcnt vmcnt(0)" ::: "memory");
        }
    }
    __syncthreads();
}

#define CG_SYNC() do { asm volatile("s_waitcnt vmcnt(0) lgkmcnt(0)" ::: "memory"); __syncthreads(); grid.sync(); \
    __builtin_amdgcn_fence(__ATOMIC_ACQUIRE, "agent"); asm volatile("s_waitcnt vmcnt(0)" ::: "memory"); __syncthreads(); } while (0)
#define IS_T0 (wave_s == 0 && hw_lane() == 0)
#define GRID_SYNC() xcd_barrier(xbar, IS_T0)
constexpr int CW_BAR = 4096;
typedef const __attribute__((address_space(4))) Args* KArgsPtr;
#define PHASE_BEGIN Args a; { KArgsPtr ka_ = (KArgsPtr)__builtin_amdgcn_kernarg_segment_ptr(); asm volatile("" : "+s"(ka_)); _Pragma("unroll") for (int i_ = 0; i_ < 18; ++i_) a.in[i_] = ka_->in[i_]; a.out = ka_->out; a.ws = ka_->ws; } \
    const int lane = hw_lane(), wave = wave_s, tid = wave_s * 64 + lane; const int G = gridDim.x, gw = blockIdx.x * NWAVES + wave, ngw = G * NWAVES; \
    unsigned* ctl = (unsigned*)(a.ws + WS_CTL); const float* mod = (const float*)(a.ws + WS_MOD); bf16* WT = (bf16*)(a.ws + WS_WT); bf16* H = (bf16*)(a.ws + WS_H); bf16* HID = (bf16*)(a.ws + WS_HID); bf16* B0 = (bf16*)(a.ws + WS_B0); \
    (void)tid; (void)lane; (void)wave; (void)G; (void)gw; (void)ngw; (void)ctl; (void)mod; (void)WT; (void)H; (void)HID; (void)B0;
#define GEMM_RUN(EPI, ...) do { pg8::StaticOrder S; S.init(MROWS, g.N, G, (int)blockIdx.x); EPI E{__VA_ARGS__}; pg8::gemm_phase<EPI, pg8::StaticOrder, true, true>(lds, g, S, E, wave_s); } while (0)

__global__ void __launch_bounds__(NTHR, 2) hybrid_fwd(Args args_unused) {
    extern __shared__ __attribute__((aligned(16))) unsigned char lds_raw[];
    LAS unsigned char* lds = (LAS unsigned char*)lds_raw;
    cg::grid_group grid = cg::this_grid();
    const int wave_s = __builtin_amdgcn_readfirstlane((int)threadIdx.x >> 6);
    LAS unsigned* qslot = (LAS unsigned*)(lds + 131072);

    {
        PHASE_BEGIN
        if (blockIdx.x == 0) { if (tid < 64) ctl[tid] = 0u; for (int i = tid; i < XCD_BAR_WORDS; i += NTHR) ctl[CW_BAR + i] = 0u; }
        ada_phase(a, lds, wave, lane);
        convert_weights(a, 0, lds, gw, ngw, wave, lane);
    }
    CG_SYNC();
    XcdBarrier xbar;
    {   PHASE_BEGIN
        volatile LAS unsigned* st = (volatile LAS unsigned*)(lds + 131072 + 16);
        if (tid < 2) st[tid] = 0u;
        __syncthreads();
        xbar = xcd_barrier_post(ctl + CW_BAR, st, tid == 0);
    }

    for (int l = 0; l < DEPTH; ++l) {
        {
            PHASE_BEGIN
            if (l > 0) convert_weights(a, l, lds, gw, ngw, wave, lane);
            norm_phase(a, (l == 0) ? a.in[0] : a.out, l, 0, gw, ngw, lane);
        }
        GRID_SYNC();
#ifdef UP_TWICE
        { PHASE_BEGIN pg8::Gemm g{H, WT + W_UPA, MROWS, 2 * DFF, DM}; GEMM_RUN(pg8::EpiSwiGLU, HID, DFF); }
        GRID_SYNC();
#endif
        { PHASE_BEGIN pg8::Gemm g{H, WT + W_UPA, MROWS, 2 * DFF, DM}; GEMM_RUN(pg8::EpiSwiGLU, HID, DFF); }
        GRID_SYNC();
        { PHASE_BEGIN pg8::Gemm g{HID, WT + W_DNA, MROWS, DM, DFF}; GEMM_RUN(pg8::EpiResid, (l == 0) ? a.in[0] : a.out, a.out, mod + (size_t)l * NB * NMOD + 0 * 3 * DM + 2 * DM, NMOD, 0.5f, DM); }
        GRID_SYNC();
        { PHASE_BEGIN norm_phase(a, a.out, l, 1, gw, ngw, lane); }
        GRID_SYNC();
        { PHASE_BEGIN pg8::Gemm g{H, WT + W_IN, MROWS, 6 * DM, DM}; GEMM_RUN(pg8::EpiBf<0>, B0, DM, DM, (size_t)MROWS * DM, 3, 0.125f * LOG2E, nullptr); }
        GRID_SYNC();
        {
            PHASE_BEGIN
#ifdef RET_TWICE
            if (blockIdx.x < 32) retention_unit(a, l, blockIdx.x >> 2, blockIdx.x & 3, lds, wave_s, true);
#endif
            if (blockIdx.x < 32) retention_unit(a, l, blockIdx.x >> 2, blockIdx.x & 3, lds, wave_s);
            const float s1 = wave_sum(a.in[9][l * 64 + lane] * a.in[10][l * 64 + lane], lane), s2 = wave_sum(a.in[11][l * 64 + lane] * a.in[12][l * 64 + lane], lane);
            const float lam_init = sgpr_f(0.8f - 0.6f * expf(-0.3f * (float)l)), lam = sgpr_f(expf(s1) - expf(s2) + lam_init);
#ifdef ATT_TWICE
            for (;;) {
                if (tid == 0) *qslot = atomicAdd(ctl + 8 + l, 1u);
                __syncthreads();
                const unsigned item = *qslot;
                __syncthreads();
                if (item >= 64u * 64u) break;
                const int qb = 63 - (int)(item >> 6), bh = (int)(item & 63u);
                attn_unit(a, l, bh >> 3, bh & 7, qb, lam, 1.0f - lam_init, lds, wave_s, true);
            }
#endif
            const int q0 = (int)(xb_xcc_id() & 7u);
            for (int k = 0; k < NB; ++k) {
                const int bq = (q0 + k) & 7;
                for (;;) {
                    if (tid == 0) *qslot = atomicAdd(ctl + l * NB + bq, 1u);
                    __syncthreads();
                    const unsigned item = *qslot;
                    __syncthreads();
                    if (item >= 8u * 64u) break;
                    attn_unit(a, l, bq, 7 - (int)(item >> 6), 63 - (int)(item & 63u), lam, 1.0f - lam_init, lds, wave_s);
                }
            }
        }
        GRID_SYNC();
        {
            PHASE_BEGIN pg8::Gemm g{H, WT + W_IN + (size_t)6 * DM * DM, MROWS, 2 * DM, DM}; GEMM_RUN(pg8::EpiBf<0>, B0, DM, DM, (size_t)4 * MROWS * DM, -1, 1.f, nullptr); }
        GRID_SYNC();
        {
            PHASE_BEGIN pg8::Gemm g{B0 + (size_t)2 * MROWS * DM, WT + W_RET, MROWS, DM, DM}; GEMM_RUN(pg8::EpiBf<2>, B0 + (size_t)1 * MROWS * DM, DM, 0, 0, -1, 1.f, B0); }
        GRID_SYNC();
        {
            PHASE_BEGIN pg8::Gemm g{B0 + (size_t)3 * MROWS * DM, WT + W_DIF, MROWS, DM, DM}; GEMM_RUN(pg8::EpiBf<3>, B0 + (size_t)1 * MROWS * DM, DM, 0, 0, -1, 1.f, B0 + (size_t)4 * MROWS * DM); }
        GRID_SYNC();
        { PHASE_BEGIN pg8::Gemm g{B0 + (size_t)1 * MROWS * DM, WT + W_OUT, MROWS, DM, DM}; GEMM_RUN(pg8::EpiResid, a.out, a.out, mod + (size_t)l * NB * NMOD + 1 * 3 * DM + 2 * DM, NMOD, 1.0f, DM); }
        GRID_SYNC();
        { PHASE_BEGIN norm_phase(a, a.out, l, 2, gw, ngw, lane); }
        GRID_SYNC();
        { PHASE_BEGIN pg8::Gemm g{H, WT + W_UPB, MROWS, 2 * DFF, DM}; GEMM_RUN(pg8::EpiSwiGLU, HID, DFF); }
        GRID_SYNC();
        { PHASE_BEGIN pg8::Gemm g{HID, WT + W_DNB, MROWS, DM, DFF}; GEMM_RUN(pg8::EpiResid, a.out, a.out, mod + (size_t)l * NB * NMOD + 2 * 3 * DM + 2 * DM, NMOD, 0.5f, DM); }
        GRID_SYNC();
    }
#ifdef SYNC_PROBE
    for (int i = 0; i < 64; ++i) GRID_SYNC();
#endif
    { PHASE_BEGIN final_norm_phase(a, gw, ngw, lane); }
}

constexpr int LDS_BYTES = 147456;
extern "C" void kernel_launch(void* const* d_in, const int* in_sizes, int n_in, void* d_out, int out_size, void* d_ws, size_t ws_size, hipStream_t stream) {
    static int grid = 0;
    if (grid == 0) {
        if (n_in != 18 || ws_size < WS_END) { fprintf(stderr, "kernel_launch: unexpected n_in %d / ws_size %zu (need %zu)\n", n_in, ws_size, (size_t)WS_END); grid = -1; return; }
        int dev = 0, cus = 0, per_cu = 0;
        (void)hipGetDevice(&dev); (void)hipDeviceGetAttribute(&cus, hipDeviceAttributeMultiprocessorCount, dev);
        if (hipFuncSetAttribute((const void*)hybrid_fwd, hipFuncAttributeMaxDynamicSharedMemorySize, LDS_BYTES) != hipSuccess) { fprintf(stderr, "kernel_launch: hipFuncSetAttribute failed\n"); grid = -1; return; }
        if (hipOccupancyMaxActiveBlocksPerMultiprocessor(&per_cu, (const void*)hybrid_fwd, NTHR, LDS_BYTES) != hipSuccess || per_cu < 1) { fprintf(stderr, "kernel_launch: occupancy query says %d\n", per_cu); per_cu = 1; }
        (void)hipGetLastError();
        grid = cus * 1;
    }
    if (grid < 0) return;
    Args a{};
    for (int i = 0; i < 18; ++i) a.in[i] = (const float*)d_in[i];
    a.out = (float*)d_out; a.ws = (unsigned char*)d_ws;
    void* kargs[] = {&a};
    hipError_t e = hipLaunchCooperativeKernel((const void*)hybrid_fwd, dim3(grid), dim3(NTHR), kargs, LDS_BYTES, stream);
    if (e != hipSuccess) fprintf(stderr, "cooperative launch failed: %s (grid %d)\n", hipGetErrorString(e), grid);
}
```

```cpp
#define GATE_LOGITS 1
#include <hip/hip_runtime.h>
#include <hip/hip_cooperative_groups.h>
#include <cstdio>
#include <cstdint>
namespace cg = cooperative_groups;
#define USE_RSB 1
__device__ __forceinline__ int hw_lane() { int l = (int)__builtin_amdgcn_mbcnt_hi(~0u, __builtin_amdgcn_mbcnt_lo(~0u, 0u)); asm volatile("" : "+v"(l)); return l; }
namespace pg8 {
#define PG8_LAS __attribute__((address_space(3)))
typedef unsigned short bf16_t;
typedef short bf16x8 __attribute__((ext_vector_type(8)));
typedef float f32x4 __attribute__((ext_vector_type(4)));
typedef unsigned u32x4 __attribute__((ext_vector_type(4)));
constexpr int BM = 256, BK = 64, HALF = 128, HTB = HALF * BK * 2  , STAGE_BYTES = 8 * HTB, NXCD = 8, WGM = 8;

__host__ __device__ __forceinline__ int lds_byte(int r, int c) { const int st = (r >> 4) * 2 + (c >> 5), rr = r & 15, cc = c & 31, ob = rr * 64 + cc * 2; return st * 1024 + (ob ^ (((ob >> 9) & 1) << 5)); }
__host__ __device__ __forceinline__ void stage_rc(int b, int& R, int& C) { const int st = b / 1024, sb = b % 1024, swz = sb ^ (((sb >> 9) & 1) << 5); R = (st >> 1) * 16 + swz / 64; C = (st & 1) * 32 + (swz % 64) / 2; }
__host__ __device__ __forceinline__ int perm32(int rho) { const int n = rho >> 4, i = rho & 15; return 8 * (i >> 2) + 4 * n + (i & 3); }

struct Unit { int pm, pn, seg; };
struct Gemm { const bf16_t* A; const bf16_t* Bt; int M, N, K; const bf16_t* A2; const bf16_t* Bt2; };

struct StaticOrder {
    int nM, nN, nwg, G, c;
    __host__ __device__ void init(int M, int N, int G_, int c_) { nM = M / BM; nN = N / BM; nwg = nM * nN; G = G_; c = c_; }
    __host__ __device__ bool next(int i, Unit& u) const {
        const long L = (long)i * G + c; if (L >= nwg) return false;
        int wgid = (int)L; { const int q = nwg / NXCD, r = nwg % NXCD, xcd = wgid % NXCD, off = wgid / NXCD; wgid = (xcd < r ? xcd * (q + 1) : r * (q + 1) + (xcd - r) * q) + off; }
        const int nig = WGM * nN, gid = wgid / nig, fm = gid * WGM, gsz = (nM - fm) < WGM ? (nM - fm) : WGM;
        u.pm = fm + ((wgid % nig) % gsz); u.pn = (wgid % nig) / gsz; u.seg = 0; return true;
    }
    __device__ __forceinline__ void a_ready(const Unit&) const {}
    __device__ __forceinline__ void done(const Unit&) const {}
};
struct SegOrder {
    StaticOrder base;
    __host__ __device__ void init(int M, int N, int G_, int c_) { base.init(M, N, G_, c_); }
    __host__ __device__ bool next(int i, Unit& u) const { const bool ok = base.next(i >> 1, u); u.seg = i & 1; return ok; }
    __device__ __forceinline__ void a_ready(const Unit&) const {}
    __device__ __forceinline__ void done(const Unit&) const {}
};
template <class E, class = void> struct epi_seg { static constexpr bool value = false; };
template <class E> struct epi_seg<E, decltype((void)E::SEG)> { static constexpr bool value = E::SEG; };


__device__ __forceinline__ unsigned cvt_pk_bf16(float lo, float hi) { unsigned r; asm volatile("v_cvt_pk_bf16_f32 %0, %1, %2" : "=v"(r) : "v"(lo), "v"(hi)); return r; }
typedef float f32x2 __attribute__((ext_vector_type(2)));

__device__ __forceinline__ float sigmoid_f(float v) { return __builtin_amdgcn_rcpf(1.0f + __builtin_amdgcn_exp2f(-1.4426950408889634f * v)); }
__device__ __forceinline__ float bf_lo(unsigned w) { return __uint_as_float(w << 16); }
__device__ __forceinline__ float bf_hi(unsigned w) { return __uint_as_float(w & 0xffff0000u); }

struct EpiSwiGLU {
    static constexpr bool PERM = true, AFTER_DRAIN = false;
    bf16_t* O; int ldc;
    __device__ __forceinline__ void operator()(const f32x4 (&acc)[2][2][4][2], const Unit& u, int wr, int wc, int fr, int fq) const {
        const int row0 = u.pm * BM + wr * 64 + fr, col0 = u.pn * HALF + wc * 32 + 8 * fq;
#pragma unroll
        for (int ai = 0; ai < 2; ++ai)
#pragma unroll
            for (int m = 0; m < 4; ++m) {
                bf16_t* rowp = O + (size_t)(row0 + ai * HALF + m * 16) * ldc + col0;
                float v[8];
#pragma unroll
                for (int n = 0; n < 2; ++n)
#pragma unroll
                    for (int e = 0; e < 4; ++e) { const float a = acc[ai][0][m][n][e], b = acc[ai][1][m][n][e]; v[4 * n + e] = a * sigmoid_f(a) * b; }
                u32x4 w; w.x = cvt_pk_bf16(v[0], v[1]); w.y = cvt_pk_bf16(v[2], v[3]); w.z = cvt_pk_bf16(v[4], v[5]); w.w = cvt_pk_bf16(v[6], v[7]);
                *(u32x4*)rowp = w;
            }
    }
};
struct EpiResid {
    static constexpr bool PERM = false, AFTER_DRAIN = false;
    const float* base; float* out; const float* gate; int gate_bstride; float coef; int ldc;
    __device__ __forceinline__ void operator()(const f32x4 (&acc)[2][2][4][2], const Unit& u, int wr, int wc, int fr, int fq) const {
        const int col0 = u.pn * BM + wc * 32 + 4 * fq;
        const float* g = gate + (size_t)(u.pm >> 5) * gate_bstride;
        f32x4 gv[2][2];
#pragma unroll
        for (int bj = 0; bj < 2; ++bj)
#pragma unroll
            for (int n = 0; n < 2; ++n) gv[bj][n] = *(const f32x4*)(g + col0 + bj * HALF + n * 16) * coef;
#pragma unroll
        for (int ai = 0; ai < 2; ++ai)
#pragma unroll
            for (int m = 0; m < 4; ++m) { const size_t off = (size_t)(u.pm * BM + ai * HALF + wr * 64 + m * 16 + fr) * ldc + col0;
#pragma unroll
                for (int bj = 0; bj < 2; ++bj)
#pragma unroll
                    for (int n = 0; n < 2; ++n) { const f32x4 bs = *(const f32x4*)(base + off + bj * HALF + n * 16); *(f32x4*)(out + off + bj * HALF + n * 16) = bs + gv[bj][n] * acc[ai][bj][m][n]; } }
    }
};
#ifdef GATE_LOGITS
#define GSIG(x) sigmoid_f(x)
#else
#define GSIG(x) (x)
#endif
template <int MODE> struct EpiBf {
    static constexpr bool PERM = true, AFTER_DRAIN = false;
    bf16_t* O; int ldc; int split_cols; size_t split_stride; int qt; float qscale; const bf16_t* G;
    __device__ __forceinline__ void operator()(const f32x4 (&acc)[2][2][4][2], const Unit& u, int wr, int wc, int fr, int fq) const {
        const int row0 = u.pm * BM + wr * 64 + fr; int colt = u.pn * BM; bf16_t* base = O; float sc = 1.f;
        if (MODE <= 1) { const int t = colt / split_cols; base += (size_t)t * split_stride; colt -= t * split_cols; if (MODE == 0 && t == qt) sc = qscale; }
        const int col0 = colt + wc * 32 + 8 * fq;
#pragma unroll
        for (int ai = 0; ai < 2; ++ai)
#pragma unroll
            for (int m = 0; m < 4; ++m) { const size_t roff = (size_t)(row0 + ai * HALF + m * 16) * ldc + col0;
#pragma unroll
                for (int bj = 0; bj < 2; ++bj) {
                    f32x4 v0 = acc[ai][bj][m][0], v1 = acc[ai][bj][m][1];
                    if (MODE == 0) { v0 = v0 * sc; v1 = v1 * sc; }
                    if (MODE == 1) {
#pragma unroll
                        for (int e = 0; e < 4; ++e) { v0[e] = sigmoid_f(v0[e]); v1[e] = sigmoid_f(v1[e]); } }
                    if (MODE >= 2) { const u32x4 g = *(const u32x4*)(G + roff + bj * HALF);
                        v0[0] *= GSIG(bf_lo(g.x)); v0[1] *= GSIG(bf_hi(g.x)); v0[2] *= GSIG(bf_lo(g.y)); v0[3] *= GSIG(bf_hi(g.y)); v1[0] *= GSIG(bf_lo(g.z)); v1[1] *= GSIG(bf_hi(g.z)); v1[2] *= GSIG(bf_lo(g.w)); v1[3] *= GSIG(bf_hi(g.w)); }
                    if (MODE == 3) { const u32x4 t = *(const u32x4*)(base + roff + bj * HALF);
                        v0[0] += bf_lo(t.x); v0[1] += bf_hi(t.x); v0[2] += bf_lo(t.y); v0[3] += bf_hi(t.y); v1[0] += bf_lo(t.z); v1[1] += bf_hi(t.z); v1[2] += bf_lo(t.w); v1[3] += bf_hi(t.w); }
                    u32x4 w; w.x = cvt_pk_bf16(v0[0], v0[1]); w.y = cvt_pk_bf16(v0[2], v0[3]); w.z = cvt_pk_bf16(v1[0], v1[1]); w.w = cvt_pk_bf16(v1[2], v1[3]);
                    *(u32x4*)(base + roff + bj * HALF) = w; } }
    }
};
struct EpiMerge {
    static constexpr bool PERM = true, AFTER_DRAIN = false, SEG = true;
    bf16_t* O; int ldc; const bf16_t* GR; const bf16_t* GD;
    __device__ __forceinline__ void operator()(f32x4 (&acc)[2][2][4][2], const Unit& u, int wr, int wc, int fr, int fq) const {
        const int row0 = u.pm * BM + wr * 64 + fr, col0 = u.pn * BM + wc * 32 + 8 * fq;
#pragma unroll
        for (int ai = 0; ai < 2; ++ai)
#pragma unroll
            for (int m = 0; m < 4; ++m) { const size_t roff = (size_t)(row0 + ai * HALF + m * 16) * ldc + col0;
#pragma unroll
                for (int bj = 0; bj < 2; ++bj) {
                    const u32x4 gd = *(const u32x4*)(GD + roff + bj * HALF);
                    const float d[8] = {bf_lo(gd.x), bf_hi(gd.x), bf_lo(gd.y), bf_hi(gd.y), bf_lo(gd.z), bf_hi(gd.z), bf_lo(gd.w), bf_hi(gd.w)};
                    if (u.seg == 0) {
                        const u32x4 gr = *(const u32x4*)(GR + roff + bj * HALF);
                        const float r[8] = {bf_lo(gr.x), bf_hi(gr.x), bf_lo(gr.y), bf_hi(gr.y), bf_lo(gr.z), bf_hi(gr.z), bf_lo(gr.w), bf_hi(gr.w)};
#pragma unroll
                        for (int e = 0; e < 8; ++e) { const float ed = __builtin_amdgcn_exp2f(-1.4426950408889634f * d[e]), er = __builtin_amdgcn_exp2f(-1.4426950408889634f * r[e]);
                            acc[ai][bj][m][e >> 2][e & 3] *= (1.0f + ed) * __builtin_amdgcn_rcpf(1.0f + er); }
                    } else {
                        float v[8];
#pragma unroll
                        for (int e = 0; e < 8; ++e) v[e] = acc[ai][bj][m][e >> 2][e & 3] * sigmoid_f(d[e]);
                        u32x4 w; w.x = cvt_pk_bf16(v[0], v[1]); w.y = cvt_pk_bf16(v[2], v[3]); w.z = cvt_pk_bf16(v[4], v[5]); w.w = cvt_pk_bf16(v[6], v[7]);
                        *(u32x4*)(O + roff + bj * HALF) = w; }
                } }
    }
};


template <class Epi, class Sched, bool ALIGN_EPI = false, bool SP2 = false>
__device__ __forceinline__ void gemm_phase(PG8_LAS unsigned char* lds, const Gemm g, const Sched& S, const Epi& E, const int wave_s) {
    const int lane = hw_lane(), wid = wave_s, tid = wave_s * 64 + lane, wr = wid >> 2, wc = wid & 3, fr = lane & 15, fq = lane >> 4;
    const int K = g.K, nt = K / BK;
    unsigned voffA[2], voffB[2];
#pragma unroll
    for (int i = 0; i < 2; ++i) { int R, C; stage_rc(tid * 16 + i * 8192, R, C); const int Rb = Epi::PERM ? ((R & ~31) + perm32(R & 31)) : R;
        voffA[i] = (unsigned)(R * K + C) * 2u; voffB[i] = (unsigned)(Rb * K + C) * 2u; }
    const size_t kstep = (size_t)(BK * 2);
    const size_t hstep = (size_t)HALF * K * 2;
    const size_t tstep = 2 * hstep;
    const unsigned ldsw = (unsigned)wid * 1024u;
    const int aoff = lds_byte(wr * 64 + fr, fq * 8), boff = lds_byte(wc * 32 + fr, fq * 8);
#define PG8_SA(b, h) (((b) * 2 + (h)) * HTB)
#define PG8_SB(b, h) ((4 + (b) * 2 + (h)) * HTB)
#define PG8_STAGE(bufoff, gbase, voff) do { _Pragma("unroll") for (int _i = 0; _i < 2; ++_i) \
        __builtin_amdgcn_global_load_lds((const unsigned*)((const char*)(gbase) + (voff)[_i]), (PG8_LAS unsigned*)(lds + (bufoff) + ldsw + _i * 8192), 16, 0, 0); } while (0)
#define PG8_LDA(dst, b, h) do { _Pragma("unroll") for (int m = 0; m < 4; ++m) _Pragma("unroll") for (int k = 0; k < 2; ++k) dst[m][k] = *(const PG8_LAS bf16x8*)(lds + PG8_SA(b, h) + aoff + m * 2048 + k * 1024); } while (0)
#define PG8_LDB(dst, b, h) do { _Pragma("unroll") for (int n = 0; n < 2; ++n) _Pragma("unroll") for (int k = 0; k < 2; ++k) dst[n][k] = *(const PG8_LAS bf16x8*)(lds + PG8_SB(b, h) + boff + n * 2048 + k * 1024); } while (0)
#define PG8_MMA(ai, bj, At, Bt) do { __builtin_amdgcn_s_setprio(1); _Pragma("unroll") for (int m = 0; m < 4; ++m) _Pragma("unroll") for (int n = 0; n < 2; ++n) _Pragma("unroll") for (int k = 0; k < 2; ++k) \
        acc[ai][bj][m][n] = __builtin_amdgcn_mfma_f32_16x16x32_bf16(Bt[n][k], At[m][k], acc[ai][bj][m][n], 0, 0, 0); __builtin_amdgcn_s_setprio(0); } while (0)
#define PG8_WAIT_V(n) asm volatile("s_waitcnt vmcnt(" #n ")" ::: "memory")
#define PG8_WAIT_L(n) asm volatile("s_waitcnt lgkmcnt(" #n ")" ::: "memory")
#define PG8_BAR __builtin_amdgcn_s_barrier()
#define PG8_SCHED __builtin_amdgcn_sched_barrier(0)
    Unit cur, nxt; int ui = 0;
    if (!S.next(0, cur)) return;
    f32x4 acc[2][2][4][2];
#pragma unroll
    for (int a = 0; a < 2; ++a)
#pragma unroll
        for (int b = 0; b < 2; ++b)
#pragma unroll
            for (int m = 0; m < 4; ++m)
#pragma unroll
                for (int n = 0; n < 2; ++n) acc[a][b][m][n] = (f32x4){0.f, 0.f, 0.f, 0.f};
    bf16x8 At[4][2], B0[2][2], B1[2][2];
    const char* cA = (const char*)(cur.seg ? g.A2 : g.A) + (size_t)cur.pm * tstep; const char* cB = (const char*)(cur.seg ? g.Bt2 : g.Bt) + (size_t)cur.pn * tstep;
    S.a_ready(cur);
    if constexpr (SP2) {
        PG8_STAGE(PG8_SB(0, 0), cB, voffB); PG8_STAGE(PG8_SB(0, 1), cB + hstep, voffB); PG8_STAGE(PG8_SA(0, 0), cA, voffA); PG8_STAGE(PG8_SA(0, 1), cA + hstep, voffA);
        if (wr == 1) PG8_BAR;
        PG8_WAIT_V(2); PG8_BAR;
        PG8_STAGE(PG8_SB(1, 0), cB + kstep, voffB); PG8_STAGE(PG8_SA(1, 0), cA + kstep, voffA); PG8_STAGE(PG8_SB(1, 1), cB + hstep + kstep, voffB);
        PG8_WAIT_V(6); PG8_BAR;
    } else {
        PG8_STAGE(PG8_SB(0, 0), cB, voffB); PG8_STAGE(PG8_SA(0, 0), cA, voffA); PG8_STAGE(PG8_SB(0, 1), cB + hstep, voffB); PG8_STAGE(PG8_SA(0, 1), cA + hstep, voffA);
        if (wr == 1) PG8_BAR;
        PG8_WAIT_V(4); PG8_BAR;
        PG8_STAGE(PG8_SB(1, 0), cB + kstep, voffB); PG8_STAGE(PG8_SA(1, 0), cA + kstep, voffA); PG8_STAGE(PG8_SB(1, 1), cB + hstep + kstep, voffB);
        PG8_WAIT_V(6); PG8_BAR;
    }
    for (;;) {
        const bool has_next = S.next(ui + 1, nxt);
        const char* nA = has_next ? (const char*)(nxt.seg ? g.A2 : g.A) + (size_t)nxt.pm * tstep : cA; const char* nB = has_next ? (const char*)(nxt.seg ? g.Bt2 : g.Bt) + (size_t)nxt.pn * tstep : cB;
        for (int t = 0; t < nt; t += 2) {
            const bool last = (t == nt - 2);
            const char* a1 = cA + (size_t)(t + 1) * kstep;
            const char* a2 = last ? nA : cA + (size_t)(t + 2) * kstep; const char* b2 = last ? nB : cB + (size_t)(t + 2) * kstep;
            const char* a3 = a2 + kstep; const char* b3 = b2 + kstep;
            if (last && has_next) S.a_ready(nxt);
            if constexpr (SP2) {
            PG8_LDB(B0, 0, 0); PG8_LDB(B1, 0, 1); PG8_SCHED; PG8_LDA(At, 0, 0); PG8_STAGE(PG8_SA(1, 1), a1 + hstep, voffA);
            PG8_WAIT_V(8); PG8_WAIT_L(0); PG8_BAR; PG8_MMA(0, 0, At, B0); PG8_MMA(0, 1, At, B1); PG8_BAR; PG8_SCHED;
            PG8_LDA(At, 0, 1); PG8_STAGE(PG8_SB(0, 0), b2, voffB); PG8_STAGE(PG8_SB(0, 1), b2 + hstep, voffB); PG8_STAGE(PG8_SA(0, 0), a2, voffA);
            PG8_WAIT_V(8); PG8_WAIT_L(0); PG8_BAR; PG8_MMA(1, 0, At, B0); PG8_MMA(1, 1, At, B1); PG8_BAR; PG8_SCHED;
            PG8_LDB(B0, 1, 0); PG8_LDB(B1, 1, 1); PG8_SCHED; PG8_LDA(At, 1, 0); PG8_STAGE(PG8_SA(0, 1), a2 + hstep, voffA);
            PG8_WAIT_V(8); PG8_WAIT_L(0); PG8_BAR; PG8_MMA(0, 0, At, B0); PG8_MMA(0, 1, At, B1); PG8_BAR; PG8_SCHED;
            PG8_LDA(At, 1, 1); PG8_STAGE(PG8_SB(1, 0), b3, voffB); PG8_STAGE(PG8_SB(1, 1), b3 + hstep, voffB); PG8_STAGE(PG8_SA(1, 0), a3, voffA);
            PG8_WAIT_V(8); PG8_WAIT_L(0); PG8_BAR; PG8_MMA(1, 0, At, B0); PG8_MMA(1, 1, At, B1); PG8_BAR; PG8_SCHED;
            } else {
            PG8_LDB(B0, 0, 0); PG8_SCHED; PG8_LDA(At, 0, 0); PG8_STAGE(PG8_SA(1, 1), a1 + hstep, voffA);
            PG8_WAIT_L(8); PG8_BAR; PG8_WAIT_L(0); PG8_MMA(0, 0, At, B0); PG8_BAR; PG8_SCHED;
            PG8_LDB(B1, 0, 1); PG8_STAGE(PG8_SB(0, 0), b2, voffB);
            PG8_BAR; PG8_WAIT_L(0); PG8_MMA(0, 1, At, B1); PG8_BAR;
            PG8_LDA(At, 0, 1); PG8_STAGE(PG8_SA(0, 0), a2, voffA);
            PG8_BAR; PG8_WAIT_L(0); PG8_MMA(1, 0, At, B0); PG8_BAR; PG8_SCHED;
            PG8_STAGE(PG8_SB(0, 1), b2 + hstep, voffB);
            PG8_WAIT_V(6); PG8_BAR; PG8_MMA(1, 1, At, B1); PG8_BAR;
            PG8_LDB(B0, 1, 0); PG8_SCHED; PG8_LDA(At, 1, 0); PG8_STAGE(PG8_SA(0, 1), a2 + hstep, voffA);
            PG8_WAIT_L(8); PG8_BAR; PG8_WAIT_L(0); PG8_MMA(0, 0, At, B0); PG8_BAR; PG8_SCHED;
            PG8_LDB(B1, 1, 1); PG8_STAGE(PG8_SB(1, 0), b3, voffB);
            PG8_BAR; PG8_WAIT_L(0); PG8_MMA(0, 1, At, B1); PG8_BAR;
            PG8_LDA(At, 1, 1); PG8_STAGE(PG8_SA(1, 0), a3, voffA);
            PG8_BAR; PG8_WAIT_L(0); PG8_MMA(1, 0, At, B0); PG8_BAR; PG8_SCHED;
            PG8_STAGE(PG8_SB(1, 1), b3 + hstep, voffB);
            PG8_WAIT_V(6); PG8_BAR; PG8_MMA(1, 1, At, B1); PG8_BAR;
            }
        }
        if constexpr (ALIGN_EPI) { if (wr == 0) PG8_BAR; }
        if constexpr (!Epi::AFTER_DRAIN) { E(acc, cur, wr, wc, fr, fq); S.done(cur); }
        if (!has_next) break;
        if (!(epi_seg<Epi>::value && nxt.seg == 1)) {
#pragma unroll
        for (int a = 0; a < 2; ++a)
#pragma unroll
            for (int b = 0; b < 2; ++b)
#pragma unroll
                for (int m = 0; m < 4; ++m)
#pragma unroll
                    for (int n = 0; n < 2; ++n) acc[a][b][m][n] = (f32x4){0.f, 0.f, 0.f, 0.f};
        }
        cur = nxt; cA = nA; cB = nB; ++ui;
        if constexpr (ALIGN_EPI) { if (wr == 1) PG8_BAR; }
    }
    PG8_WAIT_V(0);
    if constexpr (!ALIGN_EPI) { if (wr == 0) PG8_BAR; }
    PG8_BAR;
    if constexpr (Epi::AFTER_DRAIN) { E.fused(acc, cur, wr, wc, fr, fq, lds, wid, lane); S.done(cur); }
#undef PG8_SA
#undef PG8_SB
#undef PG8_STAGE
#undef PG8_LDA
#undef PG8_LDB
#undef PG8_MMA
#undef PG8_WAIT_V
#undef PG8_WAIT_L
#undef PG8_BAR
#undef PG8_SCHED
}
}

#define LAS __attribute__((address_space(3)))
typedef unsigned short bf16;
typedef float f32x4 __attribute__((ext_vector_type(4)));
typedef float f32x16 __attribute__((ext_vector_type(16)));
typedef short bf16x8 __attribute__((ext_vector_type(8)));
typedef short s16x4 __attribute__((ext_vector_type(4)));
typedef unsigned u32x4 __attribute__((ext_vector_type(4)));
typedef unsigned u32x2 __attribute__((ext_vector_type(2)));

constexpr int DM = 1024, NB = 8, SEQ = 8192, DEPTH = 4, MROWS = NB * SEQ, DFF = 2816, INW = 8192, NMOD = 9 * DM;
constexpr int NWAVES = 8, NTHR = 512;
constexpr float NORM_EPS = 1e-6f, LOG2E = 1.4426950408889634f;
constexpr size_t MiB = 1u << 20;
constexpr size_t WS_CTL = 0;
constexpr size_t WS_MOD = 1 * MiB;
constexpr size_t WS_WT = 4 * MiB;
constexpr size_t W_UPA = 0, W_DNA = W_UPA + (size_t)2 * DFF * DM, W_UPB = W_DNA + (size_t)DM * DFF, W_DNB = W_UPB + (size_t)2 * DFF * DM,
                 W_IN = W_DNB + (size_t)DM * DFF, W_RET = W_IN + (size_t)INW * DM, W_DIF = W_RET + (size_t)DM * DM, W_OUT = W_DIF + (size_t)DM * DM, W_END = W_OUT + (size_t)DM * DM;
constexpr size_t WS_H = 64 * MiB;
constexpr size_t ACT = (size_t)MROWS * DM * 2;
constexpr size_t WS_B0 = 192 * MiB;
constexpr size_t WS_HID = WS_B0;
constexpr size_t WS_END = WS_B0 + 6 * ACT;
static_assert(WS_WT + W_END * 2 <= WS_H && WS_END <= 1024 * MiB, "d_ws map");

struct Args { const float* in[18]; float* out; unsigned char* ws; };

__device__ __forceinline__ float shx(float v, int m, int lane) { return __int_as_float(__builtin_amdgcn_ds_bpermute((lane ^ m) << 2, __float_as_int(v))); }
__device__ __forceinline__ float wave_sum(float v, int lane) {
#pragma unroll
    for (int o = 1; o < 64; o <<= 1) v += shx(v, o, lane);
    return v;
}
__device__ __forceinline__ unsigned f2bf(float f) { unsigned u = __float_as_uint(f); return (u + 0x7fffu + ((u >> 16) & 1u)) >> 16; }
__device__ __forceinline__ unsigned pk2(float lo, float hi) { return pg8::cvt_pk_bf16(lo, hi); }
typedef __bf16 bf16x2_cv __attribute__((ext_vector_type(2))); typedef float f32x2_cv __attribute__((ext_vector_type(2)));
__device__ __forceinline__ unsigned pk2v(float lo, float hi) { f32x2_cv v = {lo, hi}; bf16x2_cv b = __builtin_convertvector(v, bf16x2_cv); return __builtin_bit_cast(unsigned, b); }
__device__ __forceinline__ float bflo(unsigned w) { return __uint_as_float(w << 16); }
__device__ __forceinline__ float bfhi(unsigned w) { return __uint_as_float(w & 0xffff0000u); }
__device__ __forceinline__ float sgpr_f(float v) { return __int_as_float(__builtin_amdgcn_readfirstlane(__float_as_int(v))); }
__device__ __forceinline__ int launder(int v) { asm volatile("" : "+v"(v)); return v; }
#define LDS_WAIT() asm volatile("s_waitcnt lgkmcnt(0)" ::: "memory")
#define LDS_BARRIER() do { asm volatile("s_waitcnt lgkmcnt(0)" ::: "memory"); __builtin_amdgcn_s_barrier(); asm volatile("" ::: "memory"); } while (0)
#define MFMA32(a, b, c) __builtin_amdgcn_mfma_f32_32x32x16_bf16((a), (b), (c), 0, 0, 0)
__device__ __forceinline__ int crow(int r, int hi) { return (r & 3) + 8 * (r >> 2) + 4 * hi; }
typedef short v4i16_t __attribute__((ext_vector_type(4)));
__device__ __forceinline__ s16x4 tr_read(const LAS unsigned char* p) { return __builtin_bit_cast(s16x4, __builtin_amdgcn_ds_read_tr16_b64_v4i16((LAS v4i16_t*)p)); }
__device__ __forceinline__ bf16x8 cat8(s16x4 lo, s16x4 hi) { return (bf16x8){lo[0], lo[1], lo[2], lo[3], hi[0], hi[1], hi[2], hi[3]}; }
__device__ __forceinline__ bf16x8 pack8v(const f32x16& x, int s) {
    u32x4 p; p.x = pk2v(x[8 * s], x[8 * s + 1]); p.y = pk2v(x[8 * s + 2], x[8 * s + 3]); p.z = pk2v(x[8 * s + 4], x[8 * s + 5]); p.w = pk2v(x[8 * s + 6], x[8 * s + 7]);
    return __builtin_bit_cast(bf16x8, p);
}
__device__ __forceinline__ bf16x8 pack8(const f32x16& x, int s) {
    u32x4 p; p.x = pk2(x[8 * s], x[8 * s + 1]); p.y = pk2(x[8 * s + 2], x[8 * s + 3]); p.z = pk2(x[8 * s + 4], x[8 * s + 5]); p.w = pk2(x[8 * s + 6], x[8 * s + 7]);
    return __builtin_bit_cast(bf16x8, p);
}

template <bool UPPERM>
__device__ __forceinline__ void transpose_item(const float* W, int K, int N, bf16* WT, LAS float* scr, int item, int lane) {
    const int nblk = N / 32, kb = item / nblk, nb = item % nblk, k0 = 64 * kb, n0 = 32 * nb;
#pragma unroll 8
    for (int i = 0; i < 32; ++i) { const int kk = 2 * i + (lane >> 5); scr[kk * 33 + (lane & 31)] = W[(size_t)(k0 + kk) * N + n0 + (lane & 31)]; }
    LDS_WAIT(); asm volatile("" ::: "memory");
    int d0 = n0;
    if (UPPERM) { const int half = n0 / DFF, j = n0 % DFF; d0 = (j / 128) * 256 + half * 128 + (j % 128); }
    const int c = lane & 7;
#pragma unroll
    for (int j = 0; j < 4; ++j) { const int n = (lane >> 3) + 8 * j; const LAS float* s = scr + (8 * c) * 33 + n;
        u32x4 o; o.x = pk2(s[0 * 33], s[1 * 33]); o.y = pk2(s[2 * 33], s[3 * 33]); o.z = pk2(s[4 * 33], s[5 * 33]); o.w = pk2(s[6 * 33], s[7 * 33]);
        *(u32x4*)(WT + (size_t)(d0 + n) * K + k0 + 8 * c) = o; }
    LDS_WAIT(); asm volatile("" ::: "memory");
}
__device__ __forceinline__ void convert_weights(const Args& a, int l, LAS unsigned char* lds, int gw, int ngw, int wave, int lane) {
    lane = launder(lane);
    LAS float* scr = (LAS float*)(lds + wave * 16384);
    bf16* WT = (bf16*)(a.ws + WS_WT);
    const float* up = a.in[5] + (size_t)l * 2 * DM * 2 * DFF; const float* dn = a.in[6] + (size_t)l * 2 * DFF * DM;
    const float* win = a.in[7] + (size_t)l * DM * INW; const float* wr = a.in[14] + (size_t)l * DM * DM; const float* wd = a.in[15] + (size_t)l * DM * DM; const float* wo = a.in[16] + (size_t)l * DM * DM;
    constexpr int I_UP = (DM / 64) * (2 * DFF / 32), I_DN = (DFF / 64) * (DM / 32), I_IN = (DM / 64) * (INW / 32), I_SQ = (DM / 64) * (DM / 32);
    constexpr int NITEMS = 2 * I_UP + 2 * I_DN + I_IN + 3 * I_SQ;
    for (int it = gw; it < NITEMS; it += ngw) {
        int r = it;
        if (r < I_UP) { transpose_item<true>(up, DM, 2 * DFF, WT + W_UPA, scr, r, lane); continue; } r -= I_UP;
        if (r < I_UP) { transpose_item<true>(up + (size_t)DM * 2 * DFF, DM, 2 * DFF, WT + W_UPB, scr, r, lane); continue; } r -= I_UP;
        if (r < I_DN) { transpose_item<false>(dn, DFF, DM, WT + W_DNA, scr, r, lane); continue; } r -= I_DN;
        if (r < I_DN) { transpose_item<false>(dn + (size_t)DFF * DM, DFF, DM, WT + W_DNB, scr, r, lane); continue; } r -= I_DN;
        if (r < I_IN) { transpose_item<false>(win, DM, INW, WT + W_IN, scr, r, lane); continue; } r -= I_IN;
        if (r < I_SQ) { transpose_item<false>(wr, DM, DM, WT + W_RET, scr, r, lane); continue; } r -= I_SQ;
        if (r < I_SQ) { transpose_item<false>(wd, DM, DM, WT + W_DIF, scr, r, lane); continue; } r -= I_SQ;
        transpose_item<false>(wo, DM, DM, WT + W_OUT, scr, r, lane);
    }
}
__device__ __forceinline__ void ada_phase(const Args& a, LAS unsigned char* lds, int wave, int lane) {
    lane = launder(lane);
    LAS float* sc = (LAS float*)lds; LAS float* part = (LAS float*)(lds + 32768);
    const float* c = a.in[1];
    for (int i = wave * 64 + lane; i < NB * DM; i += NTHR) { const float v = c[i]; sc[i] = v * pg8::sigmoid_f(v); }
    __syncthreads();
    float* mod = (float*)(a.ws + WS_MOD);
    constexpr int NIT = DEPTH * (NMOD / 64);
    for (int it = blockIdx.x; it < NIT; it += gridDim.x) {
        const int l = it / (NMOD / 64), j = (it % (NMOD / 64)) * 64 + lane;
        const float* w = a.in[2] + (size_t)l * DM * NMOD + j;
        float acc[NB];
#pragma unroll
        for (int b = 0; b < NB; ++b) acc[b] = 0.f;
        const int k0 = wave * 128;
#pragma unroll 8
        for (int k = 0; k < 128; ++k) { const float wv = w[(size_t)(k0 + k) * NMOD];
#pragma unroll
            for (int b = 0; b < NB; ++b) acc[b] += sc[b * DM + k0 + k] * wv; }
#pragma unroll
        for (int b = 0; b < NB; ++b) part[(wave * NB + b) * 64 + lane] = acc[b];
        __syncthreads();
        { const int b = wave; float s = a.in[3][(size_t)l * NMOD + j];
#pragma unroll
            for (int w8 = 0; w8 < 8; ++w8) s += part[(w8 * NB + b) * 64 + lane];
            mod[((size_t)l * NB + b) * NMOD + j] = s; }
        __syncthreads();
    }
}
template <int NR>
__device__ __forceinline__ void norm_mod_rows(const float* x, bf16* Hout, const float* const* mbp, const float* nw, const int* rows, int lane) {
    f32x4 v[NR][4]; float ss[NR];
#pragma unroll
    for (int r = 0; r < NR; ++r) { const f32x4* xr = (const f32x4*)(x + (size_t)rows[r] * DM) + lane;
#pragma unroll
        for (int j = 0; j < 4; ++j) v[r][j] = xr[64 * j]; }
#pragma unroll
    for (int r = 0; r < NR; ++r) { float s = 0.f;
#pragma unroll
        for (int j = 0; j < 4; ++j) s += (v[r][j].x * v[r][j].x + v[r][j].y * v[r][j].y) + (v[r][j].z * v[r][j].z + v[r][j].w * v[r][j].w);
        ss[r] = s; }
#pragma unroll
    for (int o = 1; o < 64; o <<= 1)
#pragma unroll
        for (int r = 0; r < NR; ++r) ss[r] += shx(ss[r], o, lane);
#pragma unroll
    for (int r = 0; r < NR; ++r) { const float rstd = 1.0f / sqrtf(ss[r] * (1.f / DM) + NORM_EPS); const float* shift = mbp[r]; const float* scale = mbp[r] + DM;
        u32x2* o8 = (u32x2*)(Hout + (size_t)rows[r] * DM) + lane;
#pragma unroll
        for (int j = 0; j < 4; ++j) { const int c4 = lane + 64 * j; const f32x4 w = ((const f32x4*)nw)[c4], sc = ((const f32x4*)scale)[c4], sh = ((const f32x4*)shift)[c4];
            const f32x4 o = v[r][j] * rstd * w * (sc + 1.0f) + sh; u32x2 p; p.x = pk2(o.x, o.y); p.y = pk2(o.z, o.w); o8[64 * j] = p; } }
}
__device__ __forceinline__ void norm_phase(const Args& a, const float* x, int l, int sub, int gw, int ngw, int lane) {
    lane = launder(lane);
    bf16* H = (bf16*)(a.ws + WS_H); const float* mod = (const float*)(a.ws + WS_MOD); const float* nw = a.in[4] + ((size_t)l * 3 + sub) * DM;
    constexpr int NR = 4;
    for (int m = gw; m < MROWS; m += NR * ngw) { int rows[NR]; const float* mbp[NR];
#pragma unroll
        for (int r = 0; r < NR; ++r) { rows[r] = m + r * ngw; if (rows[r] >= MROWS) rows[r] = m; mbp[r] = mod + ((size_t)l * NB + (rows[r] >> 13)) * NMOD + sub * 3 * DM; }
        norm_mod_rows<NR>(x, H, mbp, nw, rows, lane); }
}
__device__ __forceinline__ void final_norm_phase(const Args& a, int gw, int ngw, int lane) {
    lane = launder(lane);
    const float* fw = a.in[17];
#ifdef DBG_CHECK
    const float dbgs = 1.0f + (float)((const unsigned*)(a.ws + WS_CTL))[32];
#else
    const float dbgs = 1.0f;
#endif
    for (int m = gw; m < MROWS; m += ngw) { f32x4* xr = (f32x4*)(a.out + (size_t)m * DM) + lane;
        f32x4 v[4]; float s = 0.f;
#pragma unroll
        for (int j = 0; j < 4; ++j) { v[j] = xr[64 * j]; s += (v[j].x * v[j].x + v[j].y * v[j].y) + (v[j].z * v[j].z + v[j].w * v[j].w); }
        const float rstd = 1.0f / sqrtf(wave_sum(s, lane) * (1.f / DM) + NORM_EPS);
#pragma unroll
        for (int j = 0; j < 4; ++j) xr[64 * j] = v[j] * (rstd * dbgs) * ((const f32x4*)fw)[lane + 64 * j]; }
}

constexpr int R_Q = 0, R_K = R_Q + 64 * 272, R_QD = R_K + 64 * 272, R_KD = R_QD + 64 * 272, R_SC = R_KD + 64 * 320, R_V = R_SC + 64 * 144, R_DEC = R_V + 64 * 576, R_END = R_DEC + 256;
static_assert(R_END <= 131072 && 64 * 1040 <= R_DEC, "retention LDS");
__device__ __forceinline__ void retention_unit(const Args& a, int l, int b, int h, LAS unsigned char* lds, const int wave_s, const bool dummy = false) {
    asm volatile("" : "+s"(h));
    const int lane = hw_lane(), wave = wave_s, tid = wave_s * 64 + lane, r32 = lane & 31, hh = lane >> 5;
    const int q4 = (lane & 15) >> 2, p4 = lane & 3, g1 = (lane >> 4) & 1;
    const bf16* RQK = (const bf16*)(a.ws + WS_B0); const bf16* RV = (const bf16*)(a.ws + WS_B0 + ACT); bf16* RG = (bf16*)(a.ws + WS_B0 + 2 * ACT);
    const float* gn = a.in[8] + (size_t)l * DM + h * 256;
    const float lg = sgpr_f(log2f(1.0f - exp2f(-5.0f - (float)h)));
    const float sc_qk = 0.08838834764831845f;
    const float cdec = sgpr_f(exp2f(lg * 64.f));
    const size_t row0 = (size_t)b * SEQ;
    f32x16 S[4];
#pragma unroll
    for (int i = 0; i < 4; ++i) S[i] = f32x16{};
    u32x4 pq[2], pk[2], pv[4]; u32x2 prg[8];
    const int er = tid >> 3, es = tid & 7;
#ifdef USE_RSB
#define RSB() __builtin_amdgcn_sched_barrier(0)
#else
#define RSB() do {} while (0)
#endif
#define R_PREFETCH(ci) do { const size_t t0 = row0 + (size_t)(ci) * 64; \
        _Pragma("unroll") for (int i = 0; i < 2; ++i) { const int idx = tid + 512 * i, rr = idx >> 4, ch = idx & 15; \
            pq[i] = *(const u32x4*)(RQK + (t0 + rr) * DM + h * 128 + ch * 8); pk[i] = *(const u32x4*)(RQK + (t0 + rr) * DM + 512 + h * 128 + ch * 8); } \
        _Pragma("unroll") for (int i = 0; i < 4; ++i) { const int idx = tid + 512 * i, rr = idx >> 5, ch = idx & 31; pv[i] = *(const u32x4*)(RV + (t0 + rr) * DM + h * 256 + ch * 8); } } while (0)
#define R_STORE() do { \
        _Pragma("unroll") for (int i = 0; i < 2; ++i) { const int idx = tid + 512 * i, rr = idx >> 4, ch = idx & 15; \
            *(LAS u32x4*)(lds + R_Q + rr * 272 + ch * 16) = pq[i]; *(LAS u32x4*)(lds + R_K + rr * 272 + ch * 16) = pk[i]; \
            const float fqd = exp2f(lg * (float)rr); u32x4 qd; \
            qd.x = pk2(bflo(pq[i].x) * fqd, bfhi(pq[i].x) * fqd); qd.y = pk2(bflo(pq[i].y) * fqd, bfhi(pq[i].y) * fqd); qd.z = pk2(bflo(pq[i].z) * fqd, bfhi(pq[i].z) * fqd); qd.w = pk2(bflo(pq[i].w) * fqd, bfhi(pq[i].w) * fqd); \
            *(LAS u32x4*)(lds + R_QD + rr * 272 + ch * 16) = qd; \
            const float f = sc_qk * exp2f(lg * (float)(64 - rr)); u32x4 kd; \
            kd.x = pk2(bflo(pk[i].x) * f, bfhi(pk[i].x) * f); kd.y = pk2(bflo(pk[i].y) * f, bfhi(pk[i].y) * f); kd.z = pk2(bflo(pk[i].z) * f, bfhi(pk[i].z) * f); kd.w = pk2(bflo(pk[i].w) * f, bfhi(pk[i].w) * f); \
            *(LAS u32x4*)(lds + R_KD + rr * 320 + ch * 16) = kd; } \
        _Pragma("unroll") for (int i = 0; i < 4; ++i) { const int idx = tid + 512 * i, rr = idx >> 5, ch = idx & 31; *(LAS u32x4*)(lds + R_V + rr * 576 + ch * 16) = pv[i]; } } while (0)
    R_PREFETCH(0);
    if (tid < 64) *(LAS float*)(lds + R_DEC + tid * 4) = sc_qk * exp2f(lg * (float)tid);
    R_STORE();
    LDS_BARRIER();
    for (int ci = 0; ci < SEQ / 64; ++ci) {
        const size_t t0 = row0 + (size_t)ci * 64;
        float lgl = lg;
#ifdef LGL
        asm volatile("" : "+v"(lgl));
#endif
        if (ci + 1 < SEQ / 64) R_PREFETCH(ci + 1);
#ifndef RG_LATE
#pragma unroll
        for (int j = 0; j < 8; ++j) prg[j] = *(const u32x2*)(RG + (t0 + er) * DM + h * 256 + 4 * (es + 8 * j));
#endif
        RSB();
        if (wave < 4) {
            const int qb = wave >> 1, kb = wave & 1; f32x16 x = f32x16{};
#pragma unroll
            for (int ks = 0; ks < 8; ++ks) { const bf16x8 af = *(const LAS bf16x8*)(lds + R_Q + (32 * qb + r32) * 272 + (16 * ks + 8 * hh) * 2);
                const bf16x8 bfr = *(const LAS bf16x8*)(lds + R_K + (32 * kb + r32) * 272 + (16 * ks + 8 * hh) * 2); x = MFMA32(af, bfr, x); }
#pragma unroll
            for (int i = 0; i < 16; ++i) { const int q = 32 * qb + crow(i, hh), k = 32 * kb + r32; const int d = q > k ? q - k : k - q;
                const float v = x[i] * *(const LAS float*)(lds + R_DEC + d * 4); *(LAS unsigned short*)(lds + R_SC + q * 144 + k * 2) = (unsigned short)f2bf(v); }
        }
        RSB();
        f32x16 y[2]; y[0] = f32x16{}; y[1] = f32x16{};
#pragma unroll
        for (int dkb = 0; dkb < 4; ++dkb)
#pragma unroll
            for (int s = 0; s < 2; ++s) { const bf16x8 sp = pack8(S[dkb], s);
#pragma unroll
                for (int qb = 0; qb < 2; ++qb) { const LAS unsigned char* qp = lds + R_QD + (32 * qb + r32) * 272 + (32 * dkb + 16 * s + 4 * hh) * 2;
                    const s16x4 lo = *(const LAS s16x4*)qp, hi = *(const LAS s16x4*)(qp + 16); y[qb] = MFMA32(cat8(lo, hi), sp, y[qb]); } }
        RSB();
        LDS_BARRIER();
        bf16x8 vf[4];
#pragma unroll
        for (int ks = 0; ks < 4; ++ks) { const LAS unsigned char* vp = lds + R_V + (16 * ks + 8 * hh + q4) * 576 + (32 * wave + 16 * g1) * 2 + 8 * p4; vf[ks] = cat8(tr_read(vp), tr_read(vp + 4 * 576)); }
#pragma unroll
        for (int ks = 0; ks < 4; ++ks)
#pragma unroll
            for (int qb = 0; qb < 2; ++qb) { const bf16x8 af = *(const LAS bf16x8*)(lds + R_SC + (32 * qb + r32) * 144 + (16 * ks + 8 * hh) * 2); y[qb] = MFMA32(af, vf[ks], y[qb]); }
        RSB();
#pragma unroll
        for (int dkb = 0; dkb < 4; ++dkb) {
#pragma unroll
            for (int i = 0; i < 16; ++i) S[dkb][i] *= cdec;
#pragma unroll
            for (int ks = 0; ks < 4; ++ks) { const LAS unsigned char* kp = lds + R_KD + (16 * ks + 8 * hh + q4) * 320 + (32 * dkb + 16 * g1) * 2 + 8 * p4;
                S[dkb] = MFMA32(cat8(tr_read(kp), tr_read(kp + 4 * 320)), vf[ks], S[dkb]); } }
        LDS_BARRIER();
#ifdef RG_LATE
#pragma unroll
        for (int j = 0; j < 8; ++j) prg[j] = *(const u32x2*)(RG + (t0 + er) * DM + h * 256 + 4 * (es + 8 * j));
#endif
#pragma unroll
        for (int qb = 0; qb < 2; ++qb)
#pragma unroll
            for (int i = 0; i < 16; ++i) *(LAS float*)(lds + (32 * qb + crow(i, hh)) * 1040 + (32 * wave + r32) * 4) = y[qb][i];
        LDS_BARRIER();
        { f32x4 yv[8]; float ss = 0.f;
#pragma unroll
            for (int j = 0; j < 8; ++j) { yv[j] = *(const LAS f32x4*)(lds + er * 1040 + 16 * (es + 8 * j)); ss += (yv[j].x * yv[j].x + yv[j].y * yv[j].y) + (yv[j].z * yv[j].z + yv[j].w * yv[j].w); }
            ss += shx(ss, 1, lane); ss += shx(ss, 2, lane); ss += shx(ss, 4, lane);
            const float rstd = 1.0f / sqrtf(ss * (1.f / 256.f) + NORM_EPS);
#pragma unroll
            for (int j = 0; j < 8; ++j) { const int c = 4 * (es + 8 * j); const f32x4 w = *(const f32x4*)(gn + c);
                const float g0 = bflo(prg[j].x), g1v = bfhi(prg[j].x), g2 = bflo(prg[j].y), g3 = bfhi(prg[j].y);
                u32x2 o; o.x = pk2(yv[j].x * rstd * w.x * g0 * pg8::sigmoid_f(g0), yv[j].y * rstd * w.y * g1v * pg8::sigmoid_f(g1v));
                o.y = pk2(yv[j].z * rstd * w.z * g2 * pg8::sigmoid_f(g2), yv[j].w * rstd * w.w * g3 * pg8::sigmoid_f(g3));
                if (!dummy || rstd == -12345.f) *(u32x2*)(RG + (t0 + er) * DM + h * 256 + c) = o; } }
        LDS_BARRIER();
        if (ci + 1 < SEQ / 64) R_STORE();
        LDS_BARRIER();
    }
#undef R_PREFETCH
#undef R_STORE
}

constexpr int A_KS = 272, A_VS = 320, A_KB = 64 * A_KS, A_VB = 64 * A_VS, A_BUF = A_KB + A_VB, A_X = 0;
static_assert(2 * A_BUF <= 131072 && 4 * 64 * 64 * 4 <= 131072, "attention LDS");
__device__ __forceinline__ void attn_unit(const Args& a, int l, int b, int h, int qb, float lam, float post, LAS unsigned char* lds, const int wave_s, const bool dummy = false) {
    asm volatile("" : "+s"(h));
    const int lane = hw_lane(), wave = wave_s, tid = wave_s * 64 + lane, r32 = lane & 31, hh = lane >> 5;
    const int q4 = (lane & 15) >> 2, p4 = lane & 3, g1 = (lane >> 4) & 1;
    const int sub = wave >> 2, wq = wave & 3;
    bf16* DQ = (bf16*)(a.ws + WS_B0 + 3 * ACT); const bf16* DK = (const bf16*)(a.ws + WS_B0 + 4 * ACT); const bf16* DV = (const bf16*)(a.ws + WS_B0 + 5 * ACT);
    const size_t row0 = (size_t)b * SEQ; const int q0 = qb * 128;
    const int NT = 2 * qb + 2;
    const float sl2 = sgpr_f(exp2f(-(float)(h + 1)) * LOG2E);
    bf16x8 qf[4];
    { const bf16* qp = DQ + (row0 + q0 + 32 * wq + r32) * DM + h * 128 + sub * 64 + 8 * hh;
#pragma unroll
        for (int ks = 0; ks < 4; ++ks) qf[ks] = *(const bf16x8*)(qp + 16 * ks); }
    u32x4 pk[2], pv[2];
#define A_PREFETCH(t) do { const size_t t0 = row0 + (size_t)(t) * 64; \
        _Pragma("unroll") for (int i = 0; i < 2; ++i) { const int idx = tid + 512 * i, rr = idx >> 4, ch = idx & 15; \
            pk[i] = *(const u32x4*)(DK + (t0 + rr) * DM + h * 128 + ch * 8); pv[i] = *(const u32x4*)(DV + (t0 + rr) * DM + h * 128 + ch * 8); } } while (0)
#define A_STORE(bufo) do { \
        _Pragma("unroll") for (int i = 0; i < 2; ++i) { const int idx = tid + 512 * i, rr = idx >> 4, ch = idx & 15; \
            *(LAS u32x4*)(lds + (bufo) + rr * A_KS + ch * 16) = pk[i]; *(LAS u32x4*)(lds + (bufo) + A_KB + rr * A_VS + ch * 16) = pv[i]; } } while (0)
    f32x16 o[4];
#pragma unroll
    for (int i = 0; i < 4; ++i) o[i] = f32x16{};
    float mrun = -1e30f, lrun = 0.f;
    f32x16 cb;
#pragma unroll
    for (int i = 0; i < 16; ++i) cb[i] = sl2 * (float)((i & 3) + 8 * (i >> 2) + 4 * hh);
    const float c32 = sgpr_f(32.f * sl2);
    const int tq = NT - 2 + (wq >> 1);
    const float qin = (float)(32 * (wq & 1) + r32), qs = sl2 * qin;
    const int tmin = max(0, (int)ceilf((128.f * (float)qb - 63.f - 280.f / sl2) * (1.f / 64.f)));
    A_PREFETCH(NT - 1);
    A_STORE(0);
    LDS_BARRIER();
    for (int it = 0; it < NT - tmin; ++it) {
        const int t = NT - 1 - it, bufo = (it & 1) * A_BUF;
        if (t > tmin) A_PREFETCH(t - 1);
        if (t <= tq) {
            f32x16 s[2];
            s[0] = cb;
#pragma unroll
            for (int i = 0; i < 16; ++i) s[1][i] = cb[i] + c32;
#pragma unroll
            for (int kb = 0; kb < 2; ++kb)
#pragma unroll
                for (int ks = 0; ks < 4; ++ks) { const bf16x8 kf = *(const LAS bf16x8*)(lds + bufo + (32 * kb + r32) * A_KS + (sub * 64 + 16 * ks + 8 * hh) * 2); s[kb] = MFMA32(kf, qf[ks], s[kb]); }
            float ut = -sl2 * (qin + 64.f * (float)(tq - t));
            if (t == tq) {
                ut = 0.f;
#pragma unroll
                for (int i = 0; i < 16; ++i) { const float c0 = cb[i], c1 = cb[i] + c32; s[0][i] = s[0][i] - c0 - fabsf(qs - c0); s[1][i] = s[1][i] - c1 - fabsf(qs - c1); }
            }
            float mt = fmaxf(s[0][0], s[1][0]);
#pragma unroll
            for (int i = 1; i < 16; ++i) mt = fmaxf(fmaxf(mt, s[0][i]), s[1][i]);
            mt = fmaxf(mt, shx(mt, 32, lane)) + ut;
            if (__any(mt > mrun)) {
                const float mnew = fmaxf(mrun, mt), alpha = __builtin_amdgcn_exp2f(mrun - mnew); mrun = mnew; lrun *= alpha;
#pragma unroll
                for (int d4 = 0; d4 < 4; ++d4)
#pragma unroll
                    for (int i = 0; i < 16; ++i) o[d4][i] *= alpha;
            }
            const float ml = mrun - ut;
            float ps = 0.f;
#pragma unroll
            for (int kb = 0; kb < 2; ++kb)
#pragma unroll
                for (int i = 0; i < 16; ++i) { s[kb][i] = __builtin_amdgcn_exp2f(s[kb][i] - ml); ps += s[kb][i]; }
            lrun += ps;
            __builtin_amdgcn_sched_barrier(0);
            {
                const LAS unsigned char* vbase = lds + bufo + A_KB + (4 * hh + q4) * A_VS + (16 * g1) * 2 + 8 * p4;
                bf16x8 vcur[4], vnxt[4];
#pragma unroll
                for (int d4 = 0; d4 < 4; ++d4) vcur[d4] = cat8(tr_read(vbase + 64 * d4), tr_read(vbase + 64 * d4 + 8 * A_VS));
#pragma unroll
                for (int g = 0; g < 4; ++g) {
                    if (g < 3) {
#pragma unroll
                        for (int d4 = 0; d4 < 4; ++d4) vnxt[d4] = cat8(tr_read(vbase + (g + 1) * 16 * A_VS + 64 * d4), tr_read(vbase + (g + 1) * 16 * A_VS + 64 * d4 + 8 * A_VS)); }
                    const bf16x8 pf = pack8v(s[g >> 1], g & 1);
#pragma unroll
                    for (int d4 = 0; d4 < 4; ++d4) o[d4] = MFMA32(vcur[d4], pf, o[d4]);
                    __builtin_amdgcn_sched_barrier(0);
#pragma unroll
                    for (int d4 = 0; d4 < 4; ++d4) vcur[d4] = vnxt[d4];
                }
            }
        }
        if (t > tmin) A_STORE(((it + 1) & 1) * A_BUF);
        LDS_BARRIER();
    }
    lrun += shx(lrun, 32, lane);
    const float rl = 1.0f / lrun;
    if (sub == 1) {
#pragma unroll
        for (int d4 = 0; d4 < 4; ++d4)
#pragma unroll
            for (int i = 0; i < 16; ++i) *(LAS float*)(lds + A_X + ((wq * 64 + d4 * 16 + i) * 64 + lane) * 4) = o[d4][i] * rl;
    }
    __syncthreads();
    if (sub == 0) {
        float ss = 0.f;
#pragma unroll
        for (int d4 = 0; d4 < 4; ++d4)
#pragma unroll
            for (int i = 0; i < 16; ++i) { const float v = o[d4][i] * rl - lam * *(const LAS float*)(lds + A_X + ((wq * 64 + d4 * 16 + i) * 64 + lane) * 4); o[d4][i] = v; ss += v * v; }
        ss += shx(ss, 32, lane);
        const float rstd = post / sqrtf(ss * (1.f / 128.f) + NORM_EPS);
        const float* sw = a.in[13] + (size_t)l * 128;
        bf16* op = DQ + (row0 + q0 + 32 * wq + r32) * DM + h * 128;
#pragma unroll
        for (int d4 = 0; d4 < 4; ++d4)
#pragma unroll
            for (int g = 0; g < 4; ++g) { const int dv = 32 * d4 + 8 * g + 4 * hh; const f32x4 w = *(const f32x4*)(sw + dv);
                u32x2 pkd; pkd.x = pk2(o[d4][4 * g] * rstd * w.x, o[d4][4 * g + 1] * rstd * w.y); pkd.y = pk2(o[d4][4 * g + 2] * rstd * w.z, o[d4][4 * g + 3] * rstd * w.w);
                if (!dummy || rstd == -12345.f) *(u32x2*)(op + dv) = pkd; }
    }
    __syncthreads();
#undef A_PREFETCH
#undef A_STORE
}


#define XB_TMO      128
#define XB_XCNT(j)  (256  + 64 * (j))
#define XB_XSUB(j)  (1280 + 64 * (j))
#define XB_XGEN(j)  (2304 + 64 * (j))
#define XB_TOP      3328
#define XB_TOPGEN   3392
#define XCD_BAR_WORDS 3456
#define XB_SPIN_CAP (1u << 24)

__device__ __forceinline__ unsigned xb_ld(unsigned* p)              { return __hip_atomic_load(p, __ATOMIC_RELAXED, __HIP_MEMORY_SCOPE_AGENT); }
__device__ __forceinline__ unsigned xb_add(unsigned* p, unsigned v) { return __hip_atomic_fetch_add(p, v, __ATOMIC_RELAXED, __HIP_MEMORY_SCOPE_AGENT); }
__device__ __forceinline__ unsigned xb_xcc_id() { return (unsigned)__builtin_amdgcn_s_getreg((3 << 11) | 20) & 0xFu; }
#define XB_SPIN(cond, bar) do { unsigned _sp = 0; while (cond) { __builtin_amdgcn_s_sleep(1); \
    if ((++_sp & 255u) == 0u) { if (xb_ld(&(bar)[XB_TMO])) break; if (_sp > XB_SPIN_CAP) { atomicAdd(&(bar)[XB_TMO], 1u); break; } } } } while (0)

struct XcdBarrier {
    unsigned* bar; unsigned x;
    volatile LAS unsigned* st;
};

__device__ __forceinline__ XcdBarrier xcd_barrier_post(unsigned* bar, volatile LAS unsigned* st, bool first) {
    XcdBarrier b; b.bar = bar; b.x = xb_xcc_id(); b.st = st;
    if (first) (void)xb_add(&bar[XB_XCNT(b.x)], 1u);
    return b;
}
__device__ __forceinline__ void xcd_barrier_complete(unsigned* bar, unsigned x, unsigned& nloc, unsigned& nx) {
    const unsigned G = gridDim.x * gridDim.y * gridDim.z;
    unsigned sum, cnt, mine, sp = 0u;
    for (;;) {
        sum = 0u; cnt = 0u; mine = 0u;
#pragma unroll
        for (unsigned j = 0; j < 16; ++j) { const unsigned c = xb_ld(&bar[XB_XCNT(j)]); sum += c; cnt += (c > 0u) ? 1u : 0u; mine = (j == x) ? c : mine; }
        if (sum == G) break;
        __builtin_amdgcn_s_sleep(1);
        if ((++sp & 255u) == 0u) { if (xb_ld(&bar[XB_TMO])) break; if (sp > XB_SPIN_CAP) { atomicAdd(&bar[XB_TMO], 1u); break; } }
    }
    nloc = mine > 0u ? mine : 1u; nx = cnt > 0u ? cnt : 1u;
}

__device__ __forceinline__ void xcd_barrier(const XcdBarrier& b, const bool first) {
    asm volatile("s_waitcnt vmcnt(0)" ::: "memory");
    __syncthreads();
    if (first) {
        unsigned* bar = b.bar;
        __builtin_amdgcn_s_waitcnt(0);
        unsigned nloc = b.st[0], nx = b.st[1];
        if (nloc == 0u) { xcd_barrier_complete(bar, b.x, nloc, nx); b.st[0] = nloc; b.st[1] = nx; }
        const unsigned old = xb_add(&bar[XB_XSUB(b.x)], 1u);
        const unsigned gen = old / nloc;
        if (old + 1u == (gen + 1u) * nloc) {
            __builtin_amdgcn_fence(__ATOMIC_RELEASE, "agent");
            asm volatile("s_waitcnt vmcnt(0)" ::: "memory");
            const unsigned og = xb_add(&bar[XB_TOP], 1u);
            const unsigned tg = og / nx;
            if (og + 1u == (tg + 1u) * nx) xb_add(&bar[XB_TOPGEN], 1u);
            else XB_SPIN(xb_ld(&bar[XB_TOPGEN]) == tg, bar);
            __builtin_amdgcn_fence(__ATOMIC_ACQUIRE, "agent");
            xb_add(&bar[XB_XGEN(b.x)], 1u);
            asm volatile("s_waitcnt vmcnt(0)" ::: "memory");
        } else {
            XB_SPIN(xb_ld(&bar[XB_XGEN(b.x)]) == gen, bar);
            __builtin_amdgcn_fence(__ATOMIC_ACQUIRE, "agent");
            asm volatile("s_waitcnt vmcnt(0)" ::: "memory");
        }
    }
    __syncthreads();
}

#define CG_SYNC() do { asm volatile("s_waitcnt vmcnt(0) lgkmcnt(0)" ::: "memory"); __syncthreads(); grid.sync(); \
    __builtin_amdgcn_fence(__ATOMIC_ACQUIRE, "agent"); asm volatile("s_waitcnt vmcnt(0)" ::: "memory"); __syncthreads(); } while (0)
#define IS_T0 (wave_s == 0 && hw_lane() == 0)
#define GRID_SYNC() xcd_barrier(xbar, IS_T0)
constexpr int CW_BAR = 4096;
typedef const __attribute__((address_space(4))) Args* KArgsPtr;
#define PHASE_BEGIN Args a; { KArgsPtr ka_ = (KArgsPtr)__builtin_amdgcn_kernarg_segment_ptr(); asm volatile("" : "+s"(ka_)); _Pragma("unroll") for (int i_ = 0; i_ < 18; ++i_) a.in[i_] = ka_->in[i_]; a.out = ka_->out; a.ws = ka_->ws; } \
    const int lane = hw_lane(), wave = wave_s, tid = wave_s * 64 + lane; const int G = gridDim.x, gw = blockIdx.x * NWAVES + wave, ngw = G * NWAVES; \
    unsigned* ctl = (unsigned*)(a.ws + WS_CTL); const float* mod = (const float*)(a.ws + WS_MOD); bf16* WT = (bf16*)(a.ws + WS_WT); bf16* H = (bf16*)(a.ws + WS_H); bf16* HID = (bf16*)(a.ws + WS_HID); bf16* B0 = (bf16*)(a.ws + WS_B0); \
    (void)tid; (void)lane; (void)wave; (void)G; (void)gw; (void)ngw; (void)ctl; (void)mod; (void)WT; (void)H; (void)HID; (void)B0;
#define GEMM_RUN(EPI, ...) do { pg8::StaticOrder S; S.init(MROWS, g.N, G, (int)blockIdx.x); EPI E{__VA_ARGS__}; pg8::gemm_phase<EPI, pg8::StaticOrder, true, true>(lds, g, S, E, wave_s); } while (0)

__global__ void __launch_bounds__(NTHR, 2) hybrid_fwd(Args args_unused) {
    extern __shared__ __attribute__((aligned(16))) unsigned char lds_raw[];
    LAS unsigned char* lds = (LAS unsigned char*)lds_raw;
    cg::grid_group grid = cg::this_grid();
    const int wave_s = __builtin_amdgcn_readfirstlane((int)threadIdx.x >> 6);
    LAS unsigned* qslot = (LAS unsigned*)(lds + 131072);

    {
        PHASE_BEGIN
        if (blockIdx.x == 0) { if (tid < 64) ctl[tid] = 0u; for (int i = tid; i < XCD_BAR_WORDS; i += NTHR) ctl[CW_BAR + i] = 0u; }
        ada_phase(a, lds, wave, lane);
        convert_weights(a, 0, lds, gw, ngw, wave, lane);
    }
    CG_SYNC();
    XcdBarrier xbar;
    {   PHASE_BEGIN
        volatile LAS unsigned* st = (volatile LAS unsigned*)(lds + 131072 + 16);
        if (tid < 2) st[tid] = 0u;
        __syncthreads();
        xbar = xcd_barrier_post(ctl + CW_BAR, st, tid == 0);
    }

    for (int l = 0; l < DEPTH; ++l) {
        {
            PHASE_BEGIN
            if (l > 0) convert_weights(a, l, lds, gw, ngw, wave, lane);
            norm_phase(a, (l == 0) ? a.in[0] : a.out, l, 0, gw, ngw, lane);
        }
        GRID_SYNC();
#ifdef UP_TWICE
        { PHASE_BEGIN pg8::Gemm g{H, WT + W_UPA, MROWS, 2 * DFF, DM}; GEMM_RUN(pg8::EpiSwiGLU, HID, DFF); }
        GRID_SYNC();
#endif
        { PHASE_BEGIN pg8::Gemm g{H, WT + W_UPA, MROWS, 2 * DFF, DM}; GEMM_RUN(pg8::EpiSwiGLU, HID, DFF); }
        GRID_SYNC();
        { PHASE_BEGIN pg8::Gemm g{HID, WT + W_DNA, MROWS, DM, DFF}; GEMM_RUN(pg8::EpiResid, (l == 0) ? a.in[0] : a.out, a.out, mod + (size_t)l * NB * NMOD + 0 * 3 * DM + 2 * DM, NMOD, 0.5f, DM); }
        GRID_SYNC();
        { PHASE_BEGIN norm_phase(a, a.out, l, 1, gw, ngw, lane); }
        GRID_SYNC();
        { PHASE_BEGIN pg8::Gemm g{H, WT + W_IN, MROWS, 6 * DM, DM}; GEMM_RUN(pg8::EpiBf<0>, B0, DM, DM, (size_t)MROWS * DM, 3, 0.125f * LOG2E, nullptr); }
        GRID_SYNC();
        {
            PHASE_BEGIN
#ifdef RET_TWICE
            if (blockIdx.x < 32) retention_unit(a, l, blockIdx.x >> 2, blockIdx.x & 3, lds, wave_s, true);
#endif
            if (blockIdx.x < 32) retention_unit(a, l, blockIdx.x >> 2, blockIdx.x & 3, lds, wave_s);
            const float s1 = wave_sum(a.in[9][l * 64 + lane] * a.in[10][l * 64 + lane], lane), s2 = wave_sum(a.in[11][l * 64 + lane] * a.in[12][l * 64 + lane], lane);
            const float lam_init = sgpr_f(0.8f - 0.6f * expf(-0.3f * (float)l)), lam = sgpr_f(expf(s1) - expf(s2) + lam_init);
#ifdef ATT_TWICE
            for (;;) {
                if (tid == 0) *qslot = atomicAdd(ctl + 8 + l, 1u);
                __syncthreads();
                const unsigned item = *qslot;
                __syncthreads();
                if (item >= 64u * 64u) break;
                const int qb = 63 - (int)(item >> 6), bh = (int)(item & 63u);
                attn_unit(a, l, bh >> 3, bh & 7, qb, lam, 1.0f - lam_init, lds, wave_s, true);
            }
#endif
            const int q0 = (int)(xb_xcc_id() & 7u);
            for (int k = 0; k < NB; ++k) {
                const int bq = (q0 + k) & 7;
                for (;;) {
                    if (tid == 0) *qslot = atomicAdd(ctl + l * NB + bq, 1u);
                    __syncthreads();
                    const unsigned item = *qslot;
                    __syncthreads();
                    if (item >= 8u * 64u) break;
                    attn_unit(a, l, bq, 7 - (int)(item >> 6), 63 - (int)(item & 63u), lam, 1.0f - lam_init, lds, wave_s);
                }
            }
        }
        GRID_SYNC();
        {
            PHASE_BEGIN pg8::Gemm g{H, WT + W_IN + (size_t)6 * DM * DM, MROWS, 2 * DM, DM}; GEMM_RUN(pg8::EpiBf<0>, B0, DM, DM, (size_t)4 * MROWS * DM, -1, 1.f, nullptr); }
        GRID_SYNC();
        {
            PHASE_BEGIN pg8::Gemm g{B0 + (size_t)2 * MROWS * DM, WT + W_RET, MROWS, DM, DM, B0 + (size_t)3 * MROWS * DM, WT + W_DIF};
            pg8::SegOrder S; S.init(MROWS, g.N, G, (int)blockIdx.x); pg8::EpiMerge E{B0 + (size_t)1 * MROWS * DM, DM, B0, B0 + (size_t)4 * MROWS * DM};
            pg8::gemm_phase<pg8::EpiMerge, pg8::SegOrder, true, true>(lds, g, S, E, wave_s); }
        GRID_SYNC();
        { PHASE_BEGIN pg8::Gemm g{B0 + (size_t)1 * MROWS * DM, WT + W_OUT, MROWS, DM, DM}; GEMM_RUN(pg8::EpiResid, a.out, a.out, mod + (size_t)l * NB * NMOD + 1 * 3 * DM + 2 * DM, NMOD, 1.0f, DM); }
        GRID_SYNC();
        { PHASE_BEGIN norm_phase(a, a.out, l, 2, gw, ngw, lane); }
        GRID_SYNC();
        { PHASE_BEGIN pg8::Gemm g{H, WT + W_UPB, MROWS, 2 * DFF, DM}; GEMM_RUN(pg8::EpiSwiGLU, HID, DFF); }
        GRID_SYNC();
        { PHASE_BEGIN pg8::Gemm g{HID, WT + W_DNB, MROWS, DM, DFF}; GEMM_RUN(pg8::EpiResid, a.out, a.out, mod + (size_t)l * NB * NMOD + 2 * 3 * DM + 2 * DM, NMOD, 0.5f, DM); }
        GRID_SYNC();
    }
#ifdef SYNC_PROBE
    for (int i = 0; i < 64; ++i) GRID_SYNC();
#endif
    { PHASE_BEGIN final_norm_phase(a, gw, ngw, lane); }
}

constexpr int LDS_BYTES = 147456;
extern "C" void kernel_launch(void* const* d_in, const int* in_sizes, int n_in, void* d_out, int out_size, void* d_ws, size_t ws_size, hipStream_t stream) {
    static int grid = 0;
    if (grid == 0) {
        if (n_in != 18 || ws_size < WS_END) { fprintf(stderr, "kernel_launch: unexpected n_in %d / ws_size %zu (need %zu)\n", n_in, ws_size, (size_t)WS_END); grid = -1; return; }
        int dev = 0, cus = 0, per_cu = 0;
        (void)hipGetDevice(&dev); (void)hipDeviceGetAttribute(&cus, hipDeviceAttributeMultiprocessorCount, dev);
        if (hipFuncSetAttribute((const void*)hybrid_fwd, hipFuncAttributeMaxDynamicSharedMemorySize, LDS_BYTES) != hipSuccess) { fprintf(stderr, "kernel_launch: hipFuncSetAttribute failed\n"); grid = -1; return; }
        if (hipOccupancyMaxActiveBlocksPerMultiprocessor(&per_cu, (const void*)hybrid_fwd, NTHR, LDS_BYTES) != hipSuccess || per_cu < 1) { fprintf(stderr, "kernel_launch: occupancy query says %d\n", per_cu); per_cu = 1; }
        (void)hipGetLastError();
        grid = cus * 1;
    }
    if (grid < 0) return;
    Args a{};
    for (int i = 0; i < 18; ++i) a.in[i] = (const float*)d_in[i];
    a.out = (float*)d_out; a.ws = (unsigned char*)d_ws;
    void* kargs[] = {&a};
    hipError_t e = hipLaunchCooperativeKernel((const void*)hybrid_fwd, dim3(grid), dim3(NTHR), kargs, LDS_BYTES, stream);
    if (e != hipSuccess) fprintf(stderr, "cooperative launch failed: %s (grid %d)\n", hipGetErrorString(e), grid);
}
```

```cpp
#define GATE_LOGITS 1
#include <hip/hip_runtime.h>
#include <hip/hip_cooperative_groups.h>
#include <cstdio>
#include <cstdint>
namespace cg = cooperative_groups;
#define USE_RSB 1
__device__ __forceinline__ int hw_lane() { int l = (int)__builtin_amdgcn_mbcnt_hi(~0u, __builtin_amdgcn_mbcnt_lo(~0u, 0u)); asm volatile("" : "+v"(l)); return l; }
namespace pg8 {
#define PG8_LAS __attribute__((address_space(3)))
typedef unsigned short bf16_t;
typedef short bf16x8 __attribute__((ext_vector_type(8)));
typedef float f32x4 __attribute__((ext_vector_type(4)));
typedef unsigned u32x4 __attribute__((ext_vector_type(4)));
constexpr int BM = 256, BK = 64, HALF = 128, HTB = HALF * BK * 2  , STAGE_BYTES = 8 * HTB, NXCD = 8, WGM = 8;

__host__ __device__ __forceinline__ int lds_byte(int r, int c) { const int st = (r >> 4) * 2 + (c >> 5), rr = r & 15, cc = c & 31, ob = rr * 64 + cc * 2; return st * 1024 + (ob ^ (((ob >> 9) & 1) << 5)); }
__host__ __device__ __forceinline__ void stage_rc(int b, int& R, int& C) { const int st = b / 1024, sb = b % 1024, swz = sb ^ (((sb >> 9) & 1) << 5); R = (st >> 1) * 16 + swz / 64; C = (st & 1) * 32 + (swz % 64) / 2; }
__host__ __device__ __forceinline__ int perm32(int rho) { const int n = rho >> 4, i = rho & 15; return 8 * (i >> 2) + 4 * n + (i & 3); }

struct Unit { int pm, pn, seg; };
struct Gemm { const bf16_t* A; const bf16_t* Bt; int M, N, K; const bf16_t* A2; const bf16_t* Bt2; const bf16_t* A3; const bf16_t* Bt3; const bf16_t* A4; const bf16_t* Bt4; };
__host__ __device__ __forceinline__ const bf16_t* seg_a(const Gemm& g, int sg) { return sg == 0 ? g.A : sg == 1 ? g.A2 : sg == 2 ? g.A3 : g.A4; }
__host__ __device__ __forceinline__ const bf16_t* seg_b(const Gemm& g, int sg) { return sg == 0 ? g.Bt : sg == 1 ? g.Bt2 : sg == 2 ? g.Bt3 : g.Bt4; }

struct StaticOrder {
    int nM, nN, nwg, G, c;
    __host__ __device__ void init(int M, int N, int G_, int c_) { nM = M / BM; nN = N / BM; nwg = nM * nN; G = G_; c = c_; }
    __host__ __device__ bool next(int i, Unit& u) const {
        const long L = (long)i * G + c; if (L >= nwg) return false;
        int wgid = (int)L; { const int q = nwg / NXCD, r = nwg % NXCD, xcd = wgid % NXCD, off = wgid / NXCD; wgid = (xcd < r ? xcd * (q + 1) : r * (q + 1) + (xcd - r) * q) + off; }
        const int nig = WGM * nN, gid = wgid / nig, fm = gid * WGM, gsz = (nM - fm) < WGM ? (nM - fm) : WGM;
        u.pm = fm + ((wgid % nig) % gsz); u.pn = (wgid % nig) / gsz; u.seg = 0; return true;
    }
    __device__ __forceinline__ void a_ready(const Unit&) const {}
    __device__ __forceinline__ void done(const Unit&) const {}
};
template <int LOG2SEG> struct SegOrderN {
    StaticOrder base;
    __host__ __device__ void init(int M, int N, int G_, int c_) { base.init(M, N, G_, c_); }
    __host__ __device__ bool next(int i, Unit& u) const { const bool ok = base.next(i >> LOG2SEG, u); u.seg = i & ((1 << LOG2SEG) - 1); return ok; }
    __device__ __forceinline__ void a_ready(const Unit&) const {}
    __device__ __forceinline__ void done(const Unit&) const {}
};
template <class E, class = void> struct epi_seg { static constexpr bool value = false; };
template <class E> struct epi_seg<E, decltype((void)E::SEG)> { static constexpr bool value = E::SEG; };
template <class E> __host__ __device__ __forceinline__ bool epi_keep(int sg) { if constexpr (epi_seg<E>::value) return E::keep_acc(sg); else return false; }


__device__ __forceinline__ unsigned cvt_pk_bf16(float lo, float hi) { unsigned r; asm volatile("v_cvt_pk_bf16_f32 %0, %1, %2" : "=v"(r) : "v"(lo), "v"(hi)); return r; }
typedef float f32x2 __attribute__((ext_vector_type(2)));

__device__ __forceinline__ float sigmoid_f(float v) { return __builtin_amdgcn_rcpf(1.0f + __builtin_amdgcn_exp2f(-1.4426950408889634f * v)); }
__device__ __forceinline__ float bf_lo(unsigned w) { return __uint_as_float(w << 16); }
__device__ __forceinline__ float bf_hi(unsigned w) { return __uint_as_float(w & 0xffff0000u); }

struct EpiSwiGLU {
    static constexpr bool PERM = true, AFTER_DRAIN = false;
    bf16_t* O; int ldc;
    __device__ __forceinline__ void operator()(const f32x4 (&acc)[2][2][4][2], const Unit& u, int wr, int wc, int fr, int fq) const {
        const int row0 = u.pm * BM + wr * 64 + fr, col0 = u.pn * HALF + wc * 32 + 8 * fq;
#pragma unroll
        for (int ai = 0; ai < 2; ++ai)
#pragma unroll
            for (int m = 0; m < 4; ++m) {
                bf16_t* rowp = O + (size_t)(row0 + ai * HALF + m * 16) * ldc + col0;
                float v[8];
#pragma unroll
                for (int n = 0; n < 2; ++n)
#pragma unroll
                    for (int e = 0; e < 4; ++e) { const float a = acc[ai][0][m][n][e], b = acc[ai][1][m][n][e]; v[4 * n + e] = a * sigmoid_f(a) * b; }
                u32x4 w; w.x = cvt_pk_bf16(v[0], v[1]); w.y = cvt_pk_bf16(v[2], v[3]); w.z = cvt_pk_bf16(v[4], v[5]); w.w = cvt_pk_bf16(v[6], v[7]);
                *(u32x4*)rowp = w;
            }
    }
};
struct EpiResid {
    static constexpr bool PERM = false, AFTER_DRAIN = false;
    const float* base; float* out; const float* gate; int gate_bstride; float coef; int ldc;
    __device__ __forceinline__ void operator()(const f32x4 (&acc)[2][2][4][2], const Unit& u, int wr, int wc, int fr, int fq) const {
        const int col0 = u.pn * BM + wc * 32 + 4 * fq;
        const float* g = gate + (size_t)(u.pm >> 5) * gate_bstride;
        f32x4 gv[2][2];
#pragma unroll
        for (int bj = 0; bj < 2; ++bj)
#pragma unroll
            for (int n = 0; n < 2; ++n) gv[bj][n] = *(const f32x4*)(g + col0 + bj * HALF + n * 16) * coef;
#pragma unroll
        for (int ai = 0; ai < 2; ++ai)
#pragma unroll
            for (int m = 0; m < 4; ++m) { const size_t off = (size_t)(u.pm * BM + ai * HALF + wr * 64 + m * 16 + fr) * ldc + col0;
#pragma unroll
                for (int bj = 0; bj < 2; ++bj)
#pragma unroll
                    for (int n = 0; n < 2; ++n) { const f32x4 bs = *(const f32x4*)(base + off + bj * HALF + n * 16); *(f32x4*)(out + off + bj * HALF + n * 16) = bs + gv[bj][n] * acc[ai][bj][m][n]; } }
    }
};
#ifdef GATE_LOGITS
#define GSIG(x) sigmoid_f(x)
#else
#define GSIG(x) (x)
#endif
template <int MODE> struct EpiBf {
    static constexpr bool PERM = true, AFTER_DRAIN = false;
    bf16_t* O; int ldc; int split_cols; size_t split_stride; int qt; float qscale; const bf16_t* G;
    __device__ __forceinline__ void operator()(const f32x4 (&acc)[2][2][4][2], const Unit& u, int wr, int wc, int fr, int fq) const {
        const int row0 = u.pm * BM + wr * 64 + fr; int colt = u.pn * BM; bf16_t* base = O; float sc = 1.f;
        if (MODE <= 1) { const int t = colt / split_cols; base += (size_t)t * split_stride; colt -= t * split_cols; if (MODE == 0 && t == qt) sc = qscale; }
        const int col0 = colt + wc * 32 + 8 * fq;
#pragma unroll
        for (int ai = 0; ai < 2; ++ai)
#pragma unroll
            for (int m = 0; m < 4; ++m) { const size_t roff = (size_t)(row0 + ai * HALF + m * 16) * ldc + col0;
#pragma unroll
                for (int bj = 0; bj < 2; ++bj) {
                    f32x4 v0 = acc[ai][bj][m][0], v1 = acc[ai][bj][m][1];
                    if (MODE == 0) { v0 = v0 * sc; v1 = v1 * sc; }
                    if (MODE == 1) {
#pragma unroll
                        for (int e = 0; e < 4; ++e) { v0[e] = sigmoid_f(v0[e]); v1[e] = sigmoid_f(v1[e]); } }
                    if (MODE >= 2) { const u32x4 g = *(const u32x4*)(G + roff + bj * HALF);
                        v0[0] *= GSIG(bf_lo(g.x)); v0[1] *= GSIG(bf_hi(g.x)); v0[2] *= GSIG(bf_lo(g.y)); v0[3] *= GSIG(bf_hi(g.y)); v1[0] *= GSIG(bf_lo(g.z)); v1[1] *= GSIG(bf_hi(g.z)); v1[2] *= GSIG(bf_lo(g.w)); v1[3] *= GSIG(bf_hi(g.w)); }
                    if (MODE == 3) { const u32x4 t = *(const u32x4*)(base + roff + bj * HALF);
                        v0[0] += bf_lo(t.x); v0[1] += bf_hi(t.x); v0[2] += bf_lo(t.y); v0[3] += bf_hi(t.y); v1[0] += bf_lo(t.z); v1[1] += bf_hi(t.z); v1[2] += bf_lo(t.w); v1[3] += bf_hi(t.w); }
                    u32x4 w; w.x = cvt_pk_bf16(v0[0], v0[1]); w.y = cvt_pk_bf16(v0[2], v0[3]); w.z = cvt_pk_bf16(v1[0], v1[1]); w.w = cvt_pk_bf16(v1[2], v1[3]);
                    *(u32x4*)(base + roff + bj * HALF) = w; } }
    }
};
struct EpiMerge {
    static constexpr bool PERM = true, AFTER_DRAIN = false, SEG = true;
    __host__ __device__ static constexpr bool keep_acc(int sg) { return sg == 3; }
    bf16_t* O; int ldc; bf16_t* GR; bf16_t* GD;
    __device__ __forceinline__ void operator()(f32x4 (&acc)[2][2][4][2], const Unit& u, int wr, int wc, int fr, int fq) const {
        const int row0 = u.pm * BM + wr * 64 + fr, col0 = u.pn * BM + wc * 32 + 8 * fq;
#pragma unroll
        for (int ai = 0; ai < 2; ++ai)
#pragma unroll
            for (int m = 0; m < 4; ++m) { const size_t roff = (size_t)(row0 + ai * HALF + m * 16) * ldc + col0;
#pragma unroll
                for (int bj = 0; bj < 2; ++bj) {
                    if (u.seg < 2) {
                        float v[8];
#pragma unroll
                        for (int e = 0; e < 8; ++e) v[e] = __builtin_fmaxf(acc[ai][bj][m][e >> 2][e & 3], -3.0e38f);
                        u32x4 w; w.x = cvt_pk_bf16(v[0], v[1]); w.y = cvt_pk_bf16(v[2], v[3]); w.z = cvt_pk_bf16(v[4], v[5]); w.w = cvt_pk_bf16(v[6], v[7]);
                        *(u32x4*)((u.seg == 0 ? GR : GD) + roff + bj * HALF) = w;
                    } else {
                        const u32x4 gd = *(const u32x4*)(GD + roff + bj * HALF);
                        const float d[8] = {bf_lo(gd.x), bf_hi(gd.x), bf_lo(gd.y), bf_hi(gd.y), bf_lo(gd.z), bf_hi(gd.z), bf_lo(gd.w), bf_hi(gd.w)};
                        if (u.seg == 2) {
                            const u32x4 gr = *(const u32x4*)(GR + roff + bj * HALF);
                            const float r[8] = {bf_lo(gr.x), bf_hi(gr.x), bf_lo(gr.y), bf_hi(gr.y), bf_lo(gr.z), bf_hi(gr.z), bf_lo(gr.w), bf_hi(gr.w)};
#pragma unroll
                            for (int e = 0; e < 8; ++e) { const float ed = __builtin_amdgcn_exp2f(-1.4426950408889634f * d[e]), er = __builtin_amdgcn_exp2f(-1.4426950408889634f * r[e]);
                                acc[ai][bj][m][e >> 2][e & 3] *= (1.0f + ed) * __builtin_amdgcn_rcpf(1.0f + er); }
                        } else {
                            float v[8];
#pragma unroll
                            for (int e = 0; e < 8; ++e) v[e] = acc[ai][bj][m][e >> 2][e & 3] * sigmoid_f(d[e]);
                            u32x4 w; w.x = cvt_pk_bf16(v[0], v[1]); w.y = cvt_pk_bf16(v[2], v[3]); w.z = cvt_pk_bf16(v[4], v[5]); w.w = cvt_pk_bf16(v[6], v[7]);
                            *(u32x4*)(O + roff + bj * HALF) = w; }
                    }
                } }
    }
};


template <class Epi, class Sched, bool ALIGN_EPI = false, bool SP2 = false>
__device__ __forceinline__ void gemm_phase(PG8_LAS unsigned char* lds, const Gemm g, const Sched& S, const Epi& E, const int wave_s) {
    const int lane = hw_lane(), wid = wave_s, tid = wave_s * 64 + lane, wr = wid >> 2, wc = wid & 3, fr = lane & 15, fq = lane >> 4;
    const int K = g.K, nt = K / BK;
    unsigned voffA[2], voffB[2];
#pragma unroll
    for (int i = 0; i < 2; ++i) { int R, C; stage_rc(tid * 16 + i * 8192, R, C); const int Rb = Epi::PERM ? ((R & ~31) + perm32(R & 31)) : R;
        voffA[i] = (unsigned)(R * K + C) * 2u; voffB[i] = (unsigned)(Rb * K + C) * 2u; }
    const size_t kstep = (size_t)(BK * 2);
    const size_t hstep = (size_t)HALF * K * 2;
    const size_t tstep = 2 * hstep;
    const unsigned ldsw = (unsigned)wid * 1024u;
    const int aoff = lds_byte(wr * 64 + fr, fq * 8), boff = lds_byte(wc * 32 + fr, fq * 8);
#define PG8_SA(b, h) (((b) * 2 + (h)) * HTB)
#define PG8_SB(b, h) ((4 + (b) * 2 + (h)) * HTB)
#define PG8_STAGE(bufoff, gbase, voff) do { _Pragma("unroll") for (int _i = 0; _i < 2; ++_i) \
        __builtin_amdgcn_global_load_lds((const unsigned*)((const char*)(gbase) + (voff)[_i]), (PG8_LAS unsigned*)(lds + (bufoff) + ldsw + _i * 8192), 16, 0, 0); } while (0)
#define PG8_LDA(dst, b, h) do { _Pragma("unroll") for (int m = 0; m < 4; ++m) _Pragma("unroll") for (int k = 0; k < 2; ++k) dst[m][k] = *(const PG8_LAS bf16x8*)(lds + PG8_SA(b, h) + aoff + m * 2048 + k * 1024); } while (0)
#define PG8_LDB(dst, b, h) do { _Pragma("unroll") for (int n = 0; n < 2; ++n) _Pragma("unroll") for (int k = 0; k < 2; ++k) dst[n][k] = *(const PG8_LAS bf16x8*)(lds + PG8_SB(b, h) + boff + n * 2048 + k * 1024); } while (0)
#define PG8_MMA(ai, bj, At, Bt) do { __builtin_amdgcn_s_setprio(1); _Pragma("unroll") for (int m = 0; m < 4; ++m) _Pragma("unroll") for (int n = 0; n < 2; ++n) _Pragma("unroll") for (int k = 0; k < 2; ++k) \
        acc[ai][bj][m][n] = __builtin_amdgcn_mfma_f32_16x16x32_bf16(Bt[n][k], At[m][k], acc[ai][bj][m][n], 0, 0, 0); __builtin_amdgcn_s_setprio(0); } while (0)
#define PG8_WAIT_V(n) asm volatile("s_waitcnt vmcnt(" #n ")" ::: "memory")
#define PG8_WAIT_L(n) asm volatile("s_waitcnt lgkmcnt(" #n ")" ::: "memory")
#define PG8_BAR __builtin_amdgcn_s_barrier()
#define PG8_SCHED __builtin_amdgcn_sched_barrier(0)
    Unit cur, nxt; int ui = 0;
    if (!S.next(0, cur)) return;
    f32x4 acc[2][2][4][2];
#pragma unroll
    for (int a = 0; a < 2; ++a)
#pragma unroll
        for (int b = 0; b < 2; ++b)
#pragma unroll
            for (int m = 0; m < 4; ++m)
#pragma unroll
                for (int n = 0; n < 2; ++n) acc[a][b][m][n] = (f32x4){0.f, 0.f, 0.f, 0.f};
    bf16x8 At[4][2], B0[2][2], B1[2][2];
    const char* cA = (const char*)seg_a(g, cur.seg) + (size_t)cur.pm * tstep; const char* cB = (const char*)seg_b(g, cur.seg) + (size_t)cur.pn * tstep;
    S.a_ready(cur);
    if constexpr (SP2) {
        PG8_STAGE(PG8_SB(0, 0), cB, voffB); PG8_STAGE(PG8_SB(0, 1), cB + hstep, voffB); PG8_STAGE(PG8_SA(0, 0), cA, voffA); PG8_STAGE(PG8_SA(0, 1), cA + hstep, voffA);
        if (wr == 1) PG8_BAR;
        PG8_WAIT_V(2); PG8_BAR;
        PG8_STAGE(PG8_SB(1, 0), cB + kstep, voffB); PG8_STAGE(PG8_SA(1, 0), cA + kstep, voffA); PG8_STAGE(PG8_SB(1, 1), cB + hstep + kstep, voffB);
        PG8_WAIT_V(6); PG8_BAR;
    } else {
        PG8_STAGE(PG8_SB(0, 0), cB, voffB); PG8_STAGE(PG8_SA(0, 0), cA, voffA); PG8_STAGE(PG8_SB(0, 1), cB + hstep, voffB); PG8_STAGE(PG8_SA(0, 1), cA + hstep, voffA);
        if (wr == 1) PG8_BAR;
        PG8_WAIT_V(4); PG8_BAR;
        PG8_STAGE(PG8_SB(1, 0), cB + kstep, voffB); PG8_STAGE(PG8_SA(1, 0), cA + kstep, voffA); PG8_STAGE(PG8_SB(1, 1), cB + hstep + kstep, voffB);
        PG8_WAIT_V(6); PG8_BAR;
    }
    for (;;) {
        const bool has_next = S.next(ui + 1, nxt);
        const char* nA = has_next ? (const char*)seg_a(g, nxt.seg) + (size_t)nxt.pm * tstep : cA; const char* nB = has_next ? (const char*)seg_b(g, nxt.seg) + (size_t)nxt.pn * tstep : cB;
        for (int t = 0; t < nt; t += 2) {
            const bool last = (t == nt - 2);
            const char* a1 = cA + (size_t)(t + 1) * kstep;
            const char* a2 = last ? nA : cA + (size_t)(t + 2) * kstep; const char* b2 = last ? nB : cB + (size_t)(t + 2) * kstep;
            const char* a3 = a2 + kstep; const char* b3 = b2 + kstep;
            if (last && has_next) S.a_ready(nxt);
            if constexpr (SP2) {
            PG8_LDB(B0, 0, 0); PG8_LDB(B1, 0, 1); PG8_SCHED; PG8_LDA(At, 0, 0); PG8_STAGE(PG8_SA(1, 1), a1 + hstep, voffA);
            PG8_WAIT_V(8); PG8_WAIT_L(0); PG8_BAR; PG8_MMA(0, 0, At, B0); PG8_MMA(0, 1, At, B1); PG8_BAR; PG8_SCHED;
            PG8_LDA(At, 0, 1); PG8_STAGE(PG8_SB(0, 0), b2, voffB); PG8_STAGE(PG8_SB(0, 1), b2 + hstep, voffB); PG8_STAGE(PG8_SA(0, 0), a2, voffA);
            PG8_WAIT_V(8); PG8_WAIT_L(0); PG8_BAR; PG8_MMA(1, 0, At, B0); PG8_MMA(1, 1, At, B1); PG8_BAR; PG8_SCHED;
            PG8_LDB(B0, 1, 0); PG8_LDB(B1, 1, 1); PG8_SCHED; PG8_LDA(At, 1, 0); PG8_STAGE(PG8_SA(0, 1), a2 + hstep, voffA);
            PG8_WAIT_V(8); PG8_WAIT_L(0); PG8_BAR; PG8_MMA(0, 0, At, B0); PG8_MMA(0, 1, At, B1); PG8_BAR; PG8_SCHED;
            PG8_LDA(At, 1, 1); PG8_STAGE(PG8_SB(1, 0), b3, voffB); PG8_STAGE(PG8_SB(1, 1), b3 + hstep, voffB); PG8_STAGE(PG8_SA(1, 0), a3, voffA);
            PG8_WAIT_V(8); PG8_WAIT_L(0); PG8_BAR; PG8_MMA(1, 0, At, B0); PG8_MMA(1, 1, At, B1); PG8_BAR; PG8_SCHED;
            } else {
            PG8_LDB(B0, 0, 0); PG8_SCHED; PG8_LDA(At, 0, 0); PG8_STAGE(PG8_SA(1, 1), a1 + hstep, voffA);
            PG8_WAIT_L(8); PG8_BAR; PG8_WAIT_L(0); PG8_MMA(0, 0, At, B0); PG8_BAR; PG8_SCHED;
            PG8_LDB(B1, 0, 1); PG8_STAGE(PG8_SB(0, 0), b2, voffB);
            PG8_BAR; PG8_WAIT_L(0); PG8_MMA(0, 1, At, B1); PG8_BAR;
            PG8_LDA(At, 0, 1); PG8_STAGE(PG8_SA(0, 0), a2, voffA);
            PG8_BAR; PG8_WAIT_L(0); PG8_MMA(1, 0, At, B0); PG8_BAR; PG8_SCHED;
            PG8_STAGE(PG8_SB(0, 1), b2 + hstep, voffB);
            PG8_WAIT_V(6); PG8_BAR; PG8_MMA(1, 1, At, B1); PG8_BAR;
            PG8_LDB(B0, 1, 0); PG8_SCHED; PG8_LDA(At, 1, 0); PG8_STAGE(PG8_SA(0, 1), a2 + hstep, voffA);
            PG8_WAIT_L(8); PG8_BAR; PG8_WAIT_L(0); PG8_MMA(0, 0, At, B0); PG8_BAR; PG8_SCHED;
            PG8_LDB(B1, 1, 1); PG8_STAGE(PG8_SB(1, 0), b3, voffB);
            PG8_BAR; PG8_WAIT_L(0); PG8_MMA(0, 1, At, B1); PG8_BAR;
            PG8_LDA(At, 1, 1); PG8_STAGE(PG8_SA(1, 0), a3, voffA);
            PG8_BAR; PG8_WAIT_L(0); PG8_MMA(1, 0, At, B0); PG8_BAR; PG8_SCHED;
            PG8_STAGE(PG8_SB(1, 1), b3 + hstep, voffB);
            PG8_WAIT_V(6); PG8_BAR; PG8_MMA(1, 1, At, B1); PG8_BAR;
            }
        }
        if constexpr (ALIGN_EPI) { if (wr == 0) PG8_BAR; }
        if constexpr (!Epi::AFTER_DRAIN) { E(acc, cur, wr, wc, fr, fq); S.done(cur); }
        if (!has_next) break;
        if (!epi_keep<Epi>(nxt.seg)) {
#pragma unroll
        for (int a = 0; a < 2; ++a)
#pragma unroll
            for (int b = 0; b < 2; ++b)
#pragma unroll
                for (int m = 0; m < 4; ++m)
#pragma unroll
                    for (int n = 0; n < 2; ++n) acc[a][b][m][n] = (f32x4){0.f, 0.f, 0.f, 0.f};
        }
        cur = nxt; cA = nA; cB = nB; ++ui;
        if constexpr (ALIGN_EPI) { if (wr == 1) PG8_BAR; }
    }
    PG8_WAIT_V(0);
    if constexpr (!ALIGN_EPI) { if (wr == 0) PG8_BAR; }
    PG8_BAR;
    if constexpr (Epi::AFTER_DRAIN) { E.fused(acc, cur, wr, wc, fr, fq, lds, wid, lane); S.done(cur); }
#undef PG8_SA
#undef PG8_SB
#undef PG8_STAGE
#undef PG8_LDA
#undef PG8_LDB
#undef PG8_MMA
#undef PG8_WAIT_V
#undef PG8_WAIT_L
#undef PG8_BAR
#undef PG8_SCHED
}
}

#define LAS __attribute__((address_space(3)))
typedef unsigned short bf16;
typedef float f32x4 __attribute__((ext_vector_type(4)));
typedef float f32x16 __attribute__((ext_vector_type(16)));
typedef short bf16x8 __attribute__((ext_vector_type(8)));
typedef short s16x4 __attribute__((ext_vector_type(4)));
typedef unsigned u32x4 __attribute__((ext_vector_type(4)));
typedef unsigned u32x2 __attribute__((ext_vector_type(2)));

constexpr int DM = 1024, NB = 8, SEQ = 8192, DEPTH = 4, MROWS = NB * SEQ, DFF = 2816, INW = 8192, NMOD = 9 * DM;
constexpr int NWAVES = 8, NTHR = 512;
constexpr float NORM_EPS = 1e-6f, LOG2E = 1.4426950408889634f;
constexpr size_t MiB = 1u << 20;
constexpr size_t WS_CTL = 0;
constexpr size_t WS_MOD = 1 * MiB;
constexpr size_t WS_WT = 4 * MiB;
constexpr size_t W_UPA = 0, W_DNA = W_UPA + (size_t)2 * DFF * DM, W_UPB = W_DNA + (size_t)DM * DFF, W_DNB = W_UPB + (size_t)2 * DFF * DM,
                 W_IN = W_DNB + (size_t)DM * DFF, W_RET = W_IN + (size_t)INW * DM, W_DIF = W_RET + (size_t)DM * DM, W_OUT = W_DIF + (size_t)DM * DM, W_END = W_OUT + (size_t)DM * DM;
constexpr size_t WS_H = 64 * MiB;
constexpr size_t ACT = (size_t)MROWS * DM * 2;
constexpr size_t WS_B0 = 192 * MiB;
constexpr size_t WS_HID = WS_B0;
constexpr size_t WS_END = WS_B0 + 6 * ACT;
static_assert(WS_WT + W_END * 2 <= WS_H && WS_END <= 1024 * MiB, "d_ws map");

struct Args { const float* in[18]; float* out; unsigned char* ws; };

__device__ __forceinline__ float shx(float v, int m, int lane) { return __int_as_float(__builtin_amdgcn_ds_bpermute((lane ^ m) << 2, __float_as_int(v))); }
__device__ __forceinline__ float wave_sum(float v, int lane) {
#pragma unroll
    for (int o = 1; o < 64; o <<= 1) v += shx(v, o, lane);
    return v;
}
__device__ __forceinline__ unsigned f2bf(float f) { unsigned u = __float_as_uint(f); return (u + 0x7fffu + ((u >> 16) & 1u)) >> 16; }
__device__ __forceinline__ unsigned pk2(float lo, float hi) { return pg8::cvt_pk_bf16(lo, hi); }
typedef __bf16 bf16x2_cv __attribute__((ext_vector_type(2))); typedef float f32x2_cv __attribute__((ext_vector_type(2)));
__device__ __forceinline__ unsigned pk2v(float lo, float hi) { f32x2_cv v = {lo, hi}; bf16x2_cv b = __builtin_convertvector(v, bf16x2_cv); return __builtin_bit_cast(unsigned, b); }
__device__ __forceinline__ float bflo(unsigned w) { return __uint_as_float(w << 16); }
__device__ __forceinline__ float bfhi(unsigned w) { return __uint_as_float(w & 0xffff0000u); }
__device__ __forceinline__ float sgpr_f(float v) { return __int_as_float(__builtin_amdgcn_readfirstlane(__float_as_int(v))); }
__device__ __forceinline__ int launder(int v) { asm volatile("" : "+v"(v)); return v; }
#define LDS_WAIT() asm volatile("s_waitcnt lgkmcnt(0)" ::: "memory")
#define LDS_BARRIER() do { asm volatile("s_waitcnt lgkmcnt(0)" ::: "memory"); __builtin_amdgcn_s_barrier(); asm volatile("" ::: "memory"); } while (0)
#define MFMA32(a, b, c) __builtin_amdgcn_mfma_f32_32x32x16_bf16((a), (b), (c), 0, 0, 0)
__device__ __forceinline__ int crow(int r, int hi) { return (r & 3) + 8 * (r >> 2) + 4 * hi; }
typedef short v4i16_t __attribute__((ext_vector_type(4)));
__device__ __forceinline__ s16x4 tr_read(const LAS unsigned char* p) { return __builtin_bit_cast(s16x4, __builtin_amdgcn_ds_read_tr16_b64_v4i16((LAS v4i16_t*)p)); }
__device__ __forceinline__ bf16x8 cat8(s16x4 lo, s16x4 hi) { return (bf16x8){lo[0], lo[1], lo[2], lo[3], hi[0], hi[1], hi[2], hi[3]}; }
__device__ __forceinline__ bf16x8 pack8v(const f32x16& x, int s) {
    u32x4 p; p.x = pk2v(x[8 * s], x[8 * s + 1]); p.y = pk2v(x[8 * s + 2], x[8 * s + 3]); p.z = pk2v(x[8 * s + 4], x[8 * s + 5]); p.w = pk2v(x[8 * s + 6], x[8 * s + 7]);
    return __builtin_bit_cast(bf16x8, p);
}
__device__ __forceinline__ bf16x8 pack8(const f32x16& x, int s) {
    u32x4 p; p.x = pk2(x[8 * s], x[8 * s + 1]); p.y = pk2(x[8 * s + 2], x[8 * s + 3]); p.z = pk2(x[8 * s + 4], x[8 * s + 5]); p.w = pk2(x[8 * s + 6], x[8 * s + 7]);
    return __builtin_bit_cast(bf16x8, p);
}

template <bool UPPERM>
__device__ __forceinline__ void transpose_item(const float* W, int K, int N, bf16* WT, LAS float* scr, int item, int lane) {
    const int nblk = N / 32, kb = item / nblk, nb = item % nblk, k0 = 64 * kb, n0 = 32 * nb;
#pragma unroll 8
    for (int i = 0; i < 32; ++i) { const int kk = 2 * i + (lane >> 5); scr[kk * 33 + (lane & 31)] = W[(size_t)(k0 + kk) * N + n0 + (lane & 31)]; }
    LDS_WAIT(); asm volatile("" ::: "memory");
    int d0 = n0;
    if (UPPERM) { const int half = n0 / DFF, j = n0 % DFF; d0 = (j / 128) * 256 + half * 128 + (j % 128); }
    const int c = lane & 7;
#pragma unroll
    for (int j = 0; j < 4; ++j) { const int n = (lane >> 3) + 8 * j; const LAS float* s = scr + (8 * c) * 33 + n;
        u32x4 o; o.x = pk2(s[0 * 33], s[1 * 33]); o.y = pk2(s[2 * 33], s[3 * 33]); o.z = pk2(s[4 * 33], s[5 * 33]); o.w = pk2(s[6 * 33], s[7 * 33]);
        *(u32x4*)(WT + (size_t)(d0 + n) * K + k0 + 8 * c) = o; }
    LDS_WAIT(); asm volatile("" ::: "memory");
}
__device__ __forceinline__ void convert_weights(const Args& a, int l, LAS unsigned char* lds, int gw, int ngw, int wave, int lane) {
    lane = launder(lane);
    LAS float* scr = (LAS float*)(lds + wave * 16384);
    bf16* WT = (bf16*)(a.ws + WS_WT);
    const float* up = a.in[5] + (size_t)l * 2 * DM * 2 * DFF; const float* dn = a.in[6] + (size_t)l * 2 * DFF * DM;
    const float* win = a.in[7] + (size_t)l * DM * INW; const float* wr = a.in[14] + (size_t)l * DM * DM; const float* wd = a.in[15] + (size_t)l * DM * DM; const float* wo = a.in[16] + (size_t)l * DM * DM;
    constexpr int I_UP = (DM / 64) * (2 * DFF / 32), I_DN = (DFF / 64) * (DM / 32), I_IN = (DM / 64) * (INW / 32), I_SQ = (DM / 64) * (DM / 32);
    constexpr int NITEMS = 2 * I_UP + 2 * I_DN + I_IN + 3 * I_SQ;
    for (int it = gw; it < NITEMS; it += ngw) {
        int r = it;
        if (r < I_UP) { transpose_item<true>(up, DM, 2 * DFF, WT + W_UPA, scr, r, lane); continue; } r -= I_UP;
        if (r < I_UP) { transpose_item<true>(up + (size_t)DM * 2 * DFF, DM, 2 * DFF, WT + W_UPB, scr, r, lane); continue; } r -= I_UP;
        if (r < I_DN) { transpose_item<false>(dn, DFF, DM, WT + W_DNA, scr, r, lane); continue; } r -= I_DN;
        if (r < I_DN) { transpose_item<false>(dn + (size_t)DFF * DM, DFF, DM, WT + W_DNB, scr, r, lane); continue; } r -= I_DN;
        if (r < I_IN) { transpose_item<false>(win, DM, INW, WT + W_IN, scr, r, lane); continue; } r -= I_IN;
        if (r < I_SQ) { transpose_item<false>(wr, DM, DM, WT + W_RET, scr, r, lane); continue; } r -= I_SQ;
        if (r < I_SQ) { transpose_item<false>(wd, DM, DM, WT + W_DIF, scr, r, lane); continue; } r -= I_SQ;
        transpose_item<false>(wo, DM, DM, WT + W_OUT, scr, r, lane);
    }
}
__device__ __forceinline__ void ada_phase(const Args& a, LAS unsigned char* lds, int wave, int lane) {
    lane = launder(lane);
    LAS float* sc = (LAS float*)lds; LAS float* part = (LAS float*)(lds + 32768);
    const float* c = a.in[1];
    for (int i = wave * 64 + lane; i < NB * DM; i += NTHR) { const float v = c[i]; sc[i] = v * pg8::sigmoid_f(v); }
    __syncthreads();
    float* mod = (float*)(a.ws + WS_MOD);
    constexpr int NIT = DEPTH * (NMOD / 64);
    for (int it = blockIdx.x; it < NIT; it += gridDim.x) {
        const int l = it / (NMOD / 64), j = (it % (NMOD / 64)) * 64 + lane;
        const float* w = a.in[2] + (size_t)l * DM * NMOD + j;
        float acc[NB];
#pragma unroll
        for (int b = 0; b < NB; ++b) acc[b] = 0.f;
        const int k0 = wave * 128;
#pragma unroll 8
        for (int k = 0; k < 128; ++k) { const float wv = w[(size_t)(k0 + k) * NMOD];
#pragma unroll
            for (int b = 0; b < NB; ++b) acc[b] += sc[b * DM + k0 + k] * wv; }
#pragma unroll
        for (int b = 0; b < NB; ++b) part[(wave * NB + b) * 64 + lane] = acc[b];
        __syncthreads();
        { const int b = wave; float s = a.in[3][(size_t)l * NMOD + j];
#pragma unroll
            for (int w8 = 0; w8 < 8; ++w8) s += part[(w8 * NB + b) * 64 + lane];
            mod[((size_t)l * NB + b) * NMOD + j] = s; }
        __syncthreads();
    }
}
template <int NR>
__device__ __forceinline__ void norm_mod_rows(const float* x, bf16* Hout, const float* const* mbp, const float* nw, const int* rows, int lane) {
    f32x4 v[NR][4]; float ss[NR];
#pragma unroll
    for (int r = 0; r < NR; ++r) { const f32x4* xr = (const f32x4*)(x + (size_t)rows[r] * DM) + lane;
#pragma unroll
        for (int j = 0; j < 4; ++j) v[r][j] = xr[64 * j]; }
#pragma unroll
    for (int r = 0; r < NR; ++r) { float s = 0.f;
#pragma unroll
        for (int j = 0; j < 4; ++j) s += (v[r][j].x * v[r][j].x + v[r][j].y * v[r][j].y) + (v[r][j].z * v[r][j].z + v[r][j].w * v[r][j].w);
        ss[r] = s; }
#pragma unroll
    for (int o = 1; o < 64; o <<= 1)
#pragma unroll
        for (int r = 0; r < NR; ++r) ss[r] += shx(ss[r], o, lane);
#pragma unroll
    for (int r = 0; r < NR; ++r) { const float rstd = 1.0f / sqrtf(ss[r] * (1.f / DM) + NORM_EPS); const float* shift = mbp[r]; const float* scale = mbp[r] + DM;
        u32x2* o8 = (u32x2*)(Hout + (size_t)rows[r] * DM) + lane;
#pragma unroll
        for (int j = 0; j < 4; ++j) { const int c4 = lane + 64 * j; const f32x4 w = ((const f32x4*)nw)[c4], sc = ((const f32x4*)scale)[c4], sh = ((const f32x4*)shift)[c4];
            const f32x4 o = v[r][j] * rstd * w * (sc + 1.0f) + sh; u32x2 p; p.x = pk2(o.x, o.y); p.y = pk2(o.z, o.w); o8[64 * j] = p; } }
}
__device__ __forceinline__ void norm_phase(const Args& a, const float* x, int l, int sub, int gw, int ngw, int lane) {
    lane = launder(lane);
    bf16* H = (bf16*)(a.ws + WS_H); const float* mod = (const float*)(a.ws + WS_MOD); const float* nw = a.in[4] + ((size_t)l * 3 + sub) * DM;
    constexpr int NR = 4;
    for (int m = gw; m < MROWS; m += NR * ngw) { int rows[NR]; const float* mbp[NR];
#pragma unroll
        for (int r = 0; r < NR; ++r) { rows[r] = m + r * ngw; if (rows[r] >= MROWS) rows[r] = m; mbp[r] = mod + ((size_t)l * NB + (rows[r] >> 13)) * NMOD + sub * 3 * DM; }
        norm_mod_rows<NR>(x, H, mbp, nw, rows, lane); }
}
__device__ __forceinline__ void final_norm_phase(const Args& a, int gw, int ngw, int lane) {
    lane = launder(lane);
    const float* fw = a.in[17];
#ifdef DBG_CHECK
    const float dbgs = 1.0f + (float)((const unsigned*)(a.ws + WS_CTL))[32];
#else
    const float dbgs = 1.0f;
#endif
    for (int m = gw; m < MROWS; m += ngw) { f32x4* xr = (f32x4*)(a.out + (size_t)m * DM) + lane;
        f32x4 v[4]; float s = 0.f;
#pragma unroll
        for (int j = 0; j < 4; ++j) { v[j] = xr[64 * j]; s += (v[j].x * v[j].x + v[j].y * v[j].y) + (v[j].z * v[j].z + v[j].w * v[j].w); }
        const float rstd = 1.0f / sqrtf(wave_sum(s, lane) * (1.f / DM) + NORM_EPS);
#pragma unroll
        for (int j = 0; j < 4; ++j) xr[64 * j] = v[j] * (rstd * dbgs) * ((const f32x4*)fw)[lane + 64 * j]; }
}

constexpr int R_Q = 0, R_K = R_Q + 64 * 272, R_QD = R_K + 64 * 272, R_KD = R_QD + 64 * 272, R_SC = R_KD + 64 * 320, R_V = R_SC + 64 * 144, R_DEC = R_V + 64 * 576, R_END = R_DEC + 256;
static_assert(R_END <= 131072 && 64 * 1040 <= R_DEC, "retention LDS");
__device__ __forceinline__ void retention_unit(const Args& a, int l, int b, int h, LAS unsigned char* lds, const int wave_s, const bool dummy = false) {
    asm volatile("" : "+s"(h));
    const int lane = hw_lane(), wave = wave_s, tid = wave_s * 64 + lane, r32 = lane & 31, hh = lane >> 5;
    const int q4 = (lane & 15) >> 2, p4 = lane & 3, g1 = (lane >> 4) & 1;
    const bf16* RQK = (const bf16*)(a.ws + WS_B0); const bf16* RV = (const bf16*)(a.ws + WS_B0 + ACT); bf16* RG = (bf16*)(a.ws + WS_B0 + 2 * ACT);
    const float* gn = a.in[8] + (size_t)l * DM + h * 256;
    const float lg = sgpr_f(log2f(1.0f - exp2f(-5.0f - (float)h)));
    const float sc_qk = 0.08838834764831845f;
    const float cdec = sgpr_f(exp2f(lg * 64.f));
    const size_t row0 = (size_t)b * SEQ;
    f32x16 S[4];
#pragma unroll
    for (int i = 0; i < 4; ++i) S[i] = f32x16{};
    u32x4 pq[2], pk[2], pv[4]; u32x2 prg[8];
    const int er = tid >> 3, es = tid & 7;
#ifdef USE_RSB
#define RSB() __builtin_amdgcn_sched_barrier(0)
#else
#define RSB() do {} while (0)
#endif
#define R_PREFETCH(ci) do { const size_t t0 = row0 + (size_t)(ci) * 64; \
        _Pragma("unroll") for (int i = 0; i < 2; ++i) { const int idx = tid + 512 * i, rr = idx >> 4, ch = idx & 15; \
            pq[i] = *(const u32x4*)(RQK + (t0 + rr) * DM + h * 128 + ch * 8); pk[i] = *(const u32x4*)(RQK + (t0 + rr) * DM + 512 + h * 128 + ch * 8); } \
        _Pragma("unroll") for (int i = 0; i < 4; ++i) { const int idx = tid + 512 * i, rr = idx >> 5, ch = idx & 31; pv[i] = *(const u32x4*)(RV + (t0 + rr) * DM + h * 256 + ch * 8); } } while (0)
#define R_STORE() do { \
        _Pragma("unroll") for (int i = 0; i < 2; ++i) { const int idx = tid + 512 * i, rr = idx >> 4, ch = idx & 15; \
            *(LAS u32x4*)(lds + R_Q + rr * 272 + ch * 16) = pq[i]; *(LAS u32x4*)(lds + R_K + rr * 272 + ch * 16) = pk[i]; \
            const float fqd = exp2f(lg * (float)rr); u32x4 qd; \
            qd.x = pk2(bflo(pq[i].x) * fqd, bfhi(pq[i].x) * fqd); qd.y = pk2(bflo(pq[i].y) * fqd, bfhi(pq[i].y) * fqd); qd.z = pk2(bflo(pq[i].z) * fqd, bfhi(pq[i].z) * fqd); qd.w = pk2(bflo(pq[i].w) * fqd, bfhi(pq[i].w) * fqd); \
            *(LAS u32x4*)(lds + R_QD + rr * 272 + ch * 16) = qd; \
            const float f = sc_qk * exp2f(lg * (float)(64 - rr)); u32x4 kd; \
            kd.x = pk2(bflo(pk[i].x) * f, bfhi(pk[i].x) * f); kd.y = pk2(bflo(pk[i].y) * f, bfhi(pk[i].y) * f); kd.z = pk2(bflo(pk[i].z) * f, bfhi(pk[i].z) * f); kd.w = pk2(bflo(pk[i].w) * f, bfhi(pk[i].w) * f); \
            *(LAS u32x4*)(lds + R_KD + rr * 320 + ch * 16) = kd; } \
        _Pragma("unroll") for (int i = 0; i < 4; ++i) { const int idx = tid + 512 * i, rr = idx >> 5, ch = idx & 31; *(LAS u32x4*)(lds + R_V + rr * 576 + ch * 16) = pv[i]; } } while (0)
    R_PREFETCH(0);
    if (tid < 64) *(LAS float*)(lds + R_DEC + tid * 4) = sc_qk * exp2f(lg * (float)tid);
    R_STORE();
    LDS_BARRIER();
    for (int ci = 0; ci < SEQ / 64; ++ci) {
        const size_t t0 = row0 + (size_t)ci * 64;
        float lgl = lg;
#ifdef LGL
        asm volatile("" : "+v"(lgl));
#endif
        if (ci + 1 < SEQ / 64) R_PREFETCH(ci + 1);
#ifndef RG_LATE
#pragma unroll
        for (int j = 0; j < 8; ++j) prg[j] = *(const u32x2*)(RG + (t0 + er) * DM + h * 256 + 4 * (es + 8 * j));
#endif
        RSB();
        if (wave < 4) {
            const int qb = wave >> 1, kb = wave & 1; f32x16 x = f32x16{};
#pragma unroll
            for (int ks = 0; ks < 8; ++ks) { const bf16x8 af = *(const LAS bf16x8*)(lds + R_Q + (32 * qb + r32) * 272 + (16 * ks + 8 * hh) * 2);
                const bf16x8 bfr = *(const LAS bf16x8*)(lds + R_K + (32 * kb + r32) * 272 + (16 * ks + 8 * hh) * 2); x = MFMA32(af, bfr, x); }
#pragma unroll
            for (int i = 0; i < 16; ++i) { const int q = 32 * qb + crow(i, hh), k = 32 * kb + r32; const int d = q > k ? q - k : k - q;
                const float v = x[i] * *(const LAS float*)(lds + R_DEC + d * 4); *(LAS unsigned short*)(lds + R_SC + q * 144 + k * 2) = (unsigned short)f2bf(v); }
        }
        RSB();
        f32x16 y[2]; y[0] = f32x16{}; y[1] = f32x16{};
#pragma unroll
        for (int dkb = 0; dkb < 4; ++dkb)
#pragma unroll
            for (int s = 0; s < 2; ++s) { const bf16x8 sp = pack8(S[dkb], s);
#pragma unroll
                for (int qb = 0; qb < 2; ++qb) { const LAS unsigned char* qp = lds + R_QD + (32 * qb + r32) * 272 + (32 * dkb + 16 * s + 4 * hh) * 2;
                    const s16x4 lo = *(const LAS s16x4*)qp, hi = *(const LAS s16x4*)(qp + 16); y[qb] = MFMA32(cat8(lo, hi), sp, y[qb]); } }
        RSB();
        LDS_BARRIER();
        bf16x8 vf[4];
#pragma unroll
        for (int ks = 0; ks < 4; ++ks) { const LAS unsigned char* vp = lds + R_V + (16 * ks + 8 * hh + q4) * 576 + (32 * wave + 16 * g1) * 2 + 8 * p4; vf[ks] = cat8(tr_read(vp), tr_read(vp + 4 * 576)); }
#pragma unroll
        for (int ks = 0; ks < 4; ++ks)
#pragma unroll
            for (int qb = 0; qb < 2; ++qb) { const bf16x8 af = *(const LAS bf16x8*)(lds + R_SC + (32 * qb + r32) * 144 + (16 * ks + 8 * hh) * 2); y[qb] = MFMA32(af, vf[ks], y[qb]); }
        RSB();
#pragma unroll
        for (int dkb = 0; dkb < 4; ++dkb) {
#pragma unroll
            for (int i = 0; i < 16; ++i) S[dkb][i] *= cdec;
#pragma unroll
            for (int ks = 0; ks < 4; ++ks) { const LAS unsigned char* kp = lds + R_KD + (16 * ks + 8 * hh + q4) * 320 + (32 * dkb + 16 * g1) * 2 + 8 * p4;
                S[dkb] = MFMA32(cat8(tr_read(kp), tr_read(kp + 4 * 320)), vf[ks], S[dkb]); } }
        LDS_BARRIER();
#ifdef RG_LATE
#pragma unroll
        for (int j = 0; j < 8; ++j) prg[j] = *(const u32x2*)(RG + (t0 + er) * DM + h * 256 + 4 * (es + 8 * j));
#endif
#pragma unroll
        for (int qb = 0; qb < 2; ++qb)
#pragma unroll
            for (int i = 0; i < 16; ++i) *(LAS float*)(lds + (32 * qb + crow(i, hh)) * 1040 + (32 * wave + r32) * 4) = y[qb][i];
        LDS_BARRIER();
        { f32x4 yv[8]; float ss = 0.f;
#pragma unroll
            for (int j = 0; j < 8; ++j) { yv[j] = *(const LAS f32x4*)(lds + er * 1040 + 16 * (es + 8 * j)); ss += (yv[j].x * yv[j].x + yv[j].y * yv[j].y) + (yv[j].z * yv[j].z + yv[j].w * yv[j].w); }
            ss += shx(ss, 1, lane); ss += shx(ss, 2, lane); ss += shx(ss, 4, lane);
            const float rstd = 1.0f / sqrtf(ss * (1.f / 256.f) + NORM_EPS);
#pragma unroll
            for (int j = 0; j < 8; ++j) { const int c = 4 * (es + 8 * j); const f32x4 w = *(const f32x4*)(gn + c);
                const float g0 = bflo(prg[j].x), g1v = bfhi(prg[j].x), g2 = bflo(prg[j].y), g3 = bfhi(prg[j].y);
                u32x2 o; o.x = pk2(yv[j].x * rstd * w.x * g0 * pg8::sigmoid_f(g0), yv[j].y * rstd * w.y * g1v * pg8::sigmoid_f(g1v));
                o.y = pk2(yv[j].z * rstd * w.z * g2 * pg8::sigmoid_f(g2), yv[j].w * rstd * w.w * g3 * pg8::sigmoid_f(g3));
                if (!dummy || rstd == -12345.f) *(u32x2*)(RG + (t0 + er) * DM + h * 256 + c) = o; } }
        LDS_BARRIER();
        if (ci + 1 < SEQ / 64) R_STORE();
        LDS_BARRIER();
    }
#undef R_PREFETCH
#undef R_STORE
}

constexpr int A_KS = 272, A_VS = 320, A_KB = 64 * A_KS, A_VB = 64 * A_VS, A_BUF = A_KB + A_VB, A_X = 0;
static_assert(2 * A_BUF <= 131072 && 4 * 64 * 64 * 4 <= 131072, "attention LDS");
__device__ __forceinline__ void attn_unit(const Args& a, int l, int b, int h, int qb, float lam, float post, LAS unsigned char* lds, const int wave_s, const bool dummy = false) {
    asm volatile("" : "+s"(h));
    const int lane = hw_lane(), wave = wave_s, tid = wave_s * 64 + lane, r32 = lane & 31, hh = lane >> 5;
    const int q4 = (lane & 15) >> 2, p4 = lane & 3, g1 = (lane >> 4) & 1;
    const int sub = wave >> 2, wq = wave & 3;
    bf16* DQ = (bf16*)(a.ws + WS_B0 + 3 * ACT); const bf16* DK = (const bf16*)(a.ws + WS_B0 + 4 * ACT); const bf16* DV = (const bf16*)(a.ws + WS_B0 + 5 * ACT);
    const size_t row0 = (size_t)b * SEQ; const int q0 = qb * 128;
    const int NT = 2 * qb + 2;
    const float sl2 = sgpr_f(exp2f(-(float)(h + 1)) * LOG2E);
    bf16x8 qf[4];
    { const bf16* qp = DQ + (row0 + q0 + 32 * wq + r32) * DM + h * 128 + sub * 64 + 8 * hh;
#pragma unroll
        for (int ks = 0; ks < 4; ++ks) qf[ks] = *(const bf16x8*)(qp + 16 * ks); }
    u32x4 pk[2], pv[2];
#define A_PREFETCH(t) do { const size_t t0 = row0 + (size_t)(t) * 64; \
        _Pragma("unroll") for (int i = 0; i < 2; ++i) { const int idx = tid + 512 * i, rr = idx >> 4, ch = idx & 15; \
            pk[i] = *(const u32x4*)(DK + (t0 + rr) * DM + h * 128 + ch * 8); pv[i] = *(const u32x4*)(DV + (t0 + rr) * DM + h * 128 + ch * 8); } } while (0)
#define A_STORE(bufo) do { \
        _Pragma("unroll") for (int i = 0; i < 2; ++i) { const int idx = tid + 512 * i, rr = idx >> 4, ch = idx & 15; \
            *(LAS u32x4*)(lds + (bufo) + rr * A_KS + ch * 16) = pk[i]; *(LAS u32x4*)(lds + (bufo) + A_KB + rr * A_VS + ch * 16) = pv[i]; } } while (0)
    f32x16 o[4];
#pragma unroll
    for (int i = 0; i < 4; ++i) o[i] = f32x16{};
    float mrun = -1e30f, lrun = 0.f;
    f32x16 cb;
#pragma unroll
    for (int i = 0; i < 16; ++i) cb[i] = sl2 * (float)((i & 3) + 8 * (i >> 2) + 4 * hh);
    const float c32 = sgpr_f(32.f * sl2);
    const int tq = NT - 2 + (wq >> 1);
    const float qin = (float)(32 * (wq & 1) + r32), qs = sl2 * qin;
    const int tmin = max(0, (int)ceilf((128.f * (float)qb - 63.f - 280.f / sl2) * (1.f / 64.f)));
    A_PREFETCH(NT - 1);
    A_STORE(0);
    LDS_BARRIER();
    for (int it = 0; it < NT - tmin; ++it) {
        const int t = NT - 1 - it, bufo = (it & 1) * A_BUF;
        if (t > tmin) A_PREFETCH(t - 1);
        if (t <= tq) {
            f32x16 s[2];
            s[0] = cb;
#pragma unroll
            for (int i = 0; i < 16; ++i) s[1][i] = cb[i] + c32;
#pragma unroll
            for (int kb = 0; kb < 2; ++kb)
#pragma unroll
                for (int ks = 0; ks < 4; ++ks) { const bf16x8 kf = *(const LAS bf16x8*)(lds + bufo + (32 * kb + r32) * A_KS + (sub * 64 + 16 * ks + 8 * hh) * 2); s[kb] = MFMA32(kf, qf[ks], s[kb]); }
            float ut = -sl2 * (qin + 64.f * (float)(tq - t));
            if (t == tq) {
                ut = 0.f;
#pragma unroll
                for (int i = 0; i < 16; ++i) { const float c0 = cb[i], c1 = cb[i] + c32; s[0][i] = s[0][i] - c0 - fabsf(qs - c0); s[1][i] = s[1][i] - c1 - fabsf(qs - c1); }
            }
            float mt = fmaxf(s[0][0], s[1][0]);
#pragma unroll
            for (int i = 1; i < 16; ++i) mt = fmaxf(fmaxf(mt, s[0][i]), s[1][i]);
            mt = fmaxf(mt, shx(mt, 32, lane)) + ut;
            if (__any(mt > mrun)) {
                const float mnew = fmaxf(mrun, mt), alpha = __builtin_amdgcn_exp2f(mrun - mnew); mrun = mnew; lrun *= alpha;
#pragma unroll
                for (int d4 = 0; d4 < 4; ++d4)
#pragma unroll
                    for (int i = 0; i < 16; ++i) o[d4][i] *= alpha;
            }
            const float ml = mrun - ut;
            float ps = 0.f;
#pragma unroll
            for (int kb = 0; kb < 2; ++kb)
#pragma unroll
                for (int i = 0; i < 16; ++i) { s[kb][i] = __builtin_amdgcn_exp2f(s[kb][i] - ml); ps += s[kb][i]; }
            lrun += ps;
            __builtin_amdgcn_sched_barrier(0);
            {
                const LAS unsigned char* vbase = lds + bufo + A_KB + (4 * hh + q4) * A_VS + (16 * g1) * 2 + 8 * p4;
                bf16x8 vcur[4], vnxt[4];
#pragma unroll
                for (int d4 = 0; d4 < 4; ++d4) vcur[d4] = cat8(tr_read(vbase + 64 * d4), tr_read(vbase + 64 * d4 + 8 * A_VS));
#pragma unroll
                for (int g = 0; g < 4; ++g) {
                    if (g < 3) {
#pragma unroll
                        for (int d4 = 0; d4 < 4; ++d4) vnxt[d4] = cat8(tr_read(vbase + (g + 1) * 16 * A_VS + 64 * d4), tr_read(vbase + (g + 1) * 16 * A_VS + 64 * d4 + 8 * A_VS)); }
                    const bf16x8 pf = pack8v(s[g >> 1], g & 1);
#pragma unroll
                    for (int d4 = 0; d4 < 4; ++d4) o[d4] = MFMA32(vcur[d4], pf, o[d4]);
                    __builtin_amdgcn_sched_barrier(0);
#pragma unroll
                    for (int d4 = 0; d4 < 4; ++d4) vcur[d4] = vnxt[d4];
                }
            }
        }
        if (t > tmin) A_STORE(((it + 1) & 1) * A_BUF);
        LDS_BARRIER();
    }
    lrun += shx(lrun, 32, lane);
    const float rl = 1.0f / lrun;
    if (sub == 1) {
#pragma unroll
        for (int d4 = 0; d4 < 4; ++d4)
#pragma unroll
            for (int i = 0; i < 16; ++i) *(LAS float*)(lds + A_X + ((wq * 64 + d4 * 16 + i) * 64 + lane) * 4) = o[d4][i] * rl;
    }
    __syncthreads();
    if (sub == 0) {
        float ss = 0.f;
#pragma unroll
        for (int d4 = 0; d4 < 4; ++d4)
#pragma unroll
            for (int i = 0; i < 16; ++i) { const float v = o[d4][i] * rl - lam * *(const LAS float*)(lds + A_X + ((wq * 64 + d4 * 16 + i) * 64 + lane) * 4); o[d4][i] = v; ss += v * v; }
        ss += shx(ss, 32, lane);
        const float rstd = post / sqrtf(ss * (1.f / 128.f) + NORM_EPS);
        const float* sw = a.in[13] + (size_t)l * 128;
        bf16* op = DQ + (row0 + q0 + 32 * wq + r32) * DM + h * 128;
#pragma unroll
        for (int d4 = 0; d4 < 4; ++d4)
#pragma unroll
            for (int g = 0; g < 4; ++g) { const int dv = 32 * d4 + 8 * g + 4 * hh; const f32x4 w = *(const f32x4*)(sw + dv);
                u32x2 pkd; pkd.x = pk2(o[d4][4 * g] * rstd * w.x, o[d4][4 * g + 1] * rstd * w.y); pkd.y = pk2(o[d4][4 * g + 2] * rstd * w.z, o[d4][4 * g + 3] * rstd * w.w);
                if (!dummy || rstd == -12345.f) *(u32x2*)(op + dv) = pkd; }
    }
    __syncthreads();
#undef A_PREFETCH
#undef A_STORE
}


#define XB_TMO      128
#define XB_XCNT(j)  (256  + 64 * (j))
#define XB_XSUB(j)  (1280 + 64 * (j))
#define XB_XGEN(j)  (2304 + 64 * (j))
#define XB_TOP      3328
#define XB_TOPGEN   3392
#define XCD_BAR_WORDS 3456
#define XB_SPIN_CAP (1u << 24)

__device__ __forceinline__ unsigned xb_ld(unsigned* p)              { return __hip_atomic_load(p, __ATOMIC_RELAXED, __HIP_MEMORY_SCOPE_AGENT); }
__device__ __forceinline__ unsigned xb_add(unsigned* p, unsigned v) { return __hip_atomic_fetch_add(p, v, __ATOMIC_RELAXED, __HIP_MEMORY_SCOPE_AGENT); }
__device__ __forceinline__ unsigned xb_xcc_id() { return (unsigned)__builtin_amdgcn_s_getreg((3 << 11) | 20) & 0xFu; }
#define XB_SPIN(cond, bar) do { unsigned _sp = 0; while (cond) { __builtin_amdgcn_s_sleep(1); \
    if ((++_sp & 255u) == 0u) { if (xb_ld(&(bar)[XB_TMO])) break; if (_sp > XB_SPIN_CAP) { atomicAdd(&(bar)[XB_TMO], 1u); break; } } } } while (0)

struct XcdBarrier {
    unsigned* bar; unsigned x;
    volatile LAS unsigned* st;
};

__device__ __forceinline__ XcdBarrier xcd_barrier_post(unsigned* bar, volatile LAS unsigned* st, bool first) {
    XcdBarrier b; b.bar = bar; b.x = xb_xcc_id(); b.st = st;
    if (first) (void)xb_add(&bar[XB_XCNT(b.x)], 1u);
    return b;
}
__device__ __forceinline__ void xcd_barrier_complete(unsigned* bar, unsigned x, unsigned& nloc, unsigned& nx) {
    const unsigned G = gridDim.x * gridDim.y * gridDim.z;
    unsigned sum, cnt, mine, sp = 0u;
    for (;;) {
        sum = 0u; cnt = 0u; mine = 0u;
#pragma unroll
        for (unsigned j = 0; j < 16; ++j) { const unsigned c = xb_ld(&bar[XB_XCNT(j)]); sum += c; cnt += (c > 0u) ? 1u : 0u; mine = (j == x) ? c : mine; }
        if (sum == G) break;
        __builtin_amdgcn_s_sleep(1);
        if ((++sp & 255u) == 0u) { if (xb_ld(&bar[XB_TMO])) break; if (sp > XB_SPIN_CAP) { atomicAdd(&bar[XB_TMO], 1u); break; } }
    }
    nloc = mine > 0u ? mine : 1u; nx = cnt > 0u ? cnt : 1u;
}

__device__ __forceinline__ void xcd_barrier(const XcdBarrier& b, const bool first) {
    asm volatile("s_waitcnt vmcnt(0)" ::: "memory");
    __syncthreads();
    if (first) {
        unsigned* bar = b.bar;
        __builtin_amdgcn_s_waitcnt(0);
        unsigned nloc = b.st[0], nx = b.st[1];
        if (nloc == 0u) { xcd_barrier_complete(bar, b.x, nloc, nx); b.st[0] = nloc; b.st[1] = nx; }
        const unsigned old = xb_add(&bar[XB_XSUB(b.x)], 1u);
        const unsigned gen = old / nloc;
        if (old + 1u == (gen + 1u) * nloc) {
            __builtin_amdgcn_fence(__ATOMIC_RELEASE, "agent");
            asm volatile("s_waitcnt vmcnt(0)" ::: "memory");
            const unsigned og = xb_add(&bar[XB_TOP], 1u);
            const unsigned tg = og / nx;
            if (og + 1u == (tg + 1u) * nx) xb_add(&bar[XB_TOPGEN], 1u);
            else XB_SPIN(xb_ld(&bar[XB_TOPGEN]) == tg, bar);
            __builtin_amdgcn_fence(__ATOMIC_ACQUIRE, "agent");
            xb_add(&bar[XB_XGEN(b.x)], 1u);
            asm volatile("s_waitcnt vmcnt(0)" ::: "memory");
        } else {
            XB_SPIN(xb_ld(&bar[XB_XGEN(b.x)]) == gen, bar);
            __builtin_amdgcn_fence(__ATOMIC_ACQUIRE, "agent");
            asm volatile("s_waitcnt vmcnt(0)" ::: "memory");
        }
    }
    __syncthreads();
}

#define CG_SYNC() do { asm volatile("s_waitcnt vmcnt(0) lgkmcnt(0)" ::: "memory"); __syncthreads(); grid.sync(); \
    __builtin_amdgcn_fence(__ATOMIC_ACQUIRE, "agent"); asm volatile("s_waitcnt vmcnt(0)" ::: "memory"); __syncthreads(); } while (0)
#define IS_T0 (wave_s == 0 && hw_lane() == 0)
#define GRID_SYNC() xcd_barrier(xbar, IS_T0)
constexpr int CW_BAR = 4096;
typedef const __attribute__((address_space(4))) Args* KArgsPtr;
#define PHASE_BEGIN Args a; { KArgsPtr ka_ = (KArgsPtr)__builtin_amdgcn_kernarg_segment_ptr(); asm volatile("" : "+s"(ka_)); _Pragma("unroll") for (int i_ = 0; i_ < 18; ++i_) a.in[i_] = ka_->in[i_]; a.out = ka_->out; a.ws = ka_->ws; } \
    const int lane = hw_lane(), wave = wave_s, tid = wave_s * 64 + lane; const int G = gridDim.x, gw = blockIdx.x * NWAVES + wave, ngw = G * NWAVES; \
    unsigned* ctl = (unsigned*)(a.ws + WS_CTL); const float* mod = (const float*)(a.ws + WS_MOD); bf16* WT = (bf16*)(a.ws + WS_WT); bf16* H = (bf16*)(a.ws + WS_H); bf16* HID = (bf16*)(a.ws + WS_HID); bf16* B0 = (bf16*)(a.ws + WS_B0); \
    (void)tid; (void)lane; (void)wave; (void)G; (void)gw; (void)ngw; (void)ctl; (void)mod; (void)WT; (void)H; (void)HID; (void)B0;
#define GEMM_RUN(EPI, ...) do { pg8::StaticOrder S; S.init(MROWS, g.N, G, (int)blockIdx.x); EPI E{__VA_ARGS__}; pg8::gemm_phase<EPI, pg8::StaticOrder, true, true>(lds, g, S, E, wave_s); } while (0)

__global__ void __launch_bounds__(NTHR, 2) hybrid_fwd(Args args_unused) {
    extern __shared__ __attribute__((aligned(16))) unsigned char lds_raw[];
    LAS unsigned char* lds = (LAS unsigned char*)lds_raw;
    cg::grid_group grid = cg::this_grid();
    const int wave_s = __builtin_amdgcn_readfirstlane((int)threadIdx.x >> 6);
    LAS unsigned* qslot = (LAS unsigned*)(lds + 131072);

    {
        PHASE_BEGIN
        if (blockIdx.x == 0) { if (tid < 64) ctl[tid] = 0u; for (int i = tid; i < XCD_BAR_WORDS; i += NTHR) ctl[CW_BAR + i] = 0u; }
        ada_phase(a, lds, wave, lane);
        convert_weights(a, 0, lds, gw, ngw, wave, lane);
    }
    CG_SYNC();
    XcdBarrier xbar;
    {   PHASE_BEGIN
        volatile LAS unsigned* st = (volatile LAS unsigned*)(lds + 131072 + 16);
        if (tid < 2) st[tid] = 0u;
        __syncthreads();
        xbar = xcd_barrier_post(ctl + CW_BAR, st, tid == 0);
    }

    for (int l = 0; l < DEPTH; ++l) {
        {
            PHASE_BEGIN
            if (l > 0) convert_weights(a, l, lds, gw, ngw, wave, lane);
            norm_phase(a, (l == 0) ? a.in[0] : a.out, l, 0, gw, ngw, lane);
        }
        GRID_SYNC();
#ifdef UP_TWICE
        { PHASE_BEGIN pg8::Gemm g{H, WT + W_UPA, MROWS, 2 * DFF, DM}; GEMM_RUN(pg8::EpiSwiGLU, HID, DFF); }
        GRID_SYNC();
#endif
        { PHASE_BEGIN pg8::Gemm g{H, WT + W_UPA, MROWS, 2 * DFF, DM}; GEMM_RUN(pg8::EpiSwiGLU, HID, DFF); }
        GRID_SYNC();
        { PHASE_BEGIN pg8::Gemm g{HID, WT + W_DNA, MROWS, DM, DFF}; GEMM_RUN(pg8::EpiResid, (l == 0) ? a.in[0] : a.out, a.out, mod + (size_t)l * NB * NMOD + 0 * 3 * DM + 2 * DM, NMOD, 0.5f, DM); }
        GRID_SYNC();
        { PHASE_BEGIN norm_phase(a, a.out, l, 1, gw, ngw, lane); }
        GRID_SYNC();
        { PHASE_BEGIN pg8::Gemm g{H, WT + W_IN, MROWS, 6 * DM, DM}; GEMM_RUN(pg8::EpiBf<0>, B0, DM, DM, (size_t)MROWS * DM, 3, 0.125f * LOG2E, nullptr); }
        GRID_SYNC();
        {
            PHASE_BEGIN
#ifdef RET_TWICE
            if (blockIdx.x < 32) retention_unit(a, l, blockIdx.x >> 2, blockIdx.x & 3, lds, wave_s, true);
#endif
            if (blockIdx.x < 32) retention_unit(a, l, blockIdx.x >> 2, blockIdx.x & 3, lds, wave_s);
            const float s1 = wave_sum(a.in[9][l * 64 + lane] * a.in[10][l * 64 + lane], lane), s2 = wave_sum(a.in[11][l * 64 + lane] * a.in[12][l * 64 + lane], lane);
            const float lam_init = sgpr_f(0.8f - 0.6f * expf(-0.3f * (float)l)), lam = sgpr_f(expf(s1) - expf(s2) + lam_init);
#ifdef ATT_TWICE
            for (;;) {
                if (tid == 0) *qslot = atomicAdd(ctl + 8 + l, 1u);
                __syncthreads();
                const unsigned item = *qslot;
                __syncthreads();
                if (item >= 64u * 64u) break;
                const int qb = 63 - (int)(item >> 6), bh = (int)(item & 63u);
                attn_unit(a, l, bh >> 3, bh & 7, qb, lam, 1.0f - lam_init, lds, wave_s, true);
            }
#endif
            const int q0 = (int)(xb_xcc_id() & 7u);
            for (int k = 0; k < NB; ++k) {
                const int bq = (q0 + k) & 7;
                for (;;) {
                    if (tid == 0) *qslot = atomicAdd(ctl + l * NB + bq, 1u);
                    __syncthreads();
                    const unsigned item = *qslot;
                    __syncthreads();
                    if (item >= 8u * 64u) break;
                    attn_unit(a, l, bq, 7 - (int)(item >> 6), 63 - (int)(item & 63u), lam, 1.0f - lam_init, lds, wave_s);
                }
            }
        }
        GRID_SYNC();
        {
            PHASE_BEGIN pg8::Gemm g{H, WT + W_IN + (size_t)6 * DM * DM, MROWS, DM, DM, H, WT + W_IN + (size_t)7 * DM * DM, B0 + (size_t)2 * MROWS * DM, WT + W_RET, B0 + (size_t)3 * MROWS * DM, WT + W_DIF};
            pg8::SegOrderN<2> S; S.init(MROWS, g.N, G, (int)blockIdx.x); pg8::EpiMerge E{B0 + (size_t)1 * MROWS * DM, DM, B0, B0 + (size_t)4 * MROWS * DM};
            pg8::gemm_phase<pg8::EpiMerge, pg8::SegOrderN<2>, true, true>(lds, g, S, E, wave_s); }
        GRID_SYNC();
        { PHASE_BEGIN pg8::Gemm g{B0 + (size_t)1 * MROWS * DM, WT + W_OUT, MROWS, DM, DM}; GEMM_RUN(pg8::EpiResid, a.out, a.out, mod + (size_t)l * NB * NMOD + 1 * 3 * DM + 2 * DM, NMOD, 1.0f, DM); }
        GRID_SYNC();
        { PHASE_BEGIN norm_phase(a, a.out, l, 2, gw, ngw, lane); }
        GRID_SYNC();
        { PHASE_BEGIN pg8::Gemm g{H, WT + W_UPB, MROWS, 2 * DFF, DM}; GEMM_RUN(pg8::EpiSwiGLU, HID, DFF); }
        GRID_SYNC();
        { PHASE_BEGIN pg8::Gemm g{HID, WT + W_DNB, MROWS, DM, DFF}; GEMM_RUN(pg8::EpiResid, a.out, a.out, mod + (size_t)l * NB * NMOD + 2 * 3 * DM + 2 * DM, NMOD, 0.5f, DM); }
        GRID_SYNC();
    }
#ifdef SYNC_PROBE
    for (int i = 0; i < 64; ++i) GRID_SYNC();
#endif
    { PHASE_BEGIN final_norm_phase(a, gw, ngw, lane); }
}

constexpr int LDS_BYTES = 147456;
extern "C" void kernel_launch(void* const* d_in, const int* in_sizes, int n_in, void* d_out, int out_size, void* d_ws, size_t ws_size, hipStream_t stream) {
    static int grid = 0;
    if (grid == 0) {
        if (n_in != 18 || ws_size < WS_END) { fprintf(stderr, "kernel_launch: unexpected n_in %d / ws_size %zu (need %zu)\n", n_in, ws_size, (size_t)WS_END); grid = -1; return; }
        int dev = 0, cus = 0, per_cu = 0;
        (void)hipGetDevice(&dev); (void)hipDeviceGetAttribute(&cus, hipDeviceAttributeMultiprocessorCount, dev);
        if (hipFuncSetAttribute((const void*)hybrid_fwd, hipFuncAttributeMaxDynamicSharedMemorySize, LDS_BYTES) != hipSuccess) { fprintf(stderr, "kernel_launch: hipFuncSetAttribute failed\n"); grid = -1; return; }
        if (hipOccupancyMaxActiveBlocksPerMultiprocessor(&per_cu, (const void*)hybrid_fwd, NTHR, LDS_BYTES) != hipSuccess || per_cu < 1) { fprintf(stderr, "kernel_launch: occupancy query says %d\n", per_cu); per_cu = 1; }
        (void)hipGetLastError();
        grid = cus * 1;
    }
    if (grid < 0) return;
    Args a{};
    for (int i = 0; i < 18; ++i) a.in[i] = (const float*)d_in[i];
    a.out = (float*)d_out; a.ws = (unsigned char*)d_ws;
    void* kargs[] = {&a};
    hipError_t e = hipLaunchCooperativeKernel((const void*)hybrid_fwd, dim3(grid), dim3(NTHR), kargs, LDS_BYTES, stream);
    if (e != hipSuccess) fprintf(stderr, "cooperative launch failed: %s (grid %d)\n", hipGetErrorString(e), grid);
}
```

```cpp
#define GATE_LOGITS 1
#include <hip/hip_runtime.h>
#include <hip/hip_cooperative_groups.h>
#include <cstdio>
#include <cstdint>
namespace cg = cooperative_groups;
#define USE_RSB 1
__device__ __forceinline__ int hw_lane() { int l = (int)__builtin_amdgcn_mbcnt_hi(~0u, __builtin_amdgcn_mbcnt_lo(~0u, 0u)); asm volatile("" : "+v"(l)); return l; }
namespace pg8 {
#define PG8_LAS __attribute__((address_space(3)))
typedef unsigned short bf16_t;
typedef short bf16x8 __attribute__((ext_vector_type(8)));
typedef float f32x4 __attribute__((ext_vector_type(4)));
typedef unsigned u32x4 __attribute__((ext_vector_type(4)));
constexpr int BM = 256, BK = 64, HALF = 128, HTB = HALF * BK * 2  , STAGE_BYTES = 8 * HTB, NXCD = 8, WGM = 8;

__host__ __device__ __forceinline__ int lds_byte(int r, int c) { const int st = (r >> 4) * 2 + (c >> 5), rr = r & 15, cc = c & 31, ob = rr * 64 + cc * 2; return st * 1024 + (ob ^ (((ob >> 9) & 1) << 5)); }
__host__ __device__ __forceinline__ void stage_rc(int b, int& R, int& C) { const int st = b / 1024, sb = b % 1024, swz = sb ^ (((sb >> 9) & 1) << 5); R = (st >> 1) * 16 + swz / 64; C = (st & 1) * 32 + (swz % 64) / 2; }
__host__ __device__ __forceinline__ int perm32(int rho) { const int n = rho >> 4, i = rho & 15; return 8 * (i >> 2) + 4 * n + (i & 3); }

struct Unit { int pm, pn, seg; };
struct Gemm { const bf16_t* A; const bf16_t* Bt; int M, N, K; const bf16_t* A2; const bf16_t* Bt2; const bf16_t* A3; const bf16_t* Bt3; const bf16_t* A4; const bf16_t* Bt4; };
__host__ __device__ __forceinline__ const bf16_t* seg_a(const Gemm& g, int sg) { return sg == 0 ? g.A : sg == 1 ? g.A2 : sg == 2 ? g.A3 : g.A4; }
__host__ __device__ __forceinline__ const bf16_t* seg_b(const Gemm& g, int sg) { return sg == 0 ? g.Bt : sg == 1 ? g.Bt2 : sg == 2 ? g.Bt3 : g.Bt4; }

struct StaticOrder {
    int nM, nN, nwg, G, c;
    __host__ __device__ void init(int M, int N, int G_, int c_) { nM = M / BM; nN = N / BM; nwg = nM * nN; G = G_; c = c_; }
    __host__ __device__ bool next(int i, Unit& u) const {
        const long L = (long)i * G + c; if (L >= nwg) return false;
        int wgid = (int)L; { const int q = nwg / NXCD, r = nwg % NXCD, xcd = wgid % NXCD, off = wgid / NXCD; wgid = (xcd < r ? xcd * (q + 1) : r * (q + 1) + (xcd - r) * q) + off; }
        const int nig = WGM * nN, gid = wgid / nig, fm = gid * WGM, gsz = (nM - fm) < WGM ? (nM - fm) : WGM;
        u.pm = fm + ((wgid % nig) % gsz); u.pn = (wgid % nig) / gsz; u.seg = 0; return true;
    }
    __device__ __forceinline__ void a_ready(const Unit&) const {}
    __device__ __forceinline__ void done(const Unit&) const {}
};
template <int LOG2SEG> struct SegOrderN {
    StaticOrder base;
    __host__ __device__ void init(int M, int N, int G_, int c_) { base.init(M, N, G_, c_); }
    __host__ __device__ bool next(int i, Unit& u) const { const bool ok = base.next(i >> LOG2SEG, u); u.seg = i & ((1 << LOG2SEG) - 1); return ok; }
    __device__ __forceinline__ void a_ready(const Unit&) const {}
    __device__ __forceinline__ void done(const Unit&) const {}
};
template <class E, class = void> struct epi_seg { static constexpr bool value = false; };
template <class E> struct epi_seg<E, decltype((void)E::SEG)> { static constexpr bool value = E::SEG; };
template <class E> __host__ __device__ __forceinline__ bool epi_keep(int sg) { if constexpr (epi_seg<E>::value) return E::keep_acc(sg); else return false; }


__device__ __forceinline__ unsigned cvt_pk_bf16(float lo, float hi) { unsigned r; asm volatile("v_cvt_pk_bf16_f32 %0, %1, %2" : "=v"(r) : "v"(lo), "v"(hi)); return r; }
typedef float f32x2 __attribute__((ext_vector_type(2)));

__device__ __forceinline__ float sigmoid_f(float v) { return __builtin_amdgcn_rcpf(1.0f + __builtin_amdgcn_exp2f(-1.4426950408889634f * v)); }
__device__ __forceinline__ float bf_lo(unsigned w) { return __uint_as_float(w << 16); }
__device__ __forceinline__ float bf_hi(unsigned w) { return __uint_as_float(w & 0xffff0000u); }

struct EpiSwiGLU {
    static constexpr bool PERM = true, AFTER_DRAIN = false;
    bf16_t* O; int ldc;
    __device__ __forceinline__ void operator()(const f32x4 (&acc)[2][2][4][2], const Unit& u, int wr, int wc, int fr, int fq) const {
        const int row0 = u.pm * BM + wr * 64 + fr, col0 = u.pn * HALF + wc * 32 + 8 * fq;
#pragma unroll
        for (int ai = 0; ai < 2; ++ai)
#pragma unroll
            for (int m = 0; m < 4; ++m) {
                bf16_t* rowp = O + (size_t)(row0 + ai * HALF + m * 16) * ldc + col0;
                float v[8];
#pragma unroll
                for (int n = 0; n < 2; ++n)
#pragma unroll
                    for (int e = 0; e < 4; ++e) { const float a = acc[ai][0][m][n][e], b = acc[ai][1][m][n][e]; v[4 * n + e] = a * sigmoid_f(a) * b; }
                u32x4 w; w.x = cvt_pk_bf16(v[0], v[1]); w.y = cvt_pk_bf16(v[2], v[3]); w.z = cvt_pk_bf16(v[4], v[5]); w.w = cvt_pk_bf16(v[6], v[7]);
                *(u32x4*)rowp = w;
            }
    }
};
struct EpiResid {
    static constexpr bool PERM = false, AFTER_DRAIN = false;
    const float* base; float* out; const float* gate; int gate_bstride; float coef; int ldc;
    __device__ __forceinline__ void operator()(const f32x4 (&acc)[2][2][4][2], const Unit& u, int wr, int wc, int fr, int fq) const {
        const int col0 = u.pn * BM + wc * 32 + 4 * fq;
        const float* g = gate + (size_t)(u.pm >> 5) * gate_bstride;
        f32x4 gv[2][2];
#pragma unroll
        for (int bj = 0; bj < 2; ++bj)
#pragma unroll
            for (int n = 0; n < 2; ++n) gv[bj][n] = *(const f32x4*)(g + col0 + bj * HALF + n * 16) * coef;
#pragma unroll
        for (int ai = 0; ai < 2; ++ai)
#pragma unroll
            for (int m = 0; m < 4; ++m) { const size_t off = (size_t)(u.pm * BM + ai * HALF + wr * 64 + m * 16 + fr) * ldc + col0;
#pragma unroll
                for (int bj = 0; bj < 2; ++bj)
#pragma unroll
                    for (int n = 0; n < 2; ++n) { const f32x4 bs = *(const f32x4*)(base + off + bj * HALF + n * 16); *(f32x4*)(out + off + bj * HALF + n * 16) = bs + gv[bj][n] * acc[ai][bj][m][n]; } }
    }
};
#ifdef GATE_LOGITS
#define GSIG(x) sigmoid_f(x)
#else
#define GSIG(x) (x)
#endif
template <int MODE> struct EpiBf {
    static constexpr bool PERM = true, AFTER_DRAIN = false;
    bf16_t* O; int ldc; int split_cols; size_t split_stride; int qt; float qscale; const bf16_t* G;
    __device__ __forceinline__ void operator()(const f32x4 (&acc)[2][2][4][2], const Unit& u, int wr, int wc, int fr, int fq) const {
        const int row0 = u.pm * BM + wr * 64 + fr; int colt = u.pn * BM; bf16_t* base = O; float sc = 1.f;
        if (MODE <= 1) { const int t = colt / split_cols; base += (size_t)t * split_stride; colt -= t * split_cols; if (MODE == 0 && t == qt) sc = qscale; }
        const int col0 = colt + wc * 32 + 8 * fq;
#pragma unroll
        for (int ai = 0; ai < 2; ++ai)
#pragma unroll
            for (int m = 0; m < 4; ++m) { const size_t roff = (size_t)(row0 + ai * HALF + m * 16) * ldc + col0;
#pragma unroll
                for (int bj = 0; bj < 2; ++bj) {
                    f32x4 v0 = acc[ai][bj][m][0], v1 = acc[ai][bj][m][1];
                    if (MODE == 0) { v0 = v0 * sc; v1 = v1 * sc; }
                    if (MODE == 1) {
#pragma unroll
                        for (int e = 0; e < 4; ++e) { v0[e] = sigmoid_f(v0[e]); v1[e] = sigmoid_f(v1[e]); } }
                    if (MODE >= 2) { const u32x4 g = *(const u32x4*)(G + roff + bj * HALF);
                        v0[0] *= GSIG(bf_lo(g.x)); v0[1] *= GSIG(bf_hi(g.x)); v0[2] *= GSIG(bf_lo(g.y)); v0[3] *= GSIG(bf_hi(g.y)); v1[0] *= GSIG(bf_lo(g.z)); v1[1] *= GSIG(bf_hi(g.z)); v1[2] *= GSIG(bf_lo(g.w)); v1[3] *= GSIG(bf_hi(g.w)); }
                    if (MODE == 3) { const u32x4 t = *(const u32x4*)(base + roff + bj * HALF);
                        v0[0] += bf_lo(t.x); v0[1] += bf_hi(t.x); v0[2] += bf_lo(t.y); v0[3] += bf_hi(t.y); v1[0] += bf_lo(t.z); v1[1] += bf_hi(t.z); v1[2] += bf_lo(t.w); v1[3] += bf_hi(t.w); }
                    u32x4 w; w.x = cvt_pk_bf16(v0[0], v0[1]); w.y = cvt_pk_bf16(v0[2], v0[3]); w.z = cvt_pk_bf16(v1[0], v1[1]); w.w = cvt_pk_bf16(v1[2], v1[3]);
                    *(u32x4*)(base + roff + bj * HALF) = w; } }
    }
};
struct EpiMerge {
    static constexpr bool PERM = true, AFTER_DRAIN = false, SEG = true;
    __host__ __device__ static constexpr bool keep_acc(int sg) { return sg == 3; }
    bf16_t* O; int ldc; bf16_t* GR; bf16_t* GD;
    __device__ __forceinline__ void operator()(f32x4 (&acc)[2][2][4][2], const Unit& u, int wr, int wc, int fr, int fq) const {
        const int row0 = u.pm * BM + wr * 64 + fr, col0 = u.pn * BM + wc * 32 + 8 * fq;
#pragma unroll
        for (int ai = 0; ai < 2; ++ai)
#pragma unroll
            for (int m = 0; m < 4; ++m) { const size_t roff = (size_t)(row0 + ai * HALF + m * 16) * ldc + col0;
#pragma unroll
                for (int bj = 0; bj < 2; ++bj) {
                    if (u.seg < 2) {
                        float v[8];
#pragma unroll
                        for (int e = 0; e < 8; ++e) v[e] = __builtin_fmaxf(acc[ai][bj][m][e >> 2][e & 3], -3.0e38f);
                        u32x4 w; w.x = cvt_pk_bf16(v[0], v[1]); w.y = cvt_pk_bf16(v[2], v[3]); w.z = cvt_pk_bf16(v[4], v[5]); w.w = cvt_pk_bf16(v[6], v[7]);
                        *(u32x4*)((u.seg == 0 ? GR : GD) + roff + bj * HALF) = w;
                    } else {
                        const u32x4 gd = *(const u32x4*)(GD + roff + bj * HALF);
                        const float d[8] = {bf_lo(gd.x), bf_hi(gd.x), bf_lo(gd.y), bf_hi(gd.y), bf_lo(gd.z), bf_hi(gd.z), bf_lo(gd.w), bf_hi(gd.w)};
                        if (u.seg == 2) {
                            const u32x4 gr = *(const u32x4*)(GR + roff + bj * HALF);
                            const float r[8] = {bf_lo(gr.x), bf_hi(gr.x), bf_lo(gr.y), bf_hi(gr.y), bf_lo(gr.z), bf_hi(gr.z), bf_lo(gr.w), bf_hi(gr.w)};
#pragma unroll
                            for (int e = 0; e < 8; ++e) { const float ed = __builtin_amdgcn_exp2f(-1.4426950408889634f * d[e]), er = __builtin_amdgcn_exp2f(-1.4426950408889634f * r[e]);
                                acc[ai][bj][m][e >> 2][e & 3] *= (1.0f + ed) * __builtin_amdgcn_rcpf(1.0f + er); }
                        } else {
                            float v[8];
#pragma unroll
                            for (int e = 0; e < 8; ++e) v[e] = acc[ai][bj][m][e >> 2][e & 3] * sigmoid_f(d[e]);
                            u32x4 w; w.x = cvt_pk_bf16(v[0], v[1]); w.y = cvt_pk_bf16(v[2], v[3]); w.z = cvt_pk_bf16(v[4], v[5]); w.w = cvt_pk_bf16(v[6], v[7]);
                            *(u32x4*)(O + roff + bj * HALF) = w; }
                    }
                } }
    }
};


template <class Epi, class Sched, bool ALIGN_EPI = false, bool SP2 = false>
__device__ __forceinline__ void gemm_phase(PG8_LAS unsigned char* lds, const Gemm g, const Sched& S, const Epi& E, const int wave_s) {
    const int lane = hw_lane(), wid = wave_s, tid = wave_s * 64 + lane, wr = wid >> 2, wc = wid & 3, fr = lane & 15, fq = lane >> 4;
    const int K = g.K, nt = K / BK;
    unsigned voffA[2], voffB[2];
#pragma unroll
    for (int i = 0; i < 2; ++i) { int R, C; stage_rc(tid * 16 + i * 8192, R, C); const int Rb = Epi::PERM ? ((R & ~31) + perm32(R & 31)) : R;
        voffA[i] = (unsigned)(R * K + C) * 2u; voffB[i] = (unsigned)(Rb * K + C) * 2u; }
    const size_t kstep = (size_t)(BK * 2);
    const size_t hstep = (size_t)HALF * K * 2;
    const size_t tstep = 2 * hstep;
    const unsigned ldsw = (unsigned)wid * 1024u;
    const int aoff = lds_byte(wr * 64 + fr, fq * 8), boff = lds_byte(wc * 32 + fr, fq * 8);
#define PG8_SA(b, h) (((b) * 2 + (h)) * HTB)
#define PG8_SB(b, h) ((4 + (b) * 2 + (h)) * HTB)
#define PG8_STAGE(bufoff, gbase, voff) do { _Pragma("unroll") for (int _i = 0; _i < 2; ++_i) \
        __builtin_amdgcn_global_load_lds((const unsigned*)((const char*)(gbase) + (voff)[_i]), (PG8_LAS unsigned*)(lds + (bufoff) + ldsw + _i * 8192), 16, 0, 0); } while (0)
#define PG8_LDA(dst, b, h) do { _Pragma("unroll") for (int m = 0; m < 4; ++m) _Pragma("unroll") for (int k = 0; k < 2; ++k) dst[m][k] = *(const PG8_LAS bf16x8*)(lds + PG8_SA(b, h) + aoff + m * 2048 + k * 1024); } while (0)
#define PG8_LDB(dst, b, h) do { _Pragma("unroll") for (int n = 0; n < 2; ++n) _Pragma("unroll") for (int k = 0; k < 2; ++k) dst[n][k] = *(const PG8_LAS bf16x8*)(lds + PG8_SB(b, h) + boff + n * 2048 + k * 1024); } while (0)
#define PG8_MMA(ai, bj, At, Bt) do { __builtin_amdgcn_s_setprio(1); _Pragma("unroll") for (int m = 0; m < 4; ++m) _Pragma("unroll") for (int n = 0; n < 2; ++n) _Pragma("unroll") for (int k = 0; k < 2; ++k) \
        acc[ai][bj][m][n] = __builtin_amdgcn_mfma_f32_16x16x32_bf16(Bt[n][k], At[m][k], acc[ai][bj][m][n], 0, 0, 0); __builtin_amdgcn_s_setprio(0); } while (0)
#define PG8_WAIT_V(n) asm volatile("s_waitcnt vmcnt(" #n ")" ::: "memory")
#define PG8_WAIT_L(n) asm volatile("s_waitcnt lgkmcnt(" #n ")" ::: "memory")
#define PG8_BAR __builtin_amdgcn_s_barrier()
#define PG8_SCHED __builtin_amdgcn_sched_barrier(0)
    Unit cur, nxt; int ui = 0;
    if (!S.next(0, cur)) return;
    f32x4 acc[2][2][4][2];
#pragma unroll
    for (int a = 0; a < 2; ++a)
#pragma unroll
        for (int b = 0; b < 2; ++b)
#pragma unroll
            for (int m = 0; m < 4; ++m)
#pragma unroll
                for (int n = 0; n < 2; ++n) acc[a][b][m][n] = (f32x4){0.f, 0.f, 0.f, 0.f};
    bf16x8 At[4][2], B0[2][2], B1[2][2];
    const char* cA = (const char*)seg_a(g, cur.seg) + (size_t)cur.pm * tstep; const char* cB = (const char*)seg_b(g, cur.seg) + (size_t)cur.pn * tstep;
    S.a_ready(cur);
    if constexpr (SP2) {
        PG8_STAGE(PG8_SB(0, 0), cB, voffB); PG8_STAGE(PG8_SB(0, 1), cB + hstep, voffB); PG8_STAGE(PG8_SA(0, 0), cA, voffA); PG8_STAGE(PG8_SA(0, 1), cA + hstep, voffA);
        if (wr == 1) PG8_BAR;
        PG8_WAIT_V(2); PG8_BAR;
        PG8_STAGE(PG8_SB(1, 0), cB + kstep, voffB); PG8_STAGE(PG8_SA(1, 0), cA + kstep, voffA); PG8_STAGE(PG8_SB(1, 1), cB + hstep + kstep, voffB);
        PG8_WAIT_V(6); PG8_BAR;
    } else {
        PG8_STAGE(PG8_SB(0, 0), cB, voffB); PG8_STAGE(PG8_SA(0, 0), cA, voffA); PG8_STAGE(PG8_SB(0, 1), cB + hstep, voffB); PG8_STAGE(PG8_SA(0, 1), cA + hstep, voffA);
        if (wr == 1) PG8_BAR;
        PG8_WAIT_V(4); PG8_BAR;
        PG8_STAGE(PG8_SB(1, 0), cB + kstep, voffB); PG8_STAGE(PG8_SA(1, 0), cA + kstep, voffA); PG8_STAGE(PG8_SB(1, 1), cB + hstep + kstep, voffB);
        PG8_WAIT_V(6); PG8_BAR;
    }
    for (;;) {
        const bool has_next = S.next(ui + 1, nxt);
        const char* nA = has_next ? (const char*)seg_a(g, nxt.seg) + (size_t)nxt.pm * tstep : cA; const char* nB = has_next ? (const char*)seg_b(g, nxt.seg) + (size_t)nxt.pn * tstep : cB;
        for (int t = 0; t < nt; t += 2) {
            const bool last = (t == nt - 2);
            const char* a1 = cA + (size_t)(t + 1) * kstep;
            const char* a2 = last ? nA : cA + (size_t)(t + 2) * kstep; const char* b2 = last ? nB : cB + (size_t)(t + 2) * kstep;
            const char* a3 = a2 + kstep; const char* b3 = b2 + kstep;
            if (last && has_next) S.a_ready(nxt);
            if constexpr (SP2) {
            PG8_LDB(B0, 0, 0); PG8_LDB(B1, 0, 1); PG8_SCHED; PG8_LDA(At, 0, 0); PG8_STAGE(PG8_SA(1, 1), a1 + hstep, voffA);
            PG8_WAIT_V(8); PG8_WAIT_L(0); PG8_BAR; PG8_MMA(0, 0, At, B0); PG8_MMA(0, 1, At, B1); PG8_BAR; PG8_SCHED;
            PG8_LDA(At, 0, 1); PG8_STAGE(PG8_SB(0, 0), b2, voffB); PG8_STAGE(PG8_SB(0, 1), b2 + hstep, voffB); PG8_STAGE(PG8_SA(0, 0), a2, voffA);
            PG8_WAIT_V(8); PG8_WAIT_L(0); PG8_BAR; PG8_MMA(1, 0, At, B0); PG8_MMA(1, 1, At, B1); PG8_BAR; PG8_SCHED;
            PG8_LDB(B0, 1, 0); PG8_LDB(B1, 1, 1); PG8_SCHED; PG8_LDA(At, 1, 0); PG8_STAGE(PG8_SA(0, 1), a2 + hstep, voffA);
            PG8_WAIT_V(8); PG8_WAIT_L(0); PG8_BAR; PG8_MMA(0, 0, At, B0); PG8_MMA(0, 1, At, B1); PG8_BAR; PG8_SCHED;
            PG8_LDA(At, 1, 1); PG8_STAGE(PG8_SB(1, 0), b3, voffB); PG8_STAGE(PG8_SB(1, 1), b3 + hstep, voffB); PG8_STAGE(PG8_SA(1, 0), a3, voffA);
            PG8_WAIT_V(8); PG8_WAIT_L(0); PG8_BAR; PG8_MMA(1, 0, At, B0); PG8_MMA(1, 1, At, B1); PG8_BAR; PG8_SCHED;
            } else {
            PG8_LDB(B0, 0, 0); PG8_SCHED; PG8_LDA(At, 0, 0); PG8_STAGE(PG8_SA(1, 1), a1 + hstep, voffA);
            PG8_WAIT_L(8); PG8_BAR; PG8_WAIT_L(0); PG8_MMA(0, 0, At, B0); PG8_BAR; PG8_SCHED;
            PG8_LDB(B1, 0, 1); PG8_STAGE(PG8_SB(0, 0), b2, voffB);
            PG8_BAR; PG8_WAIT_L(0); PG8_MMA(0, 1, At, B1); PG8_BAR;
            PG8_LDA(At, 0, 1); PG8_STAGE(PG8_SA(0, 0), a2, voffA);
            PG8_BAR; PG8_WAIT_L(0); PG8_MMA(1, 0, At, B0); PG8_BAR; PG8_SCHED;
            PG8_STAGE(PG8_SB(0, 1), b2 + hstep, voffB);
            PG8_WAIT_V(6); PG8_BAR; PG8_MMA(1, 1, At, B1); PG8_BAR;
            PG8_LDB(B0, 1, 0); PG8_SCHED; PG8_LDA(At, 1, 0); PG8_STAGE(PG8_SA(0, 1), a2 + hstep, voffA);
            PG8_WAIT_L(8); PG8_BAR; PG8_WAIT_L(0); PG8_MMA(0, 0, At, B0); PG8_BAR; PG8_SCHED;
            PG8_LDB(B1, 1, 1); PG8_STAGE(PG8_SB(1, 0), b3, voffB);
            PG8_BAR; PG8_WAIT_L(0); PG8_MMA(0, 1, At, B1); PG8_BAR;
            PG8_LDA(At, 1, 1); PG8_STAGE(PG8_SA(1, 0), a3, voffA);
            PG8_BAR; PG8_WAIT_L(0); PG8_MMA(1, 0, At, B0); PG8_BAR; PG8_SCHED;
            PG8_STAGE(PG8_SB(1, 1), b3 + hstep, voffB);
            PG8_WAIT_V(6); PG8_BAR; PG8_MMA(1, 1, At, B1); PG8_BAR;
            }
        }
        if constexpr (ALIGN_EPI) { if (wr == 0) PG8_BAR; }
        if constexpr (!Epi::AFTER_DRAIN) { E(acc, cur, wr, wc, fr, fq); S.done(cur); }
        if (!has_next) break;
        if (!epi_keep<Epi>(nxt.seg)) {
#pragma unroll
        for (int a = 0; a < 2; ++a)
#pragma unroll
            for (int b = 0; b < 2; ++b)
#pragma unroll
                for (int m = 0; m < 4; ++m)
#pragma unroll
                    for (int n = 0; n < 2; ++n) acc[a][b][m][n] = (f32x4){0.f, 0.f, 0.f, 0.f};
        }
        cur = nxt; cA = nA; cB = nB; ++ui;
        if constexpr (ALIGN_EPI) { if (wr == 1) PG8_BAR; }
    }
    PG8_WAIT_V(0);
    if constexpr (!ALIGN_EPI) { if (wr == 0) PG8_BAR; }
    PG8_BAR;
    if constexpr (Epi::AFTER_DRAIN) { E.fused(acc, cur, wr, wc, fr, fq, lds, wid, lane); S.done(cur); }
#undef PG8_SA
#undef PG8_SB
#undef PG8_STAGE
#undef PG8_LDA
#undef PG8_LDB
#undef PG8_MMA
#undef PG8_WAIT_V
#undef PG8_WAIT_L
#undef PG8_BAR
#undef PG8_SCHED
}
}

#define LAS __attribute__((address_space(3)))
typedef unsigned short bf16;
typedef float f32x4 __attribute__((ext_vector_type(4)));
typedef float f32x16 __attribute__((ext_vector_type(16)));
typedef short bf16x8 __attribute__((ext_vector_type(8)));
typedef short s16x4 __attribute__((ext_vector_type(4)));
typedef unsigned u32x4 __attribute__((ext_vector_type(4)));
typedef unsigned u32x2 __attribute__((ext_vector_type(2)));

constexpr int DM = 1024, NB = 8, SEQ = 8192, DEPTH = 4, MROWS = NB * SEQ, DFF = 2816, INW = 8192, NMOD = 9 * DM;
constexpr int NWAVES = 8, NTHR = 512;
constexpr float NORM_EPS = 1e-6f, LOG2E = 1.4426950408889634f;
constexpr size_t MiB = 1u << 20;
constexpr size_t WS_CTL = 0;
constexpr size_t WS_MOD = 1 * MiB;
constexpr size_t WS_WT = 4 * MiB;
constexpr size_t W_UPA = 0, W_DNA = W_UPA + (size_t)2 * DFF * DM, W_UPB = W_DNA + (size_t)DM * DFF, W_DNB = W_UPB + (size_t)2 * DFF * DM,
                 W_IN = W_DNB + (size_t)DM * DFF, W_RET = W_IN + (size_t)INW * DM, W_DIF = W_RET + (size_t)DM * DM, W_OUT = W_DIF + (size_t)DM * DM, W_END = W_OUT + (size_t)DM * DM;
constexpr size_t WS_H = 64 * MiB;
constexpr size_t ACT = (size_t)MROWS * DM * 2;
constexpr size_t WS_B0 = 192 * MiB;
constexpr size_t WS_HID = WS_B0;
constexpr size_t WS_END = WS_B0 + 6 * ACT;
static_assert(WS_WT + W_END * 2 <= WS_H && WS_END <= 1024 * MiB, "d_ws map");

struct Args { const float* in[18]; float* out; unsigned char* ws; };

__device__ __forceinline__ float shx(float v, int m, int lane) { return __int_as_float(__builtin_amdgcn_ds_bpermute((lane ^ m) << 2, __float_as_int(v))); }
__device__ __forceinline__ float wave_sum(float v, int lane) {
#pragma unroll
    for (int o = 1; o < 64; o <<= 1) v += shx(v, o, lane);
    return v;
}
__device__ __forceinline__ unsigned f2bf(float f) { unsigned u = __float_as_uint(f); return (u + 0x7fffu + ((u >> 16) & 1u)) >> 16; }
__device__ __forceinline__ unsigned pk2(float lo, float hi) { return pg8::cvt_pk_bf16(lo, hi); }
typedef __bf16 bf16x2_cv __attribute__((ext_vector_type(2))); typedef float f32x2_cv __attribute__((ext_vector_type(2)));
__device__ __forceinline__ unsigned pk2v(float lo, float hi) { f32x2_cv v = {lo, hi}; bf16x2_cv b = __builtin_convertvector(v, bf16x2_cv); return __builtin_bit_cast(unsigned, b); }
__device__ __forceinline__ float bflo(unsigned w) { return __uint_as_float(w << 16); }
__device__ __forceinline__ float bfhi(unsigned w) { return __uint_as_float(w & 0xffff0000u); }
__device__ __forceinline__ float sgpr_f(float v) { return __int_as_float(__builtin_amdgcn_readfirstlane(__float_as_int(v))); }
__device__ __forceinline__ int launder(int v) { asm volatile("" : "+v"(v)); return v; }
#define LDS_WAIT() asm volatile("s_waitcnt lgkmcnt(0)" ::: "memory")
#define LDS_BARRIER() do { asm volatile("s_waitcnt lgkmcnt(0)" ::: "memory"); __builtin_amdgcn_s_barrier(); asm volatile("" ::: "memory"); } while (0)
#define MFMA32(a, b, c) __builtin_amdgcn_mfma_f32_32x32x16_bf16((a), (b), (c), 0, 0, 0)
__device__ __forceinline__ int crow(int r, int hi) { return (r & 3) + 8 * (r >> 2) + 4 * hi; }
typedef short v4i16_t __attribute__((ext_vector_type(4)));
__device__ __forceinline__ s16x4 tr_read(const LAS unsigned char* p) { return __builtin_bit_cast(s16x4, __builtin_amdgcn_ds_read_tr16_b64_v4i16((LAS v4i16_t*)p)); }
__device__ __forceinline__ bf16x8 cat8(s16x4 lo, s16x4 hi) { return (bf16x8){lo[0], lo[1], lo[2], lo[3], hi[0], hi[1], hi[2], hi[3]}; }
__device__ __forceinline__ bf16x8 pack8v(const f32x16& x, int s) {
    u32x4 p; p.x = pk2v(x[8 * s], x[8 * s + 1]); p.y = pk2v(x[8 * s + 2], x[8 * s + 3]); p.z = pk2v(x[8 * s + 4], x[8 * s + 5]); p.w = pk2v(x[8 * s + 6], x[8 * s + 7]);
    return __builtin_bit_cast(bf16x8, p);
}
__device__ __forceinline__ bf16x8 pack8(const f32x16& x, int s) {
    u32x4 p; p.x = pk2(x[8 * s], x[8 * s + 1]); p.y = pk2(x[8 * s + 2], x[8 * s + 3]); p.z = pk2(x[8 * s + 4], x[8 * s + 5]); p.w = pk2(x[8 * s + 6], x[8 * s + 7]);
    return __builtin_bit_cast(bf16x8, p);
}

template <bool UPPERM>
__device__ __forceinline__ void transpose_item(const float* W, int K, int N, bf16* WT, LAS float* scr, int item, int lane) {
    const int nblk = N / 32, kb = item / nblk, nb = item % nblk, k0 = 64 * kb, n0 = 32 * nb;
#pragma unroll 8
    for (int i = 0; i < 32; ++i) { const int kk = 2 * i + (lane >> 5); scr[kk * 33 + (lane & 31)] = W[(size_t)(k0 + kk) * N + n0 + (lane & 31)]; }
    LDS_WAIT(); asm volatile("" ::: "memory");
    int d0 = n0;
    if (UPPERM) { const int half = n0 / DFF, j = n0 % DFF; d0 = (j / 128) * 256 + half * 128 + (j % 128); }
    const int c = lane & 7;
#pragma unroll
    for (int j = 0; j < 4; ++j) { const int n = (lane >> 3) + 8 * j; const LAS float* s = scr + (8 * c) * 33 + n;
        u32x4 o; o.x = pk2(s[0 * 33], s[1 * 33]); o.y = pk2(s[2 * 33], s[3 * 33]); o.z = pk2(s[4 * 33], s[5 * 33]); o.w = pk2(s[6 * 33], s[7 * 33]);
        *(u32x4*)(WT + (size_t)(d0 + n) * K + k0 + 8 * c) = o; }
    LDS_WAIT(); asm volatile("" ::: "memory");
}
__device__ __forceinline__ void convert_weights(const Args& a, int l, LAS unsigned char* lds, int gw, int ngw, int wave, int lane) {
    lane = launder(lane);
    LAS float* scr = (LAS float*)(lds + wave * 16384);
    bf16* WT = (bf16*)(a.ws + WS_WT);
    const float* up = a.in[5] + (size_t)l * 2 * DM * 2 * DFF; const float* dn = a.in[6] + (size_t)l * 2 * DFF * DM;
    const float* win = a.in[7] + (size_t)l * DM * INW; const float* wr = a.in[14] + (size_t)l * DM * DM; const float* wd = a.in[15] + (size_t)l * DM * DM; const float* wo = a.in[16] + (size_t)l * DM * DM;
    constexpr int I_UP = (DM / 64) * (2 * DFF / 32), I_DN = (DFF / 64) * (DM / 32), I_IN = (DM / 64) * (INW / 32), I_SQ = (DM / 64) * (DM / 32);
    constexpr int NITEMS = 2 * I_UP + 2 * I_DN + I_IN + 3 * I_SQ;
    for (int it = gw; it < NITEMS; it += ngw) {
        int r = it;
        if (r < I_UP) { transpose_item<true>(up, DM, 2 * DFF, WT + W_UPA, scr, r, lane); continue; } r -= I_UP;
        if (r < I_UP) { transpose_item<true>(up + (size_t)DM * 2 * DFF, DM, 2 * DFF, WT + W_UPB, scr, r, lane); continue; } r -= I_UP;
        if (r < I_DN) { transpose_item<false>(dn, DFF, DM, WT + W_DNA, scr, r, lane); continue; } r -= I_DN;
        if (r < I_DN) { transpose_item<false>(dn + (size_t)DFF * DM, DFF, DM, WT + W_DNB, scr, r, lane); continue; } r -= I_DN;
        if (r < I_IN) { transpose_item<false>(win, DM, INW, WT + W_IN, scr, r, lane); continue; } r -= I_IN;
        if (r < I_SQ) { transpose_item<false>(wr, DM, DM, WT + W_RET, scr, r, lane); continue; } r -= I_SQ;
        if (r < I_SQ) { transpose_item<false>(wd, DM, DM, WT + W_DIF, scr, r, lane); continue; } r -= I_SQ;
        transpose_item<false>(wo, DM, DM, WT + W_OUT, scr, r, lane);
    }
}
__device__ __forceinline__ void ada_phase(const Args& a, LAS unsigned char* lds, int wave, int lane) {
    lane = launder(lane);
    LAS float* sc = (LAS float*)lds; LAS float* part = (LAS float*)(lds + 32768);
    const float* c = a.in[1];
    for (int i = wave * 64 + lane; i < NB * DM; i += NTHR) { const float v = c[i]; sc[i] = v * pg8::sigmoid_f(v); }
    __syncthreads();
    float* mod = (float*)(a.ws + WS_MOD);
    constexpr int NIT = DEPTH * (NMOD / 64);
    for (int it = blockIdx.x; it < NIT; it += gridDim.x) {
        const int l = it / (NMOD / 64), j = (it % (NMOD / 64)) * 64 + lane;
        const float* w = a.in[2] + (size_t)l * DM * NMOD + j;
        float acc[NB];
#pragma unroll
        for (int b = 0; b < NB; ++b) acc[b] = 0.f;
        const int k0 = wave * 128;
#pragma unroll 8
        for (int k = 0; k < 128; ++k) { const float wv = w[(size_t)(k0 + k) * NMOD];
#pragma unroll
            for (int b = 0; b < NB; ++b) acc[b] += sc[b * DM + k0 + k] * wv; }
#pragma unroll
        for (int b = 0; b < NB; ++b) part[(wave * NB + b) * 64 + lane] = acc[b];
        __syncthreads();
        { const int b = wave; float s = a.in[3][(size_t)l * NMOD + j];
#pragma unroll
            for (int w8 = 0; w8 < 8; ++w8) s += part[(w8 * NB + b) * 64 + lane];
            mod[((size_t)l * NB + b) * NMOD + j] = s; }
        __syncthreads();
    }
}
template <int NR>
__device__ __forceinline__ void norm_mod_rows(const float* x, bf16* Hout, const float* const* mbp, const float* nw, const int* rows, int lane) {
    f32x4 v[NR][4]; float ss[NR];
#pragma unroll
    for (int r = 0; r < NR; ++r) { const f32x4* xr = (const f32x4*)(x + (size_t)rows[r] * DM) + lane;
#pragma unroll
        for (int j = 0; j < 4; ++j) v[r][j] = xr[64 * j]; }
#pragma unroll
    for (int r = 0; r < NR; ++r) { float s = 0.f;
#pragma unroll
        for (int j = 0; j < 4; ++j) s += (v[r][j].x * v[r][j].x + v[r][j].y * v[r][j].y) + (v[r][j].z * v[r][j].z + v[r][j].w * v[r][j].w);
        ss[r] = s; }
#pragma unroll
    for (int o = 1; o < 64; o <<= 1)
#pragma unroll
        for (int r = 0; r < NR; ++r) ss[r] += shx(ss[r], o, lane);
#pragma unroll
    for (int r = 0; r < NR; ++r) { const float rstd = 1.0f / sqrtf(ss[r] * (1.f / DM) + NORM_EPS); const float* shift = mbp[r]; const float* scale = mbp[r] + DM;
        u32x2* o8 = (u32x2*)(Hout + (size_t)rows[r] * DM) + lane;
#pragma unroll
        for (int j = 0; j < 4; ++j) { const int c4 = lane + 64 * j; const f32x4 w = ((const f32x4*)nw)[c4], sc = ((const f32x4*)scale)[c4], sh = ((const f32x4*)shift)[c4];
            const f32x4 o = v[r][j] * rstd * w * (sc + 1.0f) + sh; u32x2 p; p.x = pk2(o.x, o.y); p.y = pk2(o.z, o.w); o8[64 * j] = p; } }
}
__device__ __forceinline__ void norm_phase(const Args& a, const float* x, int l, int sub, int gw, int ngw, int lane) {
    lane = launder(lane);
    bf16* H = (bf16*)(a.ws + WS_H); const float* mod = (const float*)(a.ws + WS_MOD); const float* nw = a.in[4] + ((size_t)l * 3 + sub) * DM;
    constexpr int NR = 4;
    for (int m = gw; m < MROWS; m += NR * ngw) { int rows[NR]; const float* mbp[NR];
#pragma unroll
        for (int r = 0; r < NR; ++r) { rows[r] = m + r * ngw; if (rows[r] >= MROWS) rows[r] = m; mbp[r] = mod + ((size_t)l * NB + (rows[r] >> 13)) * NMOD + sub * 3 * DM; }
        norm_mod_rows<NR>(x, H, mbp, nw, rows, lane); }
}
__device__ __forceinline__ void final_norm_phase(const Args& a, int gw, int ngw, int lane) {
    lane = launder(lane);
    const float* fw = a.in[17];
#ifdef DBG_CHECK
    const float dbgs = 1.0f + (float)((const unsigned*)(a.ws + WS_CTL))[32];
#else
    const float dbgs = 1.0f;
#endif
    for (int m = gw; m < MROWS; m += ngw) { f32x4* xr = (f32x4*)(a.out + (size_t)m * DM) + lane;
        f32x4 v[4]; float s = 0.f;
#pragma unroll
        for (int j = 0; j < 4; ++j) { v[j] = xr[64 * j]; s += (v[j].x * v[j].x + v[j].y * v[j].y) + (v[j].z * v[j].z + v[j].w * v[j].w); }
        const float rstd = 1.0f / sqrtf(wave_sum(s, lane) * (1.f / DM) + NORM_EPS);
#pragma unroll
        for (int j = 0; j < 4; ++j) xr[64 * j] = v[j] * (rstd * dbgs) * ((const f32x4*)fw)[lane + 64 * j]; }
}

constexpr int R_Q = 0, R_K = R_Q + 64 * 272, R_QD = R_K + 64 * 272, R_KD = R_QD + 64 * 272, R_SC = R_KD + 64 * 320, R_V = R_SC + 64 * 144, R_DEC = R_V + 64 * 576, R_END = R_DEC + 256;
static_assert(R_END <= 131072 && 64 * 1040 <= R_DEC, "retention LDS");
__device__ __forceinline__ void retention_unit(const Args& a, int l, int b, int h, LAS unsigned char* lds, const int wave_s, const bool dummy = false) {
    asm volatile("" : "+s"(h));
    const int lane = hw_lane(), wave = wave_s, tid = wave_s * 64 + lane, r32 = lane & 31, hh = lane >> 5;
    const int q4 = (lane & 15) >> 2, p4 = lane & 3, g1 = (lane >> 4) & 1;
    const bf16* RQK = (const bf16*)(a.ws + WS_B0); const bf16* RV = (const bf16*)(a.ws + WS_B0 + ACT); bf16* RG = (bf16*)(a.ws + WS_B0 + 2 * ACT);
    const float* gn = a.in[8] + (size_t)l * DM + h * 256;
    const float lg = sgpr_f(log2f(1.0f - exp2f(-5.0f - (float)h)));
    const float sc_qk = 0.08838834764831845f;
    const float cdec = sgpr_f(exp2f(lg * 64.f));
    const size_t row0 = (size_t)b * SEQ;
    f32x16 S[4];
#pragma unroll
    for (int i = 0; i < 4; ++i) S[i] = f32x16{};
    u32x4 pq[2], pk[2], pv[4]; u32x2 prg[8];
    const int er = tid >> 3, es = tid & 7;
#ifdef USE_RSB
#define RSB() __builtin_amdgcn_sched_barrier(0)
#else
#define RSB() do {} while (0)
#endif
#define R_PREFETCH(ci) do { const size_t t0 = row0 + (size_t)(ci) * 64; \
        _Pragma("unroll") for (int i = 0; i < 2; ++i) { const int idx = tid + 512 * i, rr = idx >> 4, ch = idx & 15; \
            pq[i] = *(const u32x4*)(RQK + (t0 + rr) * DM + h * 128 + ch * 8); pk[i] = *(const u32x4*)(RQK + (t0 + rr) * DM + 512 + h * 128 + ch * 8); } \
        _Pragma("unroll") for (int i = 0; i < 4; ++i) { const int idx = tid + 512 * i, rr = idx >> 5, ch = idx & 31; pv[i] = *(const u32x4*)(RV + (t0 + rr) * DM + h * 256 + ch * 8); } } while (0)
#define R_STORE() do { \
        _Pragma("unroll") for (int i = 0; i < 2; ++i) { const int idx = tid + 512 * i, rr = idx >> 4, ch = idx & 15; \
            *(LAS u32x4*)(lds + R_Q + rr * 272 + ch * 16) = pq[i]; *(LAS u32x4*)(lds + R_K + rr * 272 + ch * 16) = pk[i]; \
            const float fqd = exp2f(lg * (float)rr); u32x4 qd; \
            qd.x = pk2(bflo(pq[i].x) * fqd, bfhi(pq[i].x) * fqd); qd.y = pk2(bflo(pq[i].y) * fqd, bfhi(pq[i].y) * fqd); qd.z = pk2(bflo(pq[i].z) * fqd, bfhi(pq[i].z) * fqd); qd.w = pk2(bflo(pq[i].w) * fqd, bfhi(pq[i].w) * fqd); \
            *(LAS u32x4*)(lds + R_QD + rr * 272 + ch * 16) = qd; \
            const float f = sc_qk * exp2f(lg * (float)(64 - rr)); u32x4 kd; \
            kd.x = pk2(bflo(pk[i].x) * f, bfhi(pk[i].x) * f); kd.y = pk2(bflo(pk[i].y) * f, bfhi(pk[i].y) * f); kd.z = pk2(bflo(pk[i].z) * f, bfhi(pk[i].z) * f); kd.w = pk2(bflo(pk[i].w) * f, bfhi(pk[i].w) * f); \
            *(LAS u32x4*)(lds + R_KD + rr * 320 + ch * 16) = kd; } \
        _Pragma("unroll") for (int i = 0; i < 4; ++i) { const int idx = tid + 512 * i, rr = idx >> 5, ch = idx & 31; *(LAS u32x4*)(lds + R_V + rr * 576 + ch * 16) = pv[i]; } } while (0)
    R_PREFETCH(0);
    if (tid < 64) *(LAS float*)(lds + R_DEC + tid * 4) = sc_qk * exp2f(lg * (float)tid);
    R_STORE();
    LDS_BARRIER();
    for (int ci = 0; ci < SEQ / 64; ++ci) {
        const size_t t0 = row0 + (size_t)ci * 64;
        float lgl = lg;
#ifdef LGL
        asm volatile("" : "+v"(lgl));
#endif
        if (ci + 1 < SEQ / 64) R_PREFETCH(ci + 1);
#ifndef RG_LATE
#pragma unroll
        for (int j = 0; j < 8; ++j) prg[j] = *(const u32x2*)(RG + (t0 + er) * DM + h * 256 + 4 * (es + 8 * j));
#endif
        RSB();
        if (wave < 4) {
            const int qb = wave >> 1, kb = wave & 1; f32x16 x = f32x16{};
#pragma unroll
            for (int ks = 0; ks < 8; ++ks) { const bf16x8 af = *(const LAS bf16x8*)(lds + R_Q + (32 * qb + r32) * 272 + (16 * ks + 8 * hh) * 2);
                const bf16x8 bfr = *(const LAS bf16x8*)(lds + R_K + (32 * kb + r32) * 272 + (16 * ks + 8 * hh) * 2); x = MFMA32(af, bfr, x); }
#pragma unroll
            for (int i = 0; i < 16; ++i) { const int q = 32 * qb + crow(i, hh), k = 32 * kb + r32; const int d = q > k ? q - k : k - q;
                const float v = x[i] * *(const LAS float*)(lds + R_DEC + d * 4); *(LAS unsigned short*)(lds + R_SC + q * 144 + k * 2) = (unsigned short)f2bf(v); }
        }
        RSB();
        f32x16 y[2]; y[0] = f32x16{}; y[1] = f32x16{};
#pragma unroll
        for (int dkb = 0; dkb < 4; ++dkb)
#pragma unroll
            for (int s = 0; s < 2; ++s) { const bf16x8 sp = pack8(S[dkb], s);
#pragma unroll
                for (int qb = 0; qb < 2; ++qb) { const LAS unsigned char* qp = lds + R_QD + (32 * qb + r32) * 272 + (32 * dkb + 16 * s + 4 * hh) * 2;
                    const s16x4 lo = *(const LAS s16x4*)qp, hi = *(const LAS s16x4*)(qp + 16); y[qb] = MFMA32(cat8(lo, hi), sp, y[qb]); } }
        RSB();
        LDS_BARRIER();
        bf16x8 vf[4];
#pragma unroll
        for (int ks = 0; ks < 4; ++ks) { const LAS unsigned char* vp = lds + R_V + (16 * ks + 8 * hh + q4) * 576 + (32 * wave + 16 * g1) * 2 + 8 * p4; vf[ks] = cat8(tr_read(vp), tr_read(vp + 4 * 576)); }
#pragma unroll
        for (int ks = 0; ks < 4; ++ks)
#pragma unroll
            for (int qb = 0; qb < 2; ++qb) { const bf16x8 af = *(const LAS bf16x8*)(lds + R_SC + (32 * qb + r32) * 144 + (16 * ks + 8 * hh) * 2); y[qb] = MFMA32(af, vf[ks], y[qb]); }
        RSB();
#pragma unroll
        for (int dkb = 0; dkb < 4; ++dkb) {
#pragma unroll
            for (int i = 0; i < 16; ++i) S[dkb][i] *= cdec;
#pragma unroll
            for (int ks = 0; ks < 4; ++ks) { const LAS unsigned char* kp = lds + R_KD + (16 * ks + 8 * hh + q4) * 320 + (32 * dkb + 16 * g1) * 2 + 8 * p4;
                S[dkb] = MFMA32(cat8(tr_read(kp), tr_read(kp + 4 * 320)), vf[ks], S[dkb]); } }
        LDS_BARRIER();
#ifdef RG_LATE
#pragma unroll
        for (int j = 0; j < 8; ++j) prg[j] = *(const u32x2*)(RG + (t0 + er) * DM + h * 256 + 4 * (es + 8 * j));
#endif
#pragma unroll
        for (int qb = 0; qb < 2; ++qb)
#pragma unroll
            for (int i = 0; i < 16; ++i) *(LAS float*)(lds + (32 * qb + crow(i, hh)) * 1040 + (32 * wave + r32) * 4) = y[qb][i];
        LDS_BARRIER();
        { f32x4 yv[8]; float ss = 0.f;
#pragma unroll
            for (int j = 0; j < 8; ++j) { yv[j] = *(const LAS f32x4*)(lds + er * 1040 + 16 * (es + 8 * j)); ss += (yv[j].x * yv[j].x + yv[j].y * yv[j].y) + (yv[j].z * yv[j].z + yv[j].w * yv[j].w); }
            ss += shx(ss, 1, lane); ss += shx(ss, 2, lane); ss += shx(ss, 4, lane);
            const float rstd = 1.0f / sqrtf(ss * (1.f / 256.f) + NORM_EPS);
#pragma unroll
            for (int j = 0; j < 8; ++j) { const int c = 4 * (es + 8 * j); const f32x4 w = *(const f32x4*)(gn + c);
                const float g0 = bflo(prg[j].x), g1v = bfhi(prg[j].x), g2 = bflo(prg[j].y), g3 = bfhi(prg[j].y);
                u32x2 o; o.x = pk2(yv[j].x * rstd * w.x * g0 * pg8::sigmoid_f(g0), yv[j].y * rstd * w.y * g1v * pg8::sigmoid_f(g1v));
                o.y = pk2(yv[j].z * rstd * w.z * g2 * pg8::sigmoid_f(g2), yv[j].w * rstd * w.w * g3 * pg8::sigmoid_f(g3));
                if (!dummy || rstd == -12345.f) *(u32x2*)(RG + (t0 + er) * DM + h * 256 + c) = o; } }
        LDS_BARRIER();
        if (ci + 1 < SEQ / 64) R_STORE();
        LDS_BARRIER();
    }
#undef R_PREFETCH
#undef R_STORE
}

constexpr int A_KS = 272, A_VS = 320, A_KB = 64 * A_KS, A_VB = 64 * A_VS, A_BUF = A_KB + A_VB, A_X = 0;
static_assert(2 * A_BUF <= 131072 && 4 * 64 * 64 * 4 <= 131072, "attention LDS");
__device__ __forceinline__ void attn_unit(const Args& a, int l, int b, int h, int qb, float lam, float post, LAS unsigned char* lds, const int wave_s, const bool dummy = false) {
    asm volatile("" : "+s"(h));
    const int lane = hw_lane(), wave = wave_s, tid = wave_s * 64 + lane, r32 = lane & 31, hh = lane >> 5;
    const int q4 = (lane & 15) >> 2, p4 = lane & 3, g1 = (lane >> 4) & 1;
    const int sub = wave >> 2, wq = wave & 3;
    bf16* DQ = (bf16*)(a.ws + WS_B0 + 3 * ACT); const bf16* DK = (const bf16*)(a.ws + WS_B0 + 4 * ACT); const bf16* DV = (const bf16*)(a.ws + WS_B0 + 5 * ACT);
    const size_t row0 = (size_t)b * SEQ; const int q0 = qb * 128;
    const int NT = 2 * qb + 2;
    const float sl2 = sgpr_f(exp2f(-(float)(h + 1)) * LOG2E);
    bf16x8 qf[4];
    { const bf16* qp = DQ + (row0 + q0 + 32 * wq + r32) * DM + h * 128 + sub * 64 + 8 * hh;
#pragma unroll
        for (int ks = 0; ks < 4; ++ks) qf[ks] = *(const bf16x8*)(qp + 16 * ks); }
    u32x4 pk[2], pv[2];
#define A_PREFETCH(t) do { const size_t t0 = row0 + (size_t)(t) * 64; \
        _Pragma("unroll") for (int i = 0; i < 2; ++i) { const int idx = tid + 512 * i, rr = idx >> 4, ch = idx & 15; \
            pk[i] = *(const u32x4*)(DK + (t0 + rr) * DM + h * 128 + ch * 8); pv[i] = *(const u32x4*)(DV + (t0 + rr) * DM + h * 128 + ch * 8); } } while (0)
#define A_STORE(bufo) do { \
        _Pragma("unroll") for (int i = 0; i < 2; ++i) { const int idx = tid + 512 * i, rr = idx >> 4, ch = idx & 15; \
            *(LAS u32x4*)(lds + (bufo) + rr * A_KS + ch * 16) = pk[i]; *(LAS u32x4*)(lds + (bufo) + A_KB + rr * A_VS + ch * 16) = pv[i]; } } while (0)
    f32x16 o[4];
#pragma unroll
    for (int i = 0; i < 4; ++i) o[i] = f32x16{};
    float mrun = -1e30f, lrun = 0.f;
    f32x16 cb;
#pragma unroll
    for (int i = 0; i < 16; ++i) cb[i] = sl2 * (float)((i & 3) + 8 * (i >> 2) + 4 * hh);
    const float c32 = sgpr_f(32.f * sl2);
    const int tq = NT - 2 + (wq >> 1);
    const float qin = (float)(32 * (wq & 1) + r32), qs = sl2 * qin;
    const int tmin = max(0, (int)ceilf((128.f * (float)qb - 63.f - 220.f / sl2) * (1.f / 64.f)));
    A_PREFETCH(NT - 1);
    A_STORE(0);
    LDS_BARRIER();
    for (int it = 0; it < NT - tmin; ++it) {
        const int t = NT - 1 - it, bufo = (it & 1) * A_BUF;
        if (t > tmin) A_PREFETCH(t - 1);
        if (t <= tq) {
            f32x16 s[2];
            s[0] = cb;
#pragma unroll
            for (int i = 0; i < 16; ++i) s[1][i] = cb[i] + c32;
#pragma unroll
            for (int kb = 0; kb < 2; ++kb)
#pragma unroll
                for (int ks = 0; ks < 4; ++ks) { const bf16x8 kf = *(const LAS bf16x8*)(lds + bufo + (32 * kb + r32) * A_KS + (sub * 64 + 16 * ks + 8 * hh) * 2); s[kb] = MFMA32(kf, qf[ks], s[kb]); }
            float ut = -sl2 * (qin + 64.f * (float)(tq - t));
            if (t == tq) {
                ut = 0.f;
#pragma unroll
                for (int i = 0; i < 16; ++i) { const float c0 = cb[i], c1 = cb[i] + c32; s[0][i] = s[0][i] - c0 - fabsf(qs - c0); s[1][i] = s[1][i] - c1 - fabsf(qs - c1); }
            }
            float mt = fmaxf(s[0][0], s[1][0]);
#pragma unroll
            for (int i = 1; i < 16; ++i) mt = fmaxf(fmaxf(mt, s[0][i]), s[1][i]);
            mt = fmaxf(mt, shx(mt, 32, lane)) + ut;
            if (__any(mt > mrun)) {
                const float mnew = fmaxf(mrun, mt), alpha = __builtin_amdgcn_exp2f(mrun - mnew); mrun = mnew; lrun *= alpha;
#pragma unroll
                for (int d4 = 0; d4 < 4; ++d4)
#pragma unroll
                    for (int i = 0; i < 16; ++i) o[d4][i] *= alpha;
            }
            const float ml = mrun - ut;
            float ps = 0.f;
#pragma unroll
            for (int kb = 0; kb < 2; ++kb)
#pragma unroll
                for (int i = 0; i < 16; ++i) { s[kb][i] = __builtin_amdgcn_exp2f(s[kb][i] - ml); ps += s[kb][i]; }
            lrun += ps;
            __builtin_amdgcn_sched_barrier(0);
            {
                const LAS unsigned char* vbase = lds + bufo + A_KB + (4 * hh + q4) * A_VS + (16 * g1) * 2 + 8 * p4;
                bf16x8 vcur[4], vnxt[4];
#pragma unroll
                for (int d4 = 0; d4 < 4; ++d4) vcur[d4] = cat8(tr_read(vbase + 64 * d4), tr_read(vbase + 64 * d4 + 8 * A_VS));
#pragma unroll
                for (int g = 0; g < 4; ++g) {
                    if (g < 3) {
#pragma unroll
                        for (int d4 = 0; d4 < 4; ++d4) vnxt[d4] = cat8(tr_read(vbase + (g + 1) * 16 * A_VS + 64 * d4), tr_read(vbase + (g + 1) * 16 * A_VS + 64 * d4 + 8 * A_VS)); }
                    const bf16x8 pf = pack8v(s[g >> 1], g & 1);
#pragma unroll
                    for (int d4 = 0; d4 < 4; ++d4) o[d4] = MFMA32(vcur[d4], pf, o[d4]);
                    __builtin_amdgcn_sched_barrier(0);
#pragma unroll
                    for (int d4 = 0; d4 < 4; ++d4) vcur[d4] = vnxt[d4];
                }
            }
        }
        if (t > tmin) A_STORE(((it + 1) & 1) * A_BUF);
        LDS_BARRIER();
    }
    lrun += shx(lrun, 32, lane);
    const float rl = 1.0f / lrun;
    if (sub == 1) {
#pragma unroll
        for (int d4 = 0; d4 < 4; ++d4)
#pragma unroll
            for (int i = 0; i < 16; ++i) *(LAS float*)(lds + A_X + ((wq * 64 + d4 * 16 + i) * 64 + lane) * 4) = o[d4][i] * rl;
    }
    __syncthreads();
    if (sub == 0) {
        float ss = 0.f;
#pragma unroll
        for (int d4 = 0; d4 < 4; ++d4)
#pragma unroll
            for (int i = 0; i < 16; ++i) { const float v = o[d4][i] * rl - lam * *(const LAS float*)(lds + A_X + ((wq * 64 + d4 * 16 + i) * 64 + lane) * 4); o[d4][i] = v; ss += v * v; }
        ss += shx(ss, 32, lane);
        const float rstd = post / sqrtf(ss * (1.f / 128.f) + NORM_EPS);
        const float* sw = a.in[13] + (size_t)l * 128;
        bf16* op = DQ + (row0 + q0 + 32 * wq + r32) * DM + h * 128;
#pragma unroll
        for (int d4 = 0; d4 < 4; ++d4)
#pragma unroll
            for (int g = 0; g < 4; ++g) { const int dv = 32 * d4 + 8 * g + 4 * hh; const f32x4 w = *(const f32x4*)(sw + dv);
                u32x2 pkd; pkd.x = pk2(o[d4][4 * g] * rstd * w.x, o[d4][4 * g + 1] * rstd * w.y); pkd.y = pk2(o[d4][4 * g + 2] * rstd * w.z, o[d4][4 * g + 3] * rstd * w.w);
                if (!dummy || rstd == -12345.f) *(u32x2*)(op + dv) = pkd; }
    }
    __syncthreads();
#undef A_PREFETCH
#undef A_STORE
}


#define XB_TMO      128
#define XB_XCNT(j)  (256  + 64 * (j))
#define XB_XSUB(j)  (1280 + 64 * (j))
#define XB_XGEN(j)  (2304 + 64 * (j))
#define XB_TOP      3328
#define XB_TOPGEN   3392
#define XCD_BAR_WORDS 3456
#define XB_SPIN_CAP (1u << 24)

__device__ __forceinline__ unsigned xb_ld(unsigned* p)              { return __hip_atomic_load(p, __ATOMIC_RELAXED, __HIP_MEMORY_SCOPE_AGENT); }
__device__ __forceinline__ unsigned xb_add(unsigned* p, unsigned v) { return __hip_atomic_fetch_add(p, v, __ATOMIC_RELAXED, __HIP_MEMORY_SCOPE_AGENT); }
__device__ __forceinline__ unsigned xb_xcc_id() { return (unsigned)__builtin_amdgcn_s_getreg((3 << 11) | 20) & 0xFu; }
#define XB_SPIN(cond, bar) do { unsigned _sp = 0; while (cond) { __builtin_amdgcn_s_sleep(1); \
    if ((++_sp & 255u) == 0u) { if (xb_ld(&(bar)[XB_TMO])) break; if (_sp > XB_SPIN_CAP) { atomicAdd(&(bar)[XB_TMO], 1u); break; } } } } while (0)

struct XcdBarrier {
    unsigned* bar; unsigned x;
    volatile LAS unsigned* st;
};

__device__ __forceinline__ XcdBarrier xcd_barrier_post(unsigned* bar, volatile LAS unsigned* st, bool first) {
    XcdBarrier b; b.bar = bar; b.x = xb_xcc_id(); b.st = st;
    if (first) (void)xb_add(&bar[XB_XCNT(b.x)], 1u);
    return b;
}
__device__ __forceinline__ void xcd_barrier_complete(unsigned* bar, unsigned x, unsigned& nloc, unsigned& nx) {
    const unsigned G = gridDim.x * gridDim.y * gridDim.z;
    unsigned sum, cnt, mine, sp = 0u;
    for (;;) {
        sum = 0u; cnt = 0u; mine = 0u;
#pragma unroll
        for (unsigned j = 0; j < 16; ++j) { const unsigned c = xb_ld(&bar[XB_XCNT(j)]); sum += c; cnt += (c > 0u) ? 1u : 0u; mine = (j == x) ? c : mine; }
        if (sum == G) break;
        __builtin_amdgcn_s_sleep(1);
        if ((++sp & 255u) == 0u) { if (xb_ld(&bar[XB_TMO])) break; if (sp > XB_SPIN_CAP) { atomicAdd(&bar[XB_TMO], 1u); break; } }
    }
    nloc = mine > 0u ? mine : 1u; nx = cnt > 0u ? cnt : 1u;
}

__device__ __forceinline__ void xcd_barrier(const XcdBarrier& b, const bool first) {
    asm volatile("s_waitcnt vmcnt(0)" ::: "memory");
    __syncthreads();
    if (first) {
        unsigned* bar = b.bar;
        __builtin_amdgcn_s_waitcnt(0);
        unsigned nloc = b.st[0], nx = b.st[1];
        if (nloc == 0u) { xcd_barrier_complete(bar, b.x, nloc, nx); b.st[0] = nloc; b.st[1] = nx; }
        const unsigned old = xb_add(&bar[XB_XSUB(b.x)], 1u);
        const unsigned gen = old / nloc;
        if (old + 1u == (gen + 1u) * nloc) {
            __builtin_amdgcn_fence(__ATOMIC_RELEASE, "agent");
            asm volatile("s_waitcnt vmcnt(0)" ::: "memory");
            const unsigned og = xb_add(&bar[XB_TOP], 1u);
            const unsigned tg = og / nx;
            if (og + 1u == (tg + 1u) * nx) xb_add(&bar[XB_TOPGEN], 1u);
            else XB_SPIN(xb_ld(&bar[XB_TOPGEN]) == tg, bar);
            __builtin_amdgcn_fence(__ATOMIC_ACQUIRE, "agent");
            xb_add(&bar[XB_XGEN(b.x)], 1u);
            asm volatile("s_waitcnt vmcnt(0)" ::: "memory");
        } else {
            XB_SPIN(xb_ld(&bar[XB_XGEN(b.x)]) == gen, bar);
            __builtin_amdgcn_fence(__ATOMIC_ACQUIRE, "agent");
            asm volatile("s_waitcnt vmcnt(0)" ::: "memory");
        }
    }
    __syncthreads();
}

#define CG_SYNC() do { asm volatile("s_waitcnt vmcnt(0) lgkmcnt(0)" ::: "memory"); __syncthreads(); grid.sync(); \
    __builtin_amdgcn_fence(__ATOMIC_ACQUIRE, "agent"); asm volatile("s_waitcnt vmcnt(0)" ::: "memory"); __syncthreads(); } while (0)
#define IS_T0 (wave_s == 0 && hw_lane() == 0)
#define GRID_SYNC() xcd_barrier(xbar, IS_T0)
constexpr int CW_BAR = 4096;
typedef const __attribute__((address_space(4))) Args* KArgsPtr;
#define PHASE_BEGIN Args a; { KArgsPtr ka_ = (KArgsPtr)__builtin_amdgcn_kernarg_segment_ptr(); asm volatile("" : "+s"(ka_)); _Pragma("unroll") for (int i_ = 0; i_ < 18; ++i_) a.in[i_] = ka_->in[i_]; a.out = ka_->out; a.ws = ka_->ws; } \
    const int lane = hw_lane(), wave = wave_s, tid = wave_s * 64 + lane; const int G = gridDim.x, gw = blockIdx.x * NWAVES + wave, ngw = G * NWAVES; \
    unsigned* ctl = (unsigned*)(a.ws + WS_CTL); const float* mod = (const float*)(a.ws + WS_MOD); bf16* WT = (bf16*)(a.ws + WS_WT); bf16* H = (bf16*)(a.ws + WS_H); bf16* HID = (bf16*)(a.ws + WS_HID); bf16* B0 = (bf16*)(a.ws + WS_B0); \
    (void)tid; (void)lane; (void)wave; (void)G; (void)gw; (void)ngw; (void)ctl; (void)mod; (void)WT; (void)H; (void)HID; (void)B0;
#define GEMM_RUN(EPI, ...) do { pg8::StaticOrder S; S.init(MROWS, g.N, G, (int)blockIdx.x); EPI E{__VA_ARGS__}; pg8::gemm_phase<EPI, pg8::StaticOrder, true, true>(lds, g, S, E, wave_s); } while (0)

__global__ void __launch_bounds__(NTHR, 2) hybrid_fwd(Args args_unused) {
    extern __shared__ __attribute__((aligned(16))) unsigned char lds_raw[];
    LAS unsigned char* lds = (LAS unsigned char*)lds_raw;
    cg::grid_group grid = cg::this_grid();
    const int wave_s = __builtin_amdgcn_readfirstlane((int)threadIdx.x >> 6);
    LAS unsigned* qslot = (LAS unsigned*)(lds + 131072);

    {
        PHASE_BEGIN
        if (blockIdx.x == 0) { if (tid < 64) ctl[tid] = 0u; for (int i = tid; i < XCD_BAR_WORDS; i += NTHR) ctl[CW_BAR + i] = 0u; }
        ada_phase(a, lds, wave, lane);
        convert_weights(a, 0, lds, gw, ngw, wave, lane);
    }
    CG_SYNC();
    XcdBarrier xbar;
    {   PHASE_BEGIN
        volatile LAS unsigned* st = (volatile LAS unsigned*)(lds + 131072 + 16);
        if (tid < 2) st[tid] = 0u;
        __syncthreads();
        xbar = xcd_barrier_post(ctl + CW_BAR, st, tid == 0);
    }

    for (int l = 0; l < DEPTH; ++l) {
        {
            PHASE_BEGIN
            if (l > 0) convert_weights(a, l, lds, gw, ngw, wave, lane);
            norm_phase(a, (l == 0) ? a.in[0] : a.out, l, 0, gw, ngw, lane);
        }
        GRID_SYNC();
#ifdef UP_TWICE
        { PHASE_BEGIN pg8::Gemm g{H, WT + W_UPA, MROWS, 2 * DFF, DM}; GEMM_RUN(pg8::EpiSwiGLU, HID, DFF); }
        GRID_SYNC();
#endif
        { PHASE_BEGIN pg8::Gemm g{H, WT + W_UPA, MROWS, 2 * DFF, DM}; GEMM_RUN(pg8::EpiSwiGLU, HID, DFF); }
        GRID_SYNC();
        { PHASE_BEGIN pg8::Gemm g{HID, WT + W_DNA, MROWS, DM, DFF}; GEMM_RUN(pg8::EpiResid, (l == 0) ? a.in[0] : a.out, a.out, mod + (size_t)l * NB * NMOD + 0 * 3 * DM + 2 * DM, NMOD, 0.5f, DM); }
        GRID_SYNC();
        { PHASE_BEGIN norm_phase(a, a.out, l, 1, gw, ngw, lane); }
        GRID_SYNC();
        { PHASE_BEGIN pg8::Gemm g{H, WT + W_IN, MROWS, 6 * DM, DM}; GEMM_RUN(pg8::EpiBf<0>, B0, DM, DM, (size_t)MROWS * DM, 3, 0.125f * LOG2E, nullptr); }
        GRID_SYNC();
        {
            PHASE_BEGIN
#ifdef RET_TWICE
            if (blockIdx.x < 32) retention_unit(a, l, blockIdx.x >> 2, blockIdx.x & 3, lds, wave_s, true);
#endif
            if (blockIdx.x < 32) retention_unit(a, l, blockIdx.x >> 2, blockIdx.x & 3, lds, wave_s);
            const float s1 = wave_sum(a.in[9][l * 64 + lane] * a.in[10][l * 64 + lane], lane), s2 = wave_sum(a.in[11][l * 64 + lane] * a.in[12][l * 64 + lane], lane);
            const float lam_init = sgpr_f(0.8f - 0.6f * expf(-0.3f * (float)l)), lam = sgpr_f(expf(s1) - expf(s2) + lam_init);
#ifdef ATT_TWICE
            for (;;) {
                if (tid == 0) *qslot = atomicAdd(ctl + 8 + l, 1u);
                __syncthreads();
                const unsigned item = *qslot;
                __syncthreads();
                if (item >= 64u * 64u) break;
                const int qb = 63 - (int)(item >> 6), bh = (int)(item & 63u);
                attn_unit(a, l, bh >> 3, bh & 7, qb, lam, 1.0f - lam_init, lds, wave_s, true);
            }
#endif
            const int q0 = (int)(xb_xcc_id() & 7u);
            for (int k = 0; k < NB; ++k) {
                const int bq = (q0 + k) & 7;
                for (;;) {
                    if (tid == 0) *qslot = atomicAdd(ctl + l * NB + bq, 1u);
                    __syncthreads();
                    const unsigned item = *qslot;
                    __syncthreads();
                    if (item >= 8u * 64u) break;
                    attn_unit(a, l, bq, 7 - (int)(item >> 6), 63 - (int)(item & 63u), lam, 1.0f - lam_init, lds, wave_s);
                }
            }
        }
        GRID_SYNC();
        {
            PHASE_BEGIN pg8::Gemm g{H, WT + W_IN + (size_t)6 * DM * DM, MROWS, DM, DM, H, WT + W_IN + (size_t)7 * DM * DM, B0 + (size_t)2 * MROWS * DM, WT + W_RET, B0 + (size_t)3 * MROWS * DM, WT + W_DIF};
            pg8::SegOrderN<2> S; S.init(MROWS, g.N, G, (int)blockIdx.x); pg8::EpiMerge E{B0 + (size_t)1 * MROWS * DM, DM, B0, B0 + (size_t)4 * MROWS * DM};
            pg8::gemm_phase<pg8::EpiMerge, pg8::SegOrderN<2>, true, true>(lds, g, S, E, wave_s); }
        GRID_SYNC();
        { PHASE_BEGIN pg8::Gemm g{B0 + (size_t)1 * MROWS * DM, WT + W_OUT, MROWS, DM, DM}; GEMM_RUN(pg8::EpiResid, a.out, a.out, mod + (size_t)l * NB * NMOD + 1 * 3 * DM + 2 * DM, NMOD, 1.0f, DM); }
        GRID_SYNC();
        { PHASE_BEGIN norm_phase(a, a.out, l, 2, gw, ngw, lane); }
        GRID_SYNC();
        { PHASE_BEGIN pg8::Gemm g{H, WT + W_UPB, MROWS, 2 * DFF, DM}; GEMM_RUN(pg8::EpiSwiGLU, HID, DFF); }
        GRID_SYNC();
        { PHASE_BEGIN pg8::Gemm g{HID, WT + W_DNB, MROWS, DM, DFF}; GEMM_RUN(pg8::EpiResid, a.out, a.out, mod + (size_t)l * NB * NMOD + 2 * 3 * DM + 2 * DM, NMOD, 0.5f, DM); }
        GRID_SYNC();
    }
#ifdef SYNC_PROBE
    for (int i = 0; i < 64; ++i) GRID_SYNC();
#endif
    { PHASE_BEGIN final_norm_phase(a, gw, ngw, lane); }
}

constexpr int LDS_BYTES = 147456;
extern "C" void kernel_launch(void* const* d_in, const int* in_sizes, int n_in, void* d_out, int out_size, void* d_ws, size_t ws_size, hipStream_t stream) {
    static int grid = 0;
    if (grid == 0) {
        if (n_in != 18 || ws_size < WS_END) { fprintf(stderr, "kernel_launch: unexpected n_in %d / ws_size %zu (need %zu)\n", n_in, ws_size, (size_t)WS_END); grid = -1; return; }
        int dev = 0, cus = 0, per_cu = 0;
        (void)hipGetDevice(&dev); (void)hipDeviceGetAttribute(&cus, hipDeviceAttributeMultiprocessorCount, dev);
        if (hipFuncSetAttribute((const void*)hybrid_fwd, hipFuncAttributeMaxDynamicSharedMemorySize, LDS_BYTES) != hipSuccess) { fprintf(stderr, "kernel_launch: hipFuncSetAttribute failed\n"); grid = -1; return; }
        if (hipOccupancyMaxActiveBlocksPerMultiprocessor(&per_cu, (const void*)hybrid_fwd, NTHR, LDS_BYTES) != hipSuccess || per_cu < 1) { fprintf(stderr, "kernel_launch: occupancy query says %d\n", per_cu); per_cu = 1; }
        (void)hipGetLastError();
        grid = cus * 1;
    }
    if (grid < 0) return;
    Args a{};
    for (int i = 0; i < 18; ++i) a.in[i] = (const float*)d_in[i];
    a.out = (float*)d_out; a.ws = (unsigned char*)d_ws;
    void* kargs[] = {&a};
    hipError_t e = hipLaunchCooperativeKernel((const void*)hybrid_fwd, dim3(grid), dim3(NTHR), kargs, LDS_BYTES, stream);
    if (e != hipSuccess) fprintf(stderr, "cooperative launch failed: %s (grid %d)\n", hipGetErrorString(e), grid);
}
```

```cpp
#define GATE_LOGITS 1
#include <hip/hip_runtime.h>
#include <hip/hip_cooperative_groups.h>
#include <cstdio>
#include <cstdint>
namespace cg = cooperative_groups;
#define USE_RSB 1
__device__ __forceinline__ int hw_lane() { int l = (int)__builtin_amdgcn_mbcnt_hi(~0u, __builtin_amdgcn_mbcnt_lo(~0u, 0u)); asm volatile("" : "+v"(l)); return l; }
namespace pg8 {
#define PG8_LAS __attribute__((address_space(3)))
typedef unsigned short bf16_t;
typedef short bf16x8 __attribute__((ext_vector_type(8)));
typedef float f32x4 __attribute__((ext_vector_type(4)));
typedef unsigned u32x4 __attribute__((ext_vector_type(4)));
constexpr int BM = 256, BK = 64, HALF = 128, HTB = HALF * BK * 2  , STAGE_BYTES = 8 * HTB, NXCD = 8, WGM = 8;

__host__ __device__ __forceinline__ int lds_byte(int r, int c) { const int st = (r >> 4) * 2 + (c >> 5), rr = r & 15, cc = c & 31, ob = rr * 64 + cc * 2; return st * 1024 + (ob ^ (((ob >> 9) & 1) << 5)); }
__host__ __device__ __forceinline__ void stage_rc(int b, int& R, int& C) { const int st = b / 1024, sb = b % 1024, swz = sb ^ (((sb >> 9) & 1) << 5); R = (st >> 1) * 16 + swz / 64; C = (st & 1) * 32 + (swz % 64) / 2; }
__host__ __device__ __forceinline__ int perm32(int rho) { const int n = rho >> 4, i = rho & 15; return 8 * (i >> 2) + 4 * n + (i & 3); }

struct Unit { int pm, pn, seg; };
struct Gemm { const bf16_t* A; const bf16_t* Bt; int M, N, K; const bf16_t* A2; const bf16_t* Bt2; const bf16_t* A3; const bf16_t* Bt3; const bf16_t* A4; const bf16_t* Bt4; };
__host__ __device__ __forceinline__ const bf16_t* seg_a(const Gemm& g, int sg) { return sg == 0 ? g.A : sg == 1 ? g.A2 : sg == 2 ? g.A3 : g.A4; }
__host__ __device__ __forceinline__ const bf16_t* seg_b(const Gemm& g, int sg) { return sg == 0 ? g.Bt : sg == 1 ? g.Bt2 : sg == 2 ? g.Bt3 : g.Bt4; }

struct StaticOrder {
    int nM, nN, nwg, G, c;
    __host__ __device__ void init(int M, int N, int G_, int c_) { nM = M / BM; nN = N / BM; nwg = nM * nN; G = G_; c = c_; }
    __host__ __device__ bool next(int i, Unit& u) const {
        const long L = (long)i * G + c; if (L >= nwg) return false;
        int wgid = (int)L; { const int q = nwg / NXCD, r = nwg % NXCD, xcd = wgid % NXCD, off = wgid / NXCD; wgid = (xcd < r ? xcd * (q + 1) : r * (q + 1) + (xcd - r) * q) + off; }
        const int nig = WGM * nN, gid = wgid / nig, fm = gid * WGM, gsz = (nM - fm) < WGM ? (nM - fm) : WGM;
        u.pm = fm + ((wgid % nig) % gsz); u.pn = (wgid % nig) / gsz; u.seg = 0; return true;
    }
    __device__ __forceinline__ void a_ready(const Unit&) const {}
    __device__ __forceinline__ void done(const Unit&) const {}
};
template <int LOG2SEG> struct SegOrderN {
    StaticOrder base;
    __host__ __device__ void init(int M, int N, int G_, int c_) { base.init(M, N, G_, c_); }
    __host__ __device__ bool next(int i, Unit& u) const { const bool ok = base.next(i >> LOG2SEG, u); u.seg = i & ((1 << LOG2SEG) - 1); return ok; }
    __device__ __forceinline__ void a_ready(const Unit&) const {}
    __device__ __forceinline__ void done(const Unit&) const {}
};
template <class E, class = void> struct epi_seg { static constexpr bool value = false; };
template <class E> struct epi_seg<E, decltype((void)E::SEG)> { static constexpr bool value = E::SEG; };
template <class E> __host__ __device__ __forceinline__ bool epi_keep(int sg) { if constexpr (epi_seg<E>::value) return E::keep_acc(sg); else return false; }


__device__ __forceinline__ unsigned cvt_pk_bf16(float lo, float hi) { unsigned r; asm volatile("v_cvt_pk_bf16_f32 %0, %1, %2" : "=v"(r) : "v"(lo), "v"(hi)); return r; }
typedef float f32x2 __attribute__((ext_vector_type(2)));

__device__ __forceinline__ float sigmoid_f(float v) { return __builtin_amdgcn_rcpf(1.0f + __builtin_amdgcn_exp2f(-1.4426950408889634f * v)); }
__device__ __forceinline__ float bf_lo(unsigned w) { return __uint_as_float(w << 16); }
__device__ __forceinline__ float bf_hi(unsigned w) { return __uint_as_float(w & 0xffff0000u); }

struct EpiSwiGLU {
    static constexpr bool PERM = true, AFTER_DRAIN = false;
    bf16_t* O; int ldc;
    __device__ __forceinline__ void operator()(const f32x4 (&acc)[2][2][4][2], const Unit& u, int wr, int wc, int fr, int fq) const {
        const int row0 = u.pm * BM + wr * 64 + fr, col0 = u.pn * HALF + wc * 32 + 8 * fq;
#pragma unroll
        for (int ai = 0; ai < 2; ++ai)
#pragma unroll
            for (int m = 0; m < 4; ++m) {
                bf16_t* rowp = O + (size_t)(row0 + ai * HALF + m * 16) * ldc + col0;
                float v[8];
#pragma unroll
                for (int n = 0; n < 2; ++n)
#pragma unroll
                    for (int e = 0; e < 4; ++e) { const float a = acc[ai][0][m][n][e], b = acc[ai][1][m][n][e]; v[4 * n + e] = a * sigmoid_f(a) * b; }
                u32x4 w; w.x = cvt_pk_bf16(v[0], v[1]); w.y = cvt_pk_bf16(v[2], v[3]); w.z = cvt_pk_bf16(v[4], v[5]); w.w = cvt_pk_bf16(v[6], v[7]);
                *(u32x4*)rowp = w;
            }
    }
};
struct EpiResid {
    static constexpr bool PERM = false, AFTER_DRAIN = false;
    const float* base; float* out; const float* gate; int gate_bstride; float coef; int ldc;
    __device__ __forceinline__ void operator()(const f32x4 (&acc)[2][2][4][2], const Unit& u, int wr, int wc, int fr, int fq) const {
        const int col0 = u.pn * BM + wc * 32 + 4 * fq;
        const float* g = gate + (size_t)(u.pm >> 5) * gate_bstride;
        f32x4 gv[2][2];
#pragma unroll
        for (int bj = 0; bj < 2; ++bj)
#pragma unroll
            for (int n = 0; n < 2; ++n) gv[bj][n] = *(const f32x4*)(g + col0 + bj * HALF + n * 16) * coef;
#pragma unroll
        for (int ai = 0; ai < 2; ++ai)
#pragma unroll
            for (int m = 0; m < 4; ++m) { const size_t off = (size_t)(u.pm * BM + ai * HALF + wr * 64 + m * 16 + fr) * ldc + col0;
#pragma unroll
                for (int bj = 0; bj < 2; ++bj)
#pragma unroll
                    for (int n = 0; n < 2; ++n) { const f32x4 bs = *(const f32x4*)(base + off + bj * HALF + n * 16); *(f32x4*)(out + off + bj * HALF + n * 16) = bs + gv[bj][n] * acc[ai][bj][m][n]; } }
    }
};
#ifdef GATE_LOGITS
#define GSIG(x) sigmoid_f(x)
#else
#define GSIG(x) (x)
#endif
template <int MODE> struct EpiBf {
    static constexpr bool PERM = true, AFTER_DRAIN = false;
    bf16_t* O; int ldc; int split_cols; size_t split_stride; int qt; float qscale; const bf16_t* G;
    __device__ __forceinline__ void operator()(const f32x4 (&acc)[2][2][4][2], const Unit& u, int wr, int wc, int fr, int fq) const {
        const int row0 = u.pm * BM + wr * 64 + fr; int colt = u.pn * BM; bf16_t* base = O; float sc = 1.f;
        if (MODE <= 1) { const int t = colt / split_cols; base += (size_t)t * split_stride; colt -= t * split_cols; if (MODE == 0 && t == qt) sc = qscale; }
        const int col0 = colt + wc * 32 + 8 * fq;
#pragma unroll
        for (int ai = 0; ai < 2; ++ai)
#pragma unroll
            for (int m = 0; m < 4; ++m) { const size_t roff = (size_t)(row0 + ai * HALF + m * 16) * ldc + col0;
#pragma unroll
                for (int bj = 0; bj < 2; ++bj) {
                    f32x4 v0 = acc[ai][bj][m][0], v1 = acc[ai][bj][m][1];
                    if (MODE == 0) { v0 = v0 * sc; v1 = v1 * sc; }
                    if (MODE == 1) {
#pragma unroll
                        for (int e = 0; e < 4; ++e) { v0[e] = sigmoid_f(v0[e]); v1[e] = sigmoid_f(v1[e]); } }
                    if (MODE >= 2) { const u32x4 g = *(const u32x4*)(G + roff + bj * HALF);
                        v0[0] *= GSIG(bf_lo(g.x)); v0[1] *= GSIG(bf_hi(g.x)); v0[2] *= GSIG(bf_lo(g.y)); v0[3] *= GSIG(bf_hi(g.y)); v1[0] *= GSIG(bf_lo(g.z)); v1[1] *= GSIG(bf_hi(g.z)); v1[2] *= GSIG(bf_lo(g.w)); v1[3] *= GSIG(bf_hi(g.w)); }
                    if (MODE == 3) { const u32x4 t = *(const u32x4*)(base + roff + bj * HALF);
                        v0[0] += bf_lo(t.x); v0[1] += bf_hi(t.x); v0[2] += bf_lo(t.y); v0[3] += bf_hi(t.y); v1[0] += bf_lo(t.z); v1[1] += bf_hi(t.z); v1[2] += bf_lo(t.w); v1[3] += bf_hi(t.w); }
                    u32x4 w; w.x = cvt_pk_bf16(v0[0], v0[1]); w.y = cvt_pk_bf16(v0[2], v0[3]); w.z = cvt_pk_bf16(v1[0], v1[1]); w.w = cvt_pk_bf16(v1[2], v1[3]);
                    *(u32x4*)(base + roff + bj * HALF) = w; } }
    }
};
struct EpiMerge {
    static constexpr bool PERM = true, AFTER_DRAIN = false, SEG = true;
    __host__ __device__ static constexpr bool keep_acc(int sg) { return sg == 3; }
    bf16_t* O; int ldc; bf16_t* GR; bf16_t* GD;
    __device__ __forceinline__ void operator()(f32x4 (&acc)[2][2][4][2], const Unit& u, int wr, int wc, int fr, int fq) const {
        const int row0 = u.pm * BM + wr * 64 + fr, col0 = u.pn * BM + wc * 32 + 8 * fq;
#pragma unroll
        for (int ai = 0; ai < 2; ++ai)
#pragma unroll
            for (int m = 0; m < 4; ++m) { const size_t roff = (size_t)(row0 + ai * HALF + m * 16) * ldc + col0;
#pragma unroll
                for (int bj = 0; bj < 2; ++bj) {
                    if (u.seg < 2) {
                        float v[8];
#pragma unroll
                        for (int e = 0; e < 8; ++e) v[e] = __builtin_fmaxf(acc[ai][bj][m][e >> 2][e & 3], -3.0e38f);
                        u32x4 w; w.x = cvt_pk_bf16(v[0], v[1]); w.y = cvt_pk_bf16(v[2], v[3]); w.z = cvt_pk_bf16(v[4], v[5]); w.w = cvt_pk_bf16(v[6], v[7]);
                        *(u32x4*)((u.seg == 0 ? GR : GD) + roff + bj * HALF) = w;
                    } else {
                        const u32x4 gd = *(const u32x4*)(GD + roff + bj * HALF);
                        const float d[8] = {bf_lo(gd.x), bf_hi(gd.x), bf_lo(gd.y), bf_hi(gd.y), bf_lo(gd.z), bf_hi(gd.z), bf_lo(gd.w), bf_hi(gd.w)};
                        if (u.seg == 2) {
                            const u32x4 gr = *(const u32x4*)(GR + roff + bj * HALF);
                            const float r[8] = {bf_lo(gr.x), bf_hi(gr.x), bf_lo(gr.y), bf_hi(gr.y), bf_lo(gr.z), bf_hi(gr.z), bf_lo(gr.w), bf_hi(gr.w)};
#pragma unroll
                            for (int e = 0; e < 8; ++e) { const float ed = __builtin_amdgcn_exp2f(-1.4426950408889634f * d[e]), er = __builtin_amdgcn_exp2f(-1.4426950408889634f * r[e]);
                                acc[ai][bj][m][e >> 2][e & 3] *= (1.0f + ed) * __builtin_amdgcn_rcpf(1.0f + er); }
                        } else {
                            float v[8];
#pragma unroll
                            for (int e = 0; e < 8; ++e) v[e] = acc[ai][bj][m][e >> 2][e & 3] * sigmoid_f(d[e]);
                            u32x4 w; w.x = cvt_pk_bf16(v[0], v[1]); w.y = cvt_pk_bf16(v[2], v[3]); w.z = cvt_pk_bf16(v[4], v[5]); w.w = cvt_pk_bf16(v[6], v[7]);
                            *(u32x4*)(O + roff + bj * HALF) = w; }
                    }
                } }
    }
};


template <class Epi, class Sched, bool ALIGN_EPI = false, bool SP2 = false>
__device__ __forceinline__ void gemm_phase(PG8_LAS unsigned char* lds, const Gemm g, const Sched& S, const Epi& E, const int wave_s) {
    const int lane = hw_lane(), wid = wave_s, tid = wave_s * 64 + lane, wr = wid >> 2, wc = wid & 3, fr = lane & 15, fq = lane >> 4;
    const int K = g.K, nt = K / BK;
    unsigned voffA[2], voffB[2];
#pragma unroll
    for (int i = 0; i < 2; ++i) { int R, C; stage_rc(tid * 16 + i * 8192, R, C); const int Rb = Epi::PERM ? ((R & ~31) + perm32(R & 31)) : R;
        voffA[i] = (unsigned)(R * K + C) * 2u; voffB[i] = (unsigned)(Rb * K + C) * 2u; }
    const size_t kstep = (size_t)(BK * 2);
    const size_t hstep = (size_t)HALF * K * 2;
    const size_t tstep = 2 * hstep;
    const unsigned ldsw = (unsigned)wid * 1024u;
    const int aoff = lds_byte(wr * 64 + fr, fq * 8), boff = lds_byte(wc * 32 + fr, fq * 8);
#define PG8_SA(b, h) (((b) * 2 + (h)) * HTB)
#define PG8_SB(b, h) ((4 + (b) * 2 + (h)) * HTB)
#define PG8_STAGE(bufoff, gbase, voff) do { _Pragma("unroll") for (int _i = 0; _i < 2; ++_i) \
        __builtin_amdgcn_global_load_lds((const unsigned*)((const char*)(gbase) + (voff)[_i]), (PG8_LAS unsigned*)(lds + (bufoff) + ldsw + _i * 8192), 16, 0, 0); } while (0)
#define PG8_LDA(dst, b, h) do { _Pragma("unroll") for (int m = 0; m < 4; ++m) _Pragma("unroll") for (int k = 0; k < 2; ++k) dst[m][k] = *(const PG8_LAS bf16x8*)(lds + PG8_SA(b, h) + aoff + m * 2048 + k * 1024); } while (0)
#define PG8_LDB(dst, b, h) do { _Pragma("unroll") for (int n = 0; n < 2; ++n) _Pragma("unroll") for (int k = 0; k < 2; ++k) dst[n][k] = *(const PG8_LAS bf16x8*)(lds + PG8_SB(b, h) + boff + n * 2048 + k * 1024); } while (0)
#define PG8_MMA(ai, bj, At, Bt) do { __builtin_amdgcn_s_setprio(1); _Pragma("unroll") for (int m = 0; m < 4; ++m) _Pragma("unroll") for (int n = 0; n < 2; ++n) _Pragma("unroll") for (int k = 0; k < 2; ++k) \
        acc[ai][bj][m][n] = __builtin_amdgcn_mfma_f32_16x16x32_bf16(Bt[n][k], At[m][k], acc[ai][bj][m][n], 0, 0, 0); __builtin_amdgcn_s_setprio(0); } while (0)
#define PG8_WAIT_V(n) asm volatile("s_waitcnt vmcnt(" #n ")" ::: "memory")
#define PG8_WAIT_L(n) asm volatile("s_waitcnt lgkmcnt(" #n ")" ::: "memory")
#define PG8_BAR __builtin_amdgcn_s_barrier()
#define PG8_SCHED __builtin_amdgcn_sched_barrier(0)
    Unit cur, nxt; int ui = 0;
    if (!S.next(0, cur)) return;
    f32x4 acc[2][2][4][2];
#pragma unroll
    for (int a = 0; a < 2; ++a)
#pragma unroll
        for (int b = 0; b < 2; ++b)
#pragma unroll
            for (int m = 0; m < 4; ++m)
#pragma unroll
                for (int n = 0; n < 2; ++n) acc[a][b][m][n] = (f32x4){0.f, 0.f, 0.f, 0.f};
    bf16x8 At[4][2], B0[2][2], B1[2][2];
    const char* cA = (const char*)seg_a(g, cur.seg) + (size_t)cur.pm * tstep; const char* cB = (const char*)seg_b(g, cur.seg) + (size_t)cur.pn * tstep;
    S.a_ready(cur);
    if constexpr (SP2) {
        PG8_STAGE(PG8_SB(0, 0), cB, voffB); PG8_STAGE(PG8_SB(0, 1), cB + hstep, voffB); PG8_STAGE(PG8_SA(0, 0), cA, voffA); PG8_STAGE(PG8_SA(0, 1), cA + hstep, voffA);
        if (wr == 1) PG8_BAR;
        PG8_WAIT_V(2); PG8_BAR;
        PG8_STAGE(PG8_SB(1, 0), cB + kstep, voffB); PG8_STAGE(PG8_SA(1, 0), cA + kstep, voffA); PG8_STAGE(PG8_SB(1, 1), cB + hstep + kstep, voffB);
        PG8_WAIT_V(6); PG8_BAR;
    } else {
        PG8_STAGE(PG8_SB(0, 0), cB, voffB); PG8_STAGE(PG8_SA(0, 0), cA, voffA); PG8_STAGE(PG8_SB(0, 1), cB + hstep, voffB); PG8_STAGE(PG8_SA(0, 1), cA + hstep, voffA);
        if (wr == 1) PG8_BAR;
        PG8_WAIT_V(4); PG8_BAR;
        PG8_STAGE(PG8_SB(1, 0), cB + kstep, voffB); PG8_STAGE(PG8_SA(1, 0), cA + kstep, voffA); PG8_STAGE(PG8_SB(1, 1), cB + hstep + kstep, voffB);
        PG8_WAIT_V(6); PG8_BAR;
    }
    for (;;) {
        const bool has_next = S.next(ui + 1, nxt);
        const char* nA = has_next ? (const char*)seg_a(g, nxt.seg) + (size_t)nxt.pm * tstep : cA; const char* nB = has_next ? (const char*)seg_b(g, nxt.seg) + (size_t)nxt.pn * tstep : cB;
        for (int t = 0; t < nt; t += 2) {
            const bool last = (t == nt - 2);
            const char* a1 = cA + (size_t)(t + 1) * kstep;
            const char* a2 = last ? nA : cA + (size_t)(t + 2) * kstep; const char* b2 = last ? nB : cB + (size_t)(t + 2) * kstep;
            const char* a3 = a2 + kstep; const char* b3 = b2 + kstep;
            if (last && has_next) S.a_ready(nxt);
            if constexpr (SP2) {
            PG8_LDB(B0, 0, 0); PG8_LDB(B1, 0, 1); PG8_SCHED; PG8_LDA(At, 0, 0); PG8_STAGE(PG8_SA(1, 1), a1 + hstep, voffA);
            PG8_WAIT_V(8); PG8_WAIT_L(0); PG8_BAR; PG8_MMA(0, 0, At, B0); PG8_MMA(0, 1, At, B1); PG8_BAR; PG8_SCHED;
            PG8_LDA(At, 0, 1); PG8_STAGE(PG8_SB(0, 0), b2, voffB); PG8_STAGE(PG8_SB(0, 1), b2 + hstep, voffB); PG8_STAGE(PG8_SA(0, 0), a2, voffA);
            PG8_WAIT_V(8); PG8_WAIT_L(0); PG8_BAR; PG8_MMA(1, 0, At, B0); PG8_MMA(1, 1, At, B1); PG8_BAR; PG8_SCHED;
            PG8_LDB(B0, 1, 0); PG8_LDB(B1, 1, 1); PG8_SCHED; PG8_LDA(At, 1, 0); PG8_STAGE(PG8_SA(0, 1), a2 + hstep, voffA);
            PG8_WAIT_V(8); PG8_WAIT_L(0); PG8_BAR; PG8_MMA(0, 0, At, B0); PG8_MMA(0, 1, At, B1); PG8_BAR; PG8_SCHED;
            PG8_LDA(At, 1, 1); PG8_STAGE(PG8_SB(1, 0), b3, voffB); PG8_STAGE(PG8_SB(1, 1), b3 + hstep, voffB); PG8_STAGE(PG8_SA(1, 0), a3, voffA);
            PG8_WAIT_V(8); PG8_WAIT_L(0); PG8_BAR; PG8_MMA(1, 0, At, B0); PG8_MMA(1, 1, At, B1); PG8_BAR; PG8_SCHED;
            } else {
            PG8_LDB(B0, 0, 0); PG8_SCHED; PG8_LDA(At, 0, 0); PG8_STAGE(PG8_SA(1, 1), a1 + hstep, voffA);
            PG8_WAIT_L(8); PG8_BAR; PG8_WAIT_L(0); PG8_MMA(0, 0, At, B0); PG8_BAR; PG8_SCHED;
            PG8_LDB(B1, 0, 1); PG8_STAGE(PG8_SB(0, 0), b2, voffB);
            PG8_BAR; PG8_WAIT_L(0); PG8_MMA(0, 1, At, B1); PG8_BAR;
            PG8_LDA(At, 0, 1); PG8_STAGE(PG8_SA(0, 0), a2, voffA);
            PG8_BAR; PG8_WAIT_L(0); PG8_MMA(1, 0, At, B0); PG8_BAR; PG8_SCHED;
            PG8_STAGE(PG8_SB(0, 1), b2 + hstep, voffB);
            PG8_WAIT_V(6); PG8_BAR; PG8_MMA(1, 1, At, B1); PG8_BAR;
            PG8_LDB(B0, 1, 0); PG8_SCHED; PG8_LDA(At, 1, 0); PG8_STAGE(PG8_SA(0, 1), a2 + hstep, voffA);
            PG8_WAIT_L(8); PG8_BAR; PG8_WAIT_L(0); PG8_MMA(0, 0, At, B0); PG8_BAR; PG8_SCHED;
            PG8_LDB(B1, 1, 1); PG8_STAGE(PG8_SB(1, 0), b3, voffB);
            PG8_BAR; PG8_WAIT_L(0); PG8_MMA(0, 1, At, B1); PG8_BAR;
            PG8_LDA(At, 1, 1); PG8_STAGE(PG8_SA(1, 0), a3, voffA);
            PG8_BAR; PG8_WAIT_L(0); PG8_MMA(1, 0, At, B0); PG8_BAR; PG8_SCHED;
            PG8_STAGE(PG8_SB(1, 1), b3 + hstep, voffB);
            PG8_WAIT_V(6); PG8_BAR; PG8_MMA(1, 1, At, B1); PG8_BAR;
            }
        }
        if constexpr (ALIGN_EPI) { if (wr == 0) PG8_BAR; }
        if constexpr (!Epi::AFTER_DRAIN) { E(acc, cur, wr, wc, fr, fq); S.done(cur); }
        if (!has_next) break;
        if (!epi_keep<Epi>(nxt.seg)) {
#pragma unroll
        for (int a = 0; a < 2; ++a)
#pragma unroll
            for (int b = 0; b < 2; ++b)
#pragma unroll
                for (int m = 0; m < 4; ++m)
#pragma unroll
                    for (int n = 0; n < 2; ++n) acc[a][b][m][n] = (f32x4){0.f, 0.f, 0.f, 0.f};
        }
        cur = nxt; cA = nA; cB = nB; ++ui;
        if constexpr (ALIGN_EPI) { if (wr == 1) PG8_BAR; }
    }
    PG8_WAIT_V(0);
    if constexpr (!ALIGN_EPI) { if (wr == 0) PG8_BAR; }
    PG8_BAR;
    if constexpr (Epi::AFTER_DRAIN) { E.fused(acc, cur, wr, wc, fr, fq, lds, wid, lane); S.done(cur); }
#undef PG8_SA
#undef PG8_SB
#undef PG8_STAGE
#undef PG8_LDA
#undef PG8_LDB
#undef PG8_MMA
#undef PG8_WAIT_V
#undef PG8_WAIT_L
#undef PG8_BAR
#undef PG8_SCHED
}
}

#define LAS __attribute__((address_space(3)))
typedef unsigned short bf16;
typedef float f32x4 __attribute__((ext_vector_type(4)));
typedef float f32x16 __attribute__((ext_vector_type(16)));
typedef short bf16x8 __attribute__((ext_vector_type(8)));
typedef short s16x4 __attribute__((ext_vector_type(4)));
typedef unsigned u32x4 __attribute__((ext_vector_type(4)));
typedef unsigned u32x2 __attribute__((ext_vector_type(2)));

constexpr int DM = 1024, NB = 8, SEQ = 8192, DEPTH = 4, MROWS = NB * SEQ, DFF = 2816, INW = 8192, NMOD = 9 * DM;
constexpr int NWAVES = 8, NTHR = 512;
constexpr float NORM_EPS = 1e-6f, LOG2E = 1.4426950408889634f;
constexpr size_t MiB = 1u << 20;
constexpr size_t WS_CTL = 0;
constexpr size_t WS_MOD = 1 * MiB;
constexpr size_t WS_WT = 4 * MiB;
constexpr size_t W_UPA = 0, W_DNA = W_UPA + (size_t)2 * DFF * DM, W_UPB = W_DNA + (size_t)DM * DFF, W_DNB = W_UPB + (size_t)2 * DFF * DM,
                 W_IN = W_DNB + (size_t)DM * DFF, W_RET = W_IN + (size_t)INW * DM, W_DIF = W_RET + (size_t)DM * DM, W_OUT = W_DIF + (size_t)DM * DM, W_END = W_OUT + (size_t)DM * DM;
constexpr size_t WS_H = 64 * MiB;
constexpr size_t ACT = (size_t)MROWS * DM * 2;
constexpr size_t WS_B0 = 192 * MiB;
constexpr size_t WS_HID = WS_B0;
constexpr size_t WS_END = WS_B0 + 6 * ACT;
static_assert(WS_WT + W_END * 2 <= WS_H && WS_END <= 1024 * MiB, "d_ws map");

struct Args { const float* in[18]; float* out; unsigned char* ws; };

__device__ __forceinline__ float shx(float v, int m, int lane) { return __int_as_float(__builtin_amdgcn_ds_bpermute((lane ^ m) << 2, __float_as_int(v))); }
__device__ __forceinline__ float wave_sum(float v, int lane) {
#pragma unroll
    for (int o = 1; o < 64; o <<= 1) v += shx(v, o, lane);
    return v;
}
__device__ __forceinline__ unsigned f2bf(float f) { unsigned u = __float_as_uint(f); return (u + 0x7fffu + ((u >> 16) & 1u)) >> 16; }
__device__ __forceinline__ unsigned pk2(float lo, float hi) { return pg8::cvt_pk_bf16(lo, hi); }
typedef __bf16 bf16x2_cv __attribute__((ext_vector_type(2))); typedef float f32x2_cv __attribute__((ext_vector_type(2)));
__device__ __forceinline__ unsigned pk2v(float lo, float hi) { f32x2_cv v = {lo, hi}; bf16x2_cv b = __builtin_convertvector(v, bf16x2_cv); return __builtin_bit_cast(unsigned, b); }
__device__ __forceinline__ float bflo(unsigned w) { return __uint_as_float(w << 16); }
__device__ __forceinline__ float bfhi(unsigned w) { return __uint_as_float(w & 0xffff0000u); }
__device__ __forceinline__ float sgpr_f(float v) { return __int_as_float(__builtin_amdgcn_readfirstlane(__float_as_int(v))); }
__device__ __forceinline__ int launder(int v) { asm volatile("" : "+v"(v)); return v; }
#define LDS_WAIT() asm volatile("s_waitcnt lgkmcnt(0)" ::: "memory")
#define LDS_BARRIER() do { asm volatile("s_waitcnt lgkmcnt(0)" ::: "memory"); __builtin_amdgcn_s_barrier(); asm volatile("" ::: "memory"); } while (0)
#define MFMA32(a, b, c) __builtin_amdgcn_mfma_f32_32x32x16_bf16((a), (b), (c), 0, 0, 0)
__device__ __forceinline__ int crow(int r, int hi) { return (r & 3) + 8 * (r >> 2) + 4 * hi; }
typedef short v4i16_t __attribute__((ext_vector_type(4)));
__device__ __forceinline__ s16x4 tr_read(const LAS unsigned char* p) { return __builtin_bit_cast(s16x4, __builtin_amdgcn_ds_read_tr16_b64_v4i16((LAS v4i16_t*)p)); }
__device__ __forceinline__ bf16x8 cat8(s16x4 lo, s16x4 hi) { return (bf16x8){lo[0], lo[1], lo[2], lo[3], hi[0], hi[1], hi[2], hi[3]}; }
__device__ __forceinline__ bf16x8 pack8v(const f32x16& x, int s) {
    u32x4 p; p.x = pk2v(x[8 * s], x[8 * s + 1]); p.y = pk2v(x[8 * s + 2], x[8 * s + 3]); p.z = pk2v(x[8 * s + 4], x[8 * s + 5]); p.w = pk2v(x[8 * s + 6], x[8 * s + 7]);
    return __builtin_bit_cast(bf16x8, p);
}
__device__ __forceinline__ bf16x8 pack8(const f32x16& x, int s) {
    u32x4 p; p.x = pk2(x[8 * s], x[8 * s + 1]); p.y = pk2(x[8 * s + 2], x[8 * s + 3]); p.z = pk2(x[8 * s + 4], x[8 * s + 5]); p.w = pk2(x[8 * s + 6], x[8 * s + 7]);
    return __builtin_bit_cast(bf16x8, p);
}

template <bool UPPERM>
__device__ __forceinline__ void transpose_item(const float* W, int K, int N, bf16* WT, LAS float* scr, int item, int lane) {
    const int nblk = N / 32, kb = item / nblk, nb = item % nblk, k0 = 64 * kb, n0 = 32 * nb;
#pragma unroll 8
    for (int i = 0; i < 32; ++i) { const int kk = 2 * i + (lane >> 5); scr[kk * 33 + (lane & 31)] = W[(size_t)(k0 + kk) * N + n0 + (lane & 31)]; }
    LDS_WAIT(); asm volatile("" ::: "memory");
    int d0 = n0;
    if (UPPERM) { const int half = n0 / DFF, j = n0 % DFF; d0 = (j / 128) * 256 + half * 128 + (j % 128); }
    const int c = lane & 7;
#pragma unroll
    for (int j = 0; j < 4; ++j) { const int n = (lane >> 3) + 8 * j; const LAS float* s = scr + (8 * c) * 33 + n;
        u32x4 o; o.x = pk2(s[0 * 33], s[1 * 33]); o.y = pk2(s[2 * 33], s[3 * 33]); o.z = pk2(s[4 * 33], s[5 * 33]); o.w = pk2(s[6 * 33], s[7 * 33]);
        *(u32x4*)(WT + (size_t)(d0 + n) * K + k0 + 8 * c) = o; }
    LDS_WAIT(); asm volatile("" ::: "memory");
}
__device__ __forceinline__ void convert_weights(const Args& a, int l, LAS unsigned char* lds, int gw, int ngw, int wave, int lane) {
    lane = launder(lane);
    LAS float* scr = (LAS float*)(lds + wave * 16384);
    bf16* WT = (bf16*)(a.ws + WS_WT);
    const float* up = a.in[5] + (size_t)l * 2 * DM * 2 * DFF; const float* dn = a.in[6] + (size_t)l * 2 * DFF * DM;
    const float* win = a.in[7] + (size_t)l * DM * INW; const float* wr = a.in[14] + (size_t)l * DM * DM; const float* wd = a.in[15] + (size_t)l * DM * DM; const float* wo = a.in[16] + (size_t)l * DM * DM;
    constexpr int I_UP = (DM / 64) * (2 * DFF / 32), I_DN = (DFF / 64) * (DM / 32), I_IN = (DM / 64) * (INW / 32), I_SQ = (DM / 64) * (DM / 32);
    constexpr int NITEMS = 2 * I_UP + 2 * I_DN + I_IN + 3 * I_SQ;
    for (int it = gw; it < NITEMS; it += ngw) {
        int r = it;
        if (r < I_UP) { transpose_item<true>(up, DM, 2 * DFF, WT + W_UPA, scr, r, lane); continue; } r -= I_UP;
        if (r < I_UP) { transpose_item<true>(up + (size_t)DM * 2 * DFF, DM, 2 * DFF, WT + W_UPB, scr, r, lane); continue; } r -= I_UP;
        if (r < I_DN) { transpose_item<false>(dn, DFF, DM, WT + W_DNA, scr, r, lane); continue; } r -= I_DN;
        if (r < I_DN) { transpose_item<false>(dn + (size_t)DFF * DM, DFF, DM, WT + W_DNB, scr, r, lane); continue; } r -= I_DN;
        if (r < I_IN) { transpose_item<false>(win, DM, INW, WT + W_IN, scr, r, lane); continue; } r -= I_IN;
        if (r < I_SQ) { transpose_item<false>(wr, DM, DM, WT + W_RET, scr, r, lane); continue; } r -= I_SQ;
        if (r < I_SQ) { transpose_item<false>(wd, DM, DM, WT + W_DIF, scr, r, lane); continue; } r -= I_SQ;
        transpose_item<false>(wo, DM, DM, WT + W_OUT, scr, r, lane);
    }
}
__device__ __forceinline__ void ada_phase(const Args& a, LAS unsigned char* lds, int wave, int lane) {
    lane = launder(lane);
    LAS float* sc = (LAS float*)lds; LAS float* part = (LAS float*)(lds + 32768);
    const float* c = a.in[1];
    for (int i = wave * 64 + lane; i < NB * DM; i += NTHR) { const float v = c[i]; sc[i] = v * pg8::sigmoid_f(v); }
    __syncthreads();
    float* mod = (float*)(a.ws + WS_MOD);
    constexpr int NIT = DEPTH * (NMOD / 64);
    for (int it = blockIdx.x; it < NIT; it += gridDim.x) {
        const int l = it / (NMOD / 64), j = (it % (NMOD / 64)) * 64 + lane;
        const float* w = a.in[2] + (size_t)l * DM * NMOD + j;
        float acc[NB];
#pragma unroll
        for (int b = 0; b < NB; ++b) acc[b] = 0.f;
        const int k0 = wave * 128;
#pragma unroll 8
        for (int k = 0; k < 128; ++k) { const float wv = w[(size_t)(k0 + k) * NMOD];
#pragma unroll
            for (int b = 0; b < NB; ++b) acc[b] += sc[b * DM + k0 + k] * wv; }
#pragma unroll
        for (int b = 0; b < NB; ++b) part[(wave * NB + b) * 64 + lane] = acc[b];
        __syncthreads();
        { const int b = wave; float s = a.in[3][(size_t)l * NMOD + j];
#pragma unroll
            for (int w8 = 0; w8 < 8; ++w8) s += part[(w8 * NB + b) * 64 + lane];
            mod[((size_t)l * NB + b) * NMOD + j] = s; }
        __syncthreads();
    }
}
template <int NR>
__device__ __forceinline__ void norm_mod_rows(const float* x, bf16* Hout, const float* const* mbp, const float* nw, const int* rows, int lane) {
    f32x4 v[NR][4]; float ss[NR];
#pragma unroll
    for (int r = 0; r < NR; ++r) { const f32x4* xr = (const f32x4*)(x + (size_t)rows[r] * DM) + lane;
#pragma unroll
        for (int j = 0; j < 4; ++j) v[r][j] = __builtin_nontemporal_load(xr + 64 * j); }
#pragma unroll
    for (int r = 0; r < NR; ++r) { float s = 0.f;
#pragma unroll
        for (int j = 0; j < 4; ++j) s += (v[r][j].x * v[r][j].x + v[r][j].y * v[r][j].y) + (v[r][j].z * v[r][j].z + v[r][j].w * v[r][j].w);
        ss[r] = s; }
#pragma unroll
    for (int o = 1; o < 64; o <<= 1)
#pragma unroll
        for (int r = 0; r < NR; ++r) ss[r] += shx(ss[r], o, lane);
#pragma unroll
    for (int r = 0; r < NR; ++r) { const float rstd = 1.0f / sqrtf(ss[r] * (1.f / DM) + NORM_EPS); const float* shift = mbp[r]; const float* scale = mbp[r] + DM;
        u32x2* o8 = (u32x2*)(Hout + (size_t)rows[r] * DM) + lane;
#pragma unroll
        for (int j = 0; j < 4; ++j) { const int c4 = lane + 64 * j; const f32x4 w = ((const f32x4*)nw)[c4], sc = ((const f32x4*)scale)[c4], sh = ((const f32x4*)shift)[c4];
            const f32x4 o = v[r][j] * rstd * w * (sc + 1.0f) + sh; u32x2 p; p.x = pk2(o.x, o.y); p.y = pk2(o.z, o.w); o8[64 * j] = p; } }
}
__device__ __forceinline__ void norm_phase(const Args& a, const float* x, int l, int sub, int gw, int ngw, int lane) {
    lane = launder(lane);
    bf16* H = (bf16*)(a.ws + WS_H); const float* mod = (const float*)(a.ws + WS_MOD); const float* nw = a.in[4] + ((size_t)l * 3 + sub) * DM;
    constexpr int NR = 4;
    for (int m = gw; m < MROWS; m += NR * ngw) { int rows[NR]; const float* mbp[NR];
#pragma unroll
        for (int r = 0; r < NR; ++r) { rows[r] = m + r * ngw; if (rows[r] >= MROWS) rows[r] = m; mbp[r] = mod + ((size_t)l * NB + (rows[r] >> 13)) * NMOD + sub * 3 * DM; }
        norm_mod_rows<NR>(x, H, mbp, nw, rows, lane); }
}
__device__ __forceinline__ void final_norm_phase(const Args& a, int gw, int ngw, int lane) {
    lane = launder(lane);
    const float* fw = a.in[17];
#ifdef DBG_CHECK
    const float dbgs = 1.0f + (float)((const unsigned*)(a.ws + WS_CTL))[32];
#else
    const float dbgs = 1.0f;
#endif
    for (int m = gw; m < MROWS; m += ngw) { f32x4* xr = (f32x4*)(a.out + (size_t)m * DM) + lane;
        f32x4 v[4]; float s = 0.f;
#pragma unroll
        for (int j = 0; j < 4; ++j) { v[j] = xr[64 * j]; s += (v[j].x * v[j].x + v[j].y * v[j].y) + (v[j].z * v[j].z + v[j].w * v[j].w); }
        const float rstd = 1.0f / sqrtf(wave_sum(s, lane) * (1.f / DM) + NORM_EPS);
#pragma unroll
        for (int j = 0; j < 4; ++j) xr[64 * j] = v[j] * (rstd * dbgs) * ((const f32x4*)fw)[lane + 64 * j]; }
}

constexpr int R_Q = 0, R_K = R_Q + 64 * 272, R_QD = R_K + 64 * 272, R_KD = R_QD + 64 * 272, R_SC = R_KD + 64 * 320, R_V = R_SC + 64 * 144, R_DEC = R_V + 64 * 576, R_END = R_DEC + 256;
static_assert(R_END <= 131072 && 64 * 1040 <= R_DEC, "retention LDS");
__device__ __forceinline__ void retention_unit(const Args& a, int l, int b, int h, LAS unsigned char* lds, const int wave_s, const bool dummy = false) {
    asm volatile("" : "+s"(h));
    const int lane = hw_lane(), wave = wave_s, tid = wave_s * 64 + lane, r32 = lane & 31, hh = lane >> 5;
    const int q4 = (lane & 15) >> 2, p4 = lane & 3, g1 = (lane >> 4) & 1;
    const bf16* RQK = (const bf16*)(a.ws + WS_B0); const bf16* RV = (const bf16*)(a.ws + WS_B0 + ACT); bf16* RG = (bf16*)(a.ws + WS_B0 + 2 * ACT);
    const float* gn = a.in[8] + (size_t)l * DM + h * 256;
    const float lg = sgpr_f(log2f(1.0f - exp2f(-5.0f - (float)h)));
    const float sc_qk = 0.08838834764831845f;
    const float cdec = sgpr_f(exp2f(lg * 64.f));
    const size_t row0 = (size_t)b * SEQ;
    f32x16 S[4];
#pragma unroll
    for (int i = 0; i < 4; ++i) S[i] = f32x16{};
    u32x4 pq[2], pk[2], pv[4]; u32x2 prg[8];
    const int er = tid >> 3, es = tid & 7;
#ifdef USE_RSB
#define RSB() __builtin_amdgcn_sched_barrier(0)
#else
#define RSB() do {} while (0)
#endif
#define R_PREFETCH(ci) do { const size_t t0 = row0 + (size_t)(ci) * 64; \
        _Pragma("unroll") for (int i = 0; i < 2; ++i) { const int idx = tid + 512 * i, rr = idx >> 4, ch = idx & 15; \
            pq[i] = *(const u32x4*)(RQK + (t0 + rr) * DM + h * 128 + ch * 8); pk[i] = *(const u32x4*)(RQK + (t0 + rr) * DM + 512 + h * 128 + ch * 8); } \
        _Pragma("unroll") for (int i = 0; i < 4; ++i) { const int idx = tid + 512 * i, rr = idx >> 5, ch = idx & 31; pv[i] = *(const u32x4*)(RV + (t0 + rr) * DM + h * 256 + ch * 8); } } while (0)
#define R_STORE() do { \
        _Pragma("unroll") for (int i = 0; i < 2; ++i) { const int idx = tid + 512 * i, rr = idx >> 4, ch = idx & 15; \
            *(LAS u32x4*)(lds + R_Q + rr * 272 + ch * 16) = pq[i]; *(LAS u32x4*)(lds + R_K + rr * 272 + ch * 16) = pk[i]; \
            const float fqd = exp2f(lg * (float)rr); u32x4 qd; \
            qd.x = pk2(bflo(pq[i].x) * fqd, bfhi(pq[i].x) * fqd); qd.y = pk2(bflo(pq[i].y) * fqd, bfhi(pq[i].y) * fqd); qd.z = pk2(bflo(pq[i].z) * fqd, bfhi(pq[i].z) * fqd); qd.w = pk2(bflo(pq[i].w) * fqd, bfhi(pq[i].w) * fqd); \
            *(LAS u32x4*)(lds + R_QD + rr * 272 + ch * 16) = qd; \
            const float f = sc_qk * exp2f(lg * (float)(64 - rr)); u32x4 kd; \
            kd.x = pk2(bflo(pk[i].x) * f, bfhi(pk[i].x) * f); kd.y = pk2(bflo(pk[i].y) * f, bfhi(pk[i].y) * f); kd.z = pk2(bflo(pk[i].z) * f, bfhi(pk[i].z) * f); kd.w = pk2(bflo(pk[i].w) * f, bfhi(pk[i].w) * f); \
            *(LAS u32x4*)(lds + R_KD + rr * 320 + ch * 16) = kd; } \
        _Pragma("unroll") for (int i = 0; i < 4; ++i) { const int idx = tid + 512 * i, rr = idx >> 5, ch = idx & 31; *(LAS u32x4*)(lds + R_V + rr * 576 + ch * 16) = pv[i]; } } while (0)
    R_PREFETCH(0);
    if (tid < 64) *(LAS float*)(lds + R_DEC + tid * 4) = sc_qk * exp2f(lg * (float)tid);
    R_STORE();
    LDS_BARRIER();
    for (int ci = 0; ci < SEQ / 64; ++ci) {
        const size_t t0 = row0 + (size_t)ci * 64;
        float lgl = lg;
#ifdef LGL
        asm volatile("" : "+v"(lgl));
#endif
        if (ci + 1 < SEQ / 64) R_PREFETCH(ci + 1);
#ifndef RG_LATE
#pragma unroll
        for (int j = 0; j < 8; ++j) prg[j] = *(const u32x2*)(RG + (t0 + er) * DM + h * 256 + 4 * (es + 8 * j));
#endif
        RSB();
        if (wave < 4) {
            const int qb = wave >> 1, kb = wave & 1; f32x16 x = f32x16{};
#pragma unroll
            for (int ks = 0; ks < 8; ++ks) { const bf16x8 af = *(const LAS bf16x8*)(lds + R_Q + (32 * qb + r32) * 272 + (16 * ks + 8 * hh) * 2);
                const bf16x8 bfr = *(const LAS bf16x8*)(lds + R_K + (32 * kb + r32) * 272 + (16 * ks + 8 * hh) * 2); x = MFMA32(af, bfr, x); }
#pragma unroll
            for (int i = 0; i < 16; ++i) { const int q = 32 * qb + crow(i, hh), k = 32 * kb + r32; const int d = q > k ? q - k : k - q;
                const float v = x[i] * *(const LAS float*)(lds + R_DEC + d * 4); *(LAS unsigned short*)(lds + R_SC + q * 144 + k * 2) = (unsigned short)f2bf(v); }
        }
        RSB();
        f32x16 y[2]; y[0] = f32x16{}; y[1] = f32x16{};
#pragma unroll
        for (int dkb = 0; dkb < 4; ++dkb)
#pragma unroll
            for (int s = 0; s < 2; ++s) { const bf16x8 sp = pack8(S[dkb], s);
#pragma unroll
                for (int qb = 0; qb < 2; ++qb) { const LAS unsigned char* qp = lds + R_QD + (32 * qb + r32) * 272 + (32 * dkb + 16 * s + 4 * hh) * 2;
                    const s16x4 lo = *(const LAS s16x4*)qp, hi = *(const LAS s16x4*)(qp + 16); y[qb] = MFMA32(cat8(lo, hi), sp, y[qb]); } }
        RSB();
        LDS_BARRIER();
        bf16x8 vf[4];
#pragma unroll
        for (int ks = 0; ks < 4; ++ks) { const LAS unsigned char* vp = lds + R_V + (16 * ks + 8 * hh + q4) * 576 + (32 * wave + 16 * g1) * 2 + 8 * p4; vf[ks] = cat8(tr_read(vp), tr_read(vp + 4 * 576)); }
#pragma unroll
        for (int ks = 0; ks < 4; ++ks)
#pragma unroll
            for (int qb = 0; qb < 2; ++qb) { const bf16x8 af = *(const LAS bf16x8*)(lds + R_SC + (32 * qb + r32) * 144 + (16 * ks + 8 * hh) * 2); y[qb] = MFMA32(af, vf[ks], y[qb]); }
        RSB();
#pragma unroll
        for (int dkb = 0; dkb < 4; ++dkb) {
#pragma unroll
            for (int i = 0; i < 16; ++i) S[dkb][i] *= cdec;
#pragma unroll
            for (int ks = 0; ks < 4; ++ks) { const LAS unsigned char* kp = lds + R_KD + (16 * ks + 8 * hh + q4) * 320 + (32 * dkb + 16 * g1) * 2 + 8 * p4;
                S[dkb] = MFMA32(cat8(tr_read(kp), tr_read(kp + 4 * 320)), vf[ks], S[dkb]); } }
        LDS_BARRIER();
#ifdef RG_LATE
#pragma unroll
        for (int j = 0; j < 8; ++j) prg[j] = *(const u32x2*)(RG + (t0 + er) * DM + h * 256 + 4 * (es + 8 * j));
#endif
#pragma unroll
        for (int qb = 0; qb < 2; ++qb)
#pragma unroll
            for (int i = 0; i < 16; ++i) *(LAS float*)(lds + (32 * qb + crow(i, hh)) * 1040 + (32 * wave + r32) * 4) = y[qb][i];
        LDS_BARRIER();
        { f32x4 yv[8]; float ss = 0.f;
#pragma unroll
            for (int j = 0; j < 8; ++j) { yv[j] = *(const LAS f32x4*)(lds + er * 1040 + 16 * (es + 8 * j)); ss += (yv[j].x * yv[j].x + yv[j].y * yv[j].y) + (yv[j].z * yv[j].z + yv[j].w * yv[j].w); }
            ss += shx(ss, 1, lane); ss += shx(ss, 2, lane); ss += shx(ss, 4, lane);
            const float rstd = 1.0f / sqrtf(ss * (1.f / 256.f) + NORM_EPS);
#pragma unroll
            for (int j = 0; j < 8; ++j) { const int c = 4 * (es + 8 * j); const f32x4 w = *(const f32x4*)(gn + c);
                const float g0 = bflo(prg[j].x), g1v = bfhi(prg[j].x), g2 = bflo(prg[j].y), g3 = bfhi(prg[j].y);
                u32x2 o; o.x = pk2(yv[j].x * rstd * w.x * g0 * pg8::sigmoid_f(g0), yv[j].y * rstd * w.y * g1v * pg8::sigmoid_f(g1v));
                o.y = pk2(yv[j].z * rstd * w.z * g2 * pg8::sigmoid_f(g2), yv[j].w * rstd * w.w * g3 * pg8::sigmoid_f(g3));
                if (!dummy || rstd == -12345.f) *(u32x2*)(RG + (t0 + er) * DM + h * 256 + c) = o; } }
        LDS_BARRIER();
        if (ci + 1 < SEQ / 64) R_STORE();
        LDS_BARRIER();
    }
#undef R_PREFETCH
#undef R_STORE
}

constexpr int A_KS = 272, A_VS = 320, A_KB = 64 * A_KS, A_VB = 64 * A_VS, A_BUF = A_KB + A_VB, A_X = 0;
static_assert(2 * A_BUF <= 131072 && 4 * 64 * 64 * 4 <= 131072, "attention LDS");
__device__ __forceinline__ void attn_unit(const Args& a, int l, int b, int h, int qb, float lam, float post, LAS unsigned char* lds, const int wave_s, const bool dummy = false) {
    asm volatile("" : "+s"(h));
    const int lane = hw_lane(), wave = wave_s, tid = wave_s * 64 + lane, r32 = lane & 31, hh = lane >> 5;
    const int q4 = (lane & 15) >> 2, p4 = lane & 3, g1 = (lane >> 4) & 1;
    const int sub = wave >> 2, wq = wave & 3;
    bf16* DQ = (bf16*)(a.ws + WS_B0 + 3 * ACT); const bf16* DK = (const bf16*)(a.ws + WS_B0 + 4 * ACT); const bf16* DV = (const bf16*)(a.ws + WS_B0 + 5 * ACT);
    const size_t row0 = (size_t)b * SEQ; const int q0 = qb * 128;
    const int NT = 2 * qb + 2;
    const float sl2 = sgpr_f(exp2f(-(float)(h + 1)) * LOG2E);
    bf16x8 qf[4];
    { const bf16* qp = DQ + (row0 + q0 + 32 * wq + r32) * DM + h * 128 + sub * 64 + 8 * hh;
#pragma unroll
        for (int ks = 0; ks < 4; ++ks) qf[ks] = *(const bf16x8*)(qp + 16 * ks); }
    u32x4 pk[2], pv[2];
#define A_PREFETCH(t) do { const size_t t0 = row0 + (size_t)(t) * 64; \
        _Pragma("unroll") for (int i = 0; i < 2; ++i) { const int idx = tid + 512 * i, rr = idx >> 4, ch = idx & 15; \
            pk[i] = *(const u32x4*)(DK + (t0 + rr) * DM + h * 128 + ch * 8); pv[i] = *(const u32x4*)(DV + (t0 + rr) * DM + h * 128 + ch * 8); } } while (0)
#define A_STORE(bufo) do { \
        _Pragma("unroll") for (int i = 0; i < 2; ++i) { const int idx = tid + 512 * i, rr = idx >> 4, ch = idx & 15; \
            *(LAS u32x4*)(lds + (bufo) + rr * A_KS + ch * 16) = pk[i]; *(LAS u32x4*)(lds + (bufo) + A_KB + rr * A_VS + ch * 16) = pv[i]; } } while (0)
    f32x16 o[4];
#pragma unroll
    for (int i = 0; i < 4; ++i) o[i] = f32x16{};
    float mrun = -1e30f, lrun = 0.f;
    f32x16 cb;
#pragma unroll
    for (int i = 0; i < 16; ++i) cb[i] = sl2 * (float)((i & 3) + 8 * (i >> 2) + 4 * hh);
    const float c32 = sgpr_f(32.f * sl2);
    const int tq = NT - 2 + (wq >> 1);
    const float qin = (float)(32 * (wq & 1) + r32), qs = sl2 * qin;
    const int tmin = max(0, (int)ceilf((128.f * (float)qb - 63.f - 220.f / sl2) * (1.f / 64.f)));
    A_PREFETCH(NT - 1);
    A_STORE(0);
    LDS_BARRIER();
    for (int it = 0; it < NT - tmin; ++it) {
        const int t = NT - 1 - it, bufo = (it & 1) * A_BUF;
        if (t > tmin) A_PREFETCH(t - 1);
        if (t <= tq) {
            f32x16 s[2];
            s[0] = cb;
#pragma unroll
            for (int i = 0; i < 16; ++i) s[1][i] = cb[i] + c32;
#pragma unroll
            for (int kb = 0; kb < 2; ++kb)
#pragma unroll
                for (int ks = 0; ks < 4; ++ks) { const bf16x8 kf = *(const LAS bf16x8*)(lds + bufo + (32 * kb + r32) * A_KS + (sub * 64 + 16 * ks + 8 * hh) * 2); s[kb] = MFMA32(kf, qf[ks], s[kb]); }
            float ut = -sl2 * (qin + 64.f * (float)(tq - t));
            if (t == tq) {
                ut = 0.f;
#pragma unroll
                for (int i = 0; i < 16; ++i) { const float c0 = cb[i], c1 = cb[i] + c32; s[0][i] = s[0][i] - c0 - fabsf(qs - c0); s[1][i] = s[1][i] - c1 - fabsf(qs - c1); }
            }
            float mt = fmaxf(s[0][0], s[1][0]);
#pragma unroll
            for (int i = 1; i < 16; ++i) mt = fmaxf(fmaxf(mt, s[0][i]), s[1][i]);
            mt = fmaxf(mt, shx(mt, 32, lane)) + ut;
            if (__any(mt > mrun)) {
                const float mnew = fmaxf(mrun, mt), alpha = __builtin_amdgcn_exp2f(mrun - mnew); mrun = mnew; lrun *= alpha;
#pragma unroll
                for (int d4 = 0; d4 < 4; ++d4)
#pragma unroll
                    for (int i = 0; i < 16; ++i) o[d4][i] *= alpha;
            }
            const float ml = mrun - ut;
            float ps = 0.f;
#pragma unroll
            for (int kb = 0; kb < 2; ++kb)
#pragma unroll
                for (int i = 0; i < 16; ++i) { s[kb][i] = __builtin_amdgcn_exp2f(s[kb][i] - ml); ps += s[kb][i]; }
            lrun += ps;
            __builtin_amdgcn_sched_barrier(0);
            {
                const LAS unsigned char* vbase = lds + bufo + A_KB + (4 * hh + q4) * A_VS + (16 * g1) * 2 + 8 * p4;
                bf16x8 vcur[4], vnxt[4];
#pragma unroll
                for (int d4 = 0; d4 < 4; ++d4) vcur[d4] = cat8(tr_read(vbase + 64 * d4), tr_read(vbase + 64 * d4 + 8 * A_VS));
#pragma unroll
                for (int g = 0; g < 4; ++g) {
                    if (g < 3) {
#pragma unroll
                        for (int d4 = 0; d4 < 4; ++d4) vnxt[d4] = cat8(tr_read(vbase + (g + 1) * 16 * A_VS + 64 * d4), tr_read(vbase + (g + 1) * 16 * A_VS + 64 * d4 + 8 * A_VS)); }
                    const bf16x8 pf = pack8v(s[g >> 1], g & 1);
#pragma unroll
                    for (int d4 = 0; d4 < 4; ++d4) o[d4] = MFMA32(vcur[d4], pf, o[d4]);
                    __builtin_amdgcn_sched_barrier(0);
#pragma unroll
                    for (int d4 = 0; d4 < 4; ++d4) vcur[d4] = vnxt[d4];
                }
            }
        }
        if (t > tmin) A_STORE(((it + 1) & 1) * A_BUF);
        LDS_BARRIER();
    }
    lrun += shx(lrun, 32, lane);
    const float rl = 1.0f / lrun;
    if (sub == 1) {
#pragma unroll
        for (int d4 = 0; d4 < 4; ++d4)
#pragma unroll
            for (int i = 0; i < 16; ++i) *(LAS float*)(lds + A_X + ((wq * 64 + d4 * 16 + i) * 64 + lane) * 4) = o[d4][i] * rl;
    }
    __syncthreads();
    if (sub == 0) {
        float ss = 0.f;
#pragma unroll
        for (int d4 = 0; d4 < 4; ++d4)
#pragma unroll
            for (int i = 0; i < 16; ++i) { const float v = o[d4][i] * rl - lam * *(const LAS float*)(lds + A_X + ((wq * 64 + d4 * 16 + i) * 64 + lane) * 4); o[d4][i] = v; ss += v * v; }
        ss += shx(ss, 32, lane);
        const float rstd = post / sqrtf(ss * (1.f / 128.f) + NORM_EPS);
        const float* sw = a.in[13] + (size_t)l * 128;
        bf16* op = DQ + (row0 + q0 + 32 * wq + r32) * DM + h * 128;
#pragma unroll
        for (int d4 = 0; d4 < 4; ++d4)
#pragma unroll
            for (int g = 0; g < 4; ++g) { const int dv = 32 * d4 + 8 * g + 4 * hh; const f32x4 w = *(const f32x4*)(sw + dv);
                u32x2 pkd; pkd.x = pk2(o[d4][4 * g] * rstd * w.x, o[d4][4 * g + 1] * rstd * w.y); pkd.y = pk2(o[d4][4 * g + 2] * rstd * w.z, o[d4][4 * g + 3] * rstd * w.w);
                if (!dummy || rstd == -12345.f) *(u32x2*)(op + dv) = pkd; }
    }
    __syncthreads();
#undef A_PREFETCH
#undef A_STORE
}


#define XB_TMO      128
#define XB_XCNT(j)  (256  + 64 * (j))
#define XB_XSUB(j)  (1280 + 64 * (j))
#define XB_XGEN(j)  (2304 + 64 * (j))
#define XB_TOP      3328
#define XB_TOPGEN   3392
#define XCD_BAR_WORDS 3456
#define XB_SPIN_CAP (1u << 24)

__device__ __forceinline__ unsigned xb_ld(unsigned* p)              { return __hip_atomic_load(p, __ATOMIC_RELAXED, __HIP_MEMORY_SCOPE_AGENT); }
__device__ __forceinline__ unsigned xb_add(unsigned* p, unsigned v) { return __hip_atomic_fetch_add(p, v, __ATOMIC_RELAXED, __HIP_MEMORY_SCOPE_AGENT); }
__device__ __forceinline__ unsigned xb_xcc_id() { return (unsigned)__builtin_amdgcn_s_getreg((3 << 11) | 20) & 0xFu; }
#define XB_SPIN(cond, bar) do { unsigned _sp = 0; while (cond) { __builtin_amdgcn_s_sleep(1); \
    if ((++_sp & 255u) == 0u) { if (xb_ld(&(bar)[XB_TMO])) break; if (_sp > XB_SPIN_CAP) { atomicAdd(&(bar)[XB_TMO], 1u); break; } } } } while (0)

struct XcdBarrier {
    unsigned* bar; unsigned x;
    volatile LAS unsigned* st;
};

__device__ __forceinline__ XcdBarrier xcd_barrier_post(unsigned* bar, volatile LAS unsigned* st, bool first) {
    XcdBarrier b; b.bar = bar; b.x = xb_xcc_id(); b.st = st;
    if (first) (void)xb_add(&bar[XB_XCNT(b.x)], 1u);
    return b;
}
__device__ __forceinline__ void xcd_barrier_complete(unsigned* bar, unsigned x, unsigned& nloc, unsigned& nx) {
    const unsigned G = gridDim.x * gridDim.y * gridDim.z;
    unsigned sum, cnt, mine, sp = 0u;
    for (;;) {
        sum = 0u; cnt = 0u; mine = 0u;
#pragma unroll
        for (unsigned j = 0; j < 16; ++j) { const unsigned c = xb_ld(&bar[XB_XCNT(j)]); sum += c; cnt += (c > 0u) ? 1u : 0u; mine = (j == x) ? c : mine; }
        if (sum == G) break;
        __builtin_amdgcn_s_sleep(1);
        if ((++sp & 255u) == 0u) { if (xb_ld(&bar[XB_TMO])) break; if (sp > XB_SPIN_CAP) { atomicAdd(&bar[XB_TMO], 1u); break; } }
    }
    nloc = mine > 0u ? mine : 1u; nx = cnt > 0u ? cnt : 1u;
}

__device__ __forceinline__ void xcd_barrier(const XcdBarrier& b, const bool first) {
    asm volatile("s_waitcnt vmcnt(0)" ::: "memory");
    __syncthreads();
    if (first) {
        unsigned* bar = b.bar;
        __builtin_amdgcn_s_waitcnt(0);
        unsigned nloc = b.st[0], nx = b.st[1];
        if (nloc == 0u) { xcd_barrier_complete(bar, b.x, nloc, nx); b.st[0] = nloc; b.st[1] = nx; }
        const unsigned old = xb_add(&bar[XB_XSUB(b.x)], 1u);
        const unsigned gen = old / nloc;
        if (old + 1u == (gen + 1u) * nloc) {
            __builtin_amdgcn_fence(__ATOMIC_RELEASE, "agent");
            asm volatile("s_waitcnt vmcnt(0)" ::: "memory");
            const unsigned og = xb_add(&bar[XB_TOP], 1u);
            const unsigned tg = og / nx;
            if (og + 1u == (tg + 1u) * nx) xb_add(&bar[XB_TOPGEN], 1u);
            else XB_SPIN(xb_ld(&bar[XB_TOPGEN]) == tg, bar);
            __builtin_amdgcn_fence(__ATOMIC_ACQUIRE, "agent");
            xb_add(&bar[XB_XGEN(b.x)], 1u);
            asm volatile("s_waitcnt vmcnt(0)" ::: "memory");
        } else {
            XB_SPIN(xb_ld(&bar[XB_XGEN(b.x)]) == gen, bar);
            __builtin_amdgcn_fence(__ATOMIC_ACQUIRE, "agent");
            asm volatile("s_waitcnt vmcnt(0)" ::: "memory");
        }
    }
    __syncthreads();
}

#define CG_SYNC() do { asm volatile("s_waitcnt vmcnt(0) lgkmcnt(0)" ::: "memory"); __syncthreads(); grid.sync(); \
    __builtin_amdgcn_fence(__ATOMIC_ACQUIRE, "agent"); asm volatile("s_waitcnt vmcnt(0)" ::: "memory"); __syncthreads(); } while (0)
#define IS_T0 (wave_s == 0 && hw_lane() == 0)
#define GRID_SYNC() xcd_barrier(xbar, IS_T0)
constexpr int CW_BAR = 4096;
typedef const __attribute__((address_space(4))) Args* KArgsPtr;
#define PHASE_BEGIN Args a; { KArgsPtr ka_ = (KArgsPtr)__builtin_amdgcn_kernarg_segment_ptr(); asm volatile("" : "+s"(ka_)); _Pragma("unroll") for (int i_ = 0; i_ < 18; ++i_) a.in[i_] = ka_->in[i_]; a.out = ka_->out; a.ws = ka_->ws; } \
    const int lane = hw_lane(), wave = wave_s, tid = wave_s * 64 + lane; const int G = gridDim.x, gw = blockIdx.x * NWAVES + wave, ngw = G * NWAVES; \
    unsigned* ctl = (unsigned*)(a.ws + WS_CTL); const float* mod = (const float*)(a.ws + WS_MOD); bf16* WT = (bf16*)(a.ws + WS_WT); bf16* H = (bf16*)(a.ws + WS_H); bf16* HID = (bf16*)(a.ws + WS_HID); bf16* B0 = (bf16*)(a.ws + WS_B0); \
    (void)tid; (void)lane; (void)wave; (void)G; (void)gw; (void)ngw; (void)ctl; (void)mod; (void)WT; (void)H; (void)HID; (void)B0;
#define GEMM_RUN(EPI, ...) do { pg8::StaticOrder S; S.init(MROWS, g.N, G, (int)blockIdx.x); EPI E{__VA_ARGS__}; pg8::gemm_phase<EPI, pg8::StaticOrder, true, true>(lds, g, S, E, wave_s); } while (0)

__global__ void __launch_bounds__(NTHR, 2) hybrid_fwd(Args args_unused) {
    extern __shared__ __attribute__((aligned(16))) unsigned char lds_raw[];
    LAS unsigned char* lds = (LAS unsigned char*)lds_raw;
    cg::grid_group grid = cg::this_grid();
    const int wave_s = __builtin_amdgcn_readfirstlane((int)threadIdx.x >> 6);
    LAS unsigned* qslot = (LAS unsigned*)(lds + 131072);

    {
        PHASE_BEGIN
        if (blockIdx.x == 0) { if (tid < 64) ctl[tid] = 0u; for (int i = tid; i < XCD_BAR_WORDS; i += NTHR) ctl[CW_BAR + i] = 0u; }
        ada_phase(a, lds, wave, lane);
        convert_weights(a, 0, lds, gw, ngw, wave, lane);
    }
    CG_SYNC();
    XcdBarrier xbar;
    {   PHASE_BEGIN
        volatile LAS unsigned* st = (volatile LAS unsigned*)(lds + 131072 + 16);
        if (tid < 2) st[tid] = 0u;
        __syncthreads();
        xbar = xcd_barrier_post(ctl + CW_BAR, st, tid == 0);
    }

    for (int l = 0; l < DEPTH; ++l) {
        {
            PHASE_BEGIN
            if (l > 0) convert_weights(a, l, lds, gw, ngw, wave, lane);
            norm_phase(a, (l == 0) ? a.in[0] : a.out, l, 0, gw, ngw, lane);
        }
        GRID_SYNC();
#ifdef UP_TWICE
        { PHASE_BEGIN pg8::Gemm g{H, WT + W_UPA, MROWS, 2 * DFF, DM}; GEMM_RUN(pg8::EpiSwiGLU, HID, DFF); }
        GRID_SYNC();
#endif
        { PHASE_BEGIN pg8::Gemm g{H, WT + W_UPA, MROWS, 2 * DFF, DM}; GEMM_RUN(pg8::EpiSwiGLU, HID, DFF); }
        GRID_SYNC();
        { PHASE_BEGIN pg8::Gemm g{HID, WT + W_DNA, MROWS, DM, DFF}; GEMM_RUN(pg8::EpiResid, (l == 0) ? a.in[0] : a.out, a.out, mod + (size_t)l * NB * NMOD + 0 * 3 * DM + 2 * DM, NMOD, 0.5f, DM); }
        GRID_SYNC();
        { PHASE_BEGIN norm_phase(a, a.out, l, 1, gw, ngw, lane); }
        GRID_SYNC();
        { PHASE_BEGIN pg8::Gemm g{H, WT + W_IN, MROWS, 6 * DM, DM}; GEMM_RUN(pg8::EpiBf<0>, B0, DM, DM, (size_t)MROWS * DM, 3, 0.125f * LOG2E, nullptr); }
        GRID_SYNC();
        {
            PHASE_BEGIN
#ifdef RET_TWICE
            if (blockIdx.x < 32) retention_unit(a, l, blockIdx.x >> 2, blockIdx.x & 3, lds, wave_s, true);
#endif
            if (blockIdx.x < 32) retention_unit(a, l, blockIdx.x >> 2, blockIdx.x & 3, lds, wave_s);
            const float s1 = wave_sum(a.in[9][l * 64 + lane] * a.in[10][l * 64 + lane], lane), s2 = wave_sum(a.in[11][l * 64 + lane] * a.in[12][l * 64 + lane], lane);
            const float lam_init = sgpr_f(0.8f - 0.6f * expf(-0.3f * (float)l)), lam = sgpr_f(expf(s1) - expf(s2) + lam_init);
#ifdef ATT_TWICE
            for (;;) {
                if (tid == 0) *qslot = atomicAdd(ctl + 8 + l, 1u);
                __syncthreads();
                const unsigned item = *qslot;
                __syncthreads();
                if (item >= 64u * 64u) break;
                const int qb = 63 - (int)(item >> 6), bh = (int)(item & 63u);
                attn_unit(a, l, bh >> 3, bh & 7, qb, lam, 1.0f - lam_init, lds, wave_s, true);
            }
#endif
            const int q0 = (int)(xb_xcc_id() & 7u);
            for (int k = 0; k < NB; ++k) {
                const int bq = (q0 + k) & 7;
                for (;;) {
                    if (tid == 0) *qslot = atomicAdd(ctl + l * NB + bq, 1u);
                    __syncthreads();
                    const unsigned item = *qslot;
                    __syncthreads();
                    if (item >= 8u * 64u) break;
                    attn_unit(a, l, bq, 7 - (int)(item >> 6), 63 - (int)(item & 63u), lam, 1.0f - lam_init, lds, wave_s);
                }
            }
        }
        GRID_SYNC();
        {
            PHASE_BEGIN pg8::Gemm g{H, WT + W_IN + (size_t)6 * DM * DM, MROWS, DM, DM, H, WT + W_IN + (size_t)7 * DM * DM, B0 + (size_t)2 * MROWS * DM, WT + W_RET, B0 + (size_t)3 * MROWS * DM, WT + W_DIF};
            pg8::SegOrderN<2> S; S.init(MROWS, g.N, G, (int)blockIdx.x); pg8::EpiMerge E{B0 + (size_t)1 * MROWS * DM, DM, B0, B0 + (size_t)4 * MROWS * DM};
            pg8::gemm_phase<pg8::EpiMerge, pg8::SegOrderN<2>, true, true>(lds, g, S, E, wave_s); }
        GRID_SYNC();
        { PHASE_BEGIN pg8::Gemm g{B0 + (size_t)1 * MROWS * DM, WT + W_OUT, MROWS, DM, DM}; GEMM_RUN(pg8::EpiResid, a.out, a.out, mod + (size_t)l * NB * NMOD + 1 * 3 * DM + 2 * DM, NMOD, 1.0f, DM); }
        GRID_SYNC();
        { PHASE_BEGIN norm_phase(a, a.out, l, 2, gw, ngw, lane); }
        GRID_SYNC();
        { PHASE_BEGIN pg8::Gemm g{H, WT + W_UPB, MROWS, 2 * DFF, DM}; GEMM_RUN(pg8::EpiSwiGLU, HID, DFF); }
        GRID_SYNC();
        { PHASE_BEGIN pg8::Gemm g{HID, WT + W_DNB, MROWS, DM, DFF}; GEMM_RUN(pg8::EpiResid, a.out, a.out, mod + (size_t)l * NB * NMOD + 2 * 3 * DM + 2 * DM, NMOD, 0.5f, DM); }
        GRID_SYNC();
    }
#ifdef SYNC_PROBE
    for (int i = 0; i < 64; ++i) GRID_SYNC();
#endif
    { PHASE_BEGIN final_norm_phase(a, gw, ngw, lane); }
}

constexpr int LDS_BYTES = 147456;
extern "C" void kernel_launch(void* const* d_in, const int* in_sizes, int n_in, void* d_out, int out_size, void* d_ws, size_t ws_size, hipStream_t stream) {
    static int grid = 0;
    if (grid == 0) {
        if (n_in != 18 || ws_size < WS_END) { fprintf(stderr, "kernel_launch: unexpected n_in %d / ws_size %zu (need %zu)\n", n_in, ws_size, (size_t)WS_END); grid = -1; return; }
        int dev = 0, cus = 0, per_cu = 0;
        (void)hipGetDevice(&dev); (void)hipDeviceGetAttribute(&cus, hipDeviceAttributeMultiprocessorCount, dev);
        if (hipFuncSetAttribute((const void*)hybrid_fwd, hipFuncAttributeMaxDynamicSharedMemorySize, LDS_BYTES) != hipSuccess) { fprintf(stderr, "kernel_launch: hipFuncSetAttribute failed\n"); grid = -1; return; }
        if (hipOccupancyMaxActiveBlocksPerMultiprocessor(&per_cu, (const void*)hybrid_fwd, NTHR, LDS_BYTES) != hipSuccess || per_cu < 1) { fprintf(stderr, "kernel_launch: occupancy query says %d\n", per_cu); per_cu = 1; }
        (void)hipGetLastError();
        grid = cus * 1;
    }
    if (grid < 0) return;
    Args a{};
    for (int i = 0; i < 18; ++i) a.in[i] = (const float*)d_in[i];
    a.out = (float*)d_out; a.ws = (unsigned char*)d_ws;
    void* kargs[] = {&a};
    hipError_t e = hipLaunchCooperativeKernel((const void*)hybrid_fwd, dim3(grid), dim3(NTHR), kargs, LDS_BYTES, stream);
    if (e != hipSuccess) fprintf(stderr, "cooperative launch failed: %s (grid %d)\n", hipGetErrorString(e), grid);
}
```

```cpp
#define GATE_LOGITS 1
#include <hip/hip_runtime.h>
#include <hip/hip_cooperative_groups.h>
#include <cstdio>
#include <cstdint>
namespace cg = cooperative_groups;
#define USE_RSB 1
__device__ __forceinline__ int hw_lane() { int l = (int)__builtin_amdgcn_mbcnt_hi(~0u, __builtin_amdgcn_mbcnt_lo(~0u, 0u)); asm volatile("" : "+v"(l)); return l; }
namespace pg8 {
#define PG8_LAS __attribute__((address_space(3)))
typedef unsigned short bf16_t;
typedef short bf16x8 __attribute__((ext_vector_type(8)));
typedef float f32x4 __attribute__((ext_vector_type(4)));
typedef unsigned u32x4 __attribute__((ext_vector_type(4)));
constexpr int BM = 256, BK = 64, HALF = 128, HTB = HALF * BK * 2  , STAGE_BYTES = 8 * HTB, NXCD = 8, WGM = 8;

__host__ __device__ __forceinline__ int lds_byte(int r, int c) { const int st = (r >> 4) * 2 + (c >> 5), rr = r & 15, cc = c & 31, ob = rr * 64 + cc * 2; return st * 1024 + (ob ^ (((ob >> 9) & 1) << 5)); }
__host__ __device__ __forceinline__ void stage_rc(int b, int& R, int& C) { const int st = b / 1024, sb = b % 1024, swz = sb ^ (((sb >> 9) & 1) << 5); R = (st >> 1) * 16 + swz / 64; C = (st & 1) * 32 + (swz % 64) / 2; }
__host__ __device__ __forceinline__ int perm32(int rho) { const int n = rho >> 4, i = rho & 15; return 8 * (i >> 2) + 4 * n + (i & 3); }

struct Unit { int pm, pn, seg; };
struct Gemm { const bf16_t* A; const bf16_t* Bt; int M, N, K; const bf16_t* A2; const bf16_t* Bt2; const bf16_t* A3; const bf16_t* Bt3; const bf16_t* A4; const bf16_t* Bt4; };
__host__ __device__ __forceinline__ const bf16_t* seg_a(const Gemm& g, int sg) { return sg == 0 ? g.A : sg == 1 ? g.A2 : sg == 2 ? g.A3 : g.A4; }
__host__ __device__ __forceinline__ const bf16_t* seg_b(const Gemm& g, int sg) { return sg == 0 ? g.Bt : sg == 1 ? g.Bt2 : sg == 2 ? g.Bt3 : g.Bt4; }

struct StaticOrder {
    int nM, nN, nwg, G, c;
    __host__ __device__ void init(int M, int N, int G_, int c_) { nM = M / BM; nN = N / BM; nwg = nM * nN; G = G_; c = c_; }
    __host__ __device__ bool next(int i, Unit& u) const {
        const long L = (long)i * G + c; if (L >= nwg) return false;
        int wgid = (int)L; { const int q = nwg / NXCD, r = nwg % NXCD, xcd = wgid % NXCD, off = wgid / NXCD; wgid = (xcd < r ? xcd * (q + 1) : r * (q + 1) + (xcd - r) * q) + off; }
        const int nig = WGM * nN, gid = wgid / nig, fm = gid * WGM, gsz = (nM - fm) < WGM ? (nM - fm) : WGM;
        u.pm = fm + ((wgid % nig) % gsz); u.pn = (wgid % nig) / gsz; u.seg = 0; return true;
    }
    __device__ __forceinline__ void a_ready(const Unit&) const {}
    __device__ __forceinline__ void done(const Unit&) const {}
};
template <int LOG2SEG> struct SegOrderN {
    StaticOrder base;
    __host__ __device__ void init(int M, int N, int G_, int c_) { base.init(M, N, G_, c_); }
    __host__ __device__ bool next(int i, Unit& u) const { const bool ok = base.next(i >> LOG2SEG, u); u.seg = i & ((1 << LOG2SEG) - 1); return ok; }
    __device__ __forceinline__ void a_ready(const Unit&) const {}
    __device__ __forceinline__ void done(const Unit&) const {}
};
template <class E, class = void> struct epi_seg { static constexpr bool value = false; };
template <class E> struct epi_seg<E, decltype((void)E::SEG)> { static constexpr bool value = E::SEG; };
template <class E> __host__ __device__ __forceinline__ bool epi_keep(int sg) { if constexpr (epi_seg<E>::value) return E::keep_acc(sg); else return false; }


__device__ __forceinline__ unsigned cvt_pk_bf16(float lo, float hi) { unsigned r; asm volatile("v_cvt_pk_bf16_f32 %0, %1, %2" : "=v"(r) : "v"(lo), "v"(hi)); return r; }
typedef float f32x2 __attribute__((ext_vector_type(2)));

__device__ __forceinline__ float sigmoid_f(float v) { return __builtin_amdgcn_rcpf(1.0f + __builtin_amdgcn_exp2f(-1.4426950408889634f * v)); }
__device__ __forceinline__ float bf_lo(unsigned w) { return __uint_as_float(w << 16); }
__device__ __forceinline__ float bf_hi(unsigned w) { return __uint_as_float(w & 0xffff0000u); }

struct EpiSwiGLU {
    static constexpr bool PERM = true, AFTER_DRAIN = false;
    bf16_t* O; int ldc;
    __device__ __forceinline__ void operator()(const f32x4 (&acc)[2][2][4][2], const Unit& u, int wr, int wc, int fr, int fq) const {
        const int row0 = u.pm * BM + wr * 64 + fr, col0 = u.pn * HALF + wc * 32 + 8 * fq;
#pragma unroll
        for (int ai = 0; ai < 2; ++ai)
#pragma unroll
            for (int m = 0; m < 4; ++m) {
                bf16_t* rowp = O + (size_t)(row0 + ai * HALF + m * 16) * ldc + col0;
                float v[8];
#pragma unroll
                for (int n = 0; n < 2; ++n)
#pragma unroll
                    for (int e = 0; e < 4; ++e) { const float a = acc[ai][0][m][n][e], b = acc[ai][1][m][n][e]; v[4 * n + e] = a * sigmoid_f(a) * b; }
                u32x4 w; w.x = cvt_pk_bf16(v[0], v[1]); w.y = cvt_pk_bf16(v[2], v[3]); w.z = cvt_pk_bf16(v[4], v[5]); w.w = cvt_pk_bf16(v[6], v[7]);
                *(u32x4*)rowp = w;
            }
    }
};
struct EpiResid {
    static constexpr bool PERM = false, AFTER_DRAIN = false;
    const float* base; float* out; const float* gate; int gate_bstride; float coef; int ldc;
    __device__ __forceinline__ void operator()(const f32x4 (&acc)[2][2][4][2], const Unit& u, int wr, int wc, int fr, int fq) const {
        const int col0 = u.pn * BM + wc * 32 + 4 * fq;
        const float* g = gate + (size_t)(u.pm >> 5) * gate_bstride;
        f32x4 gv[2][2];
#pragma unroll
        for (int bj = 0; bj < 2; ++bj)
#pragma unroll
            for (int n = 0; n < 2; ++n) gv[bj][n] = *(const f32x4*)(g + col0 + bj * HALF + n * 16) * coef;
#pragma unroll
        for (int ai = 0; ai < 2; ++ai)
#pragma unroll
            for (int m = 0; m < 4; ++m) { const size_t off = (size_t)(u.pm * BM + ai * HALF + wr * 64 + m * 16 + fr) * ldc + col0;
#pragma unroll
                for (int bj = 0; bj < 2; ++bj)
#pragma unroll
                    for (int n = 0; n < 2; ++n) { const f32x4 bs = *(const f32x4*)(base + off + bj * HALF + n * 16); *(f32x4*)(out + off + bj * HALF + n * 16) = bs + gv[bj][n] * acc[ai][bj][m][n]; } }
    }
};
#ifdef GATE_LOGITS
#define GSIG(x) sigmoid_f(x)
#else
#define GSIG(x) (x)
#endif
template <int MODE> struct EpiBf {
    static constexpr bool PERM = true, AFTER_DRAIN = false;
    bf16_t* O; int ldc; int split_cols; size_t split_stride; int qt; float qscale; const bf16_t* G;
    __device__ __forceinline__ void operator()(const f32x4 (&acc)[2][2][4][2], const Unit& u, int wr, int wc, int fr, int fq) const {
        const int row0 = u.pm * BM + wr * 64 + fr; int colt = u.pn * BM; bf16_t* base = O; float sc = 1.f;
        if (MODE <= 1) { const int t = colt / split_cols; base += (size_t)t * split_stride; colt -= t * split_cols; if (MODE == 0 && t == qt) sc = qscale; }
        const int col0 = colt + wc * 32 + 8 * fq;
#pragma unroll
        for (int ai = 0; ai < 2; ++ai)
#pragma unroll
            for (int m = 0; m < 4; ++m) { const size_t roff = (size_t)(row0 + ai * HALF + m * 16) * ldc + col0;
#pragma unroll
                for (int bj = 0; bj < 2; ++bj) {
                    f32x4 v0 = acc[ai][bj][m][0], v1 = acc[ai][bj][m][1];
                    if (MODE == 0) { v0 = v0 * sc; v1 = v1 * sc; }
                    if (MODE == 1) {
#pragma unroll
                        for (int e = 0; e < 4; ++e) { v0[e] = sigmoid_f(v0[e]); v1[e] = sigmoid_f(v1[e]); } }
                    if (MODE >= 2) { const u32x4 g = *(const u32x4*)(G + roff + bj * HALF);
                        v0[0] *= GSIG(bf_lo(g.x)); v0[1] *= GSIG(bf_hi(g.x)); v0[2] *= GSIG(bf_lo(g.y)); v0[3] *= GSIG(bf_hi(g.y)); v1[0] *= GSIG(bf_lo(g.z)); v1[1] *= GSIG(bf_hi(g.z)); v1[2] *= GSIG(bf_lo(g.w)); v1[3] *= GSIG(bf_hi(g.w)); }
                    if (MODE == 3) { const u32x4 t = *(const u32x4*)(base + roff + bj * HALF);
                        v0[0] += bf_lo(t.x); v0[1] += bf_hi(t.x); v0[2] += bf_lo(t.y); v0[3] += bf_hi(t.y); v1[0] += bf_lo(t.z); v1[1] += bf_hi(t.z); v1[2] += bf_lo(t.w); v1[3] += bf_hi(t.w); }
                    u32x4 w; w.x = cvt_pk_bf16(v0[0], v0[1]); w.y = cvt_pk_bf16(v0[2], v0[3]); w.z = cvt_pk_bf16(v1[0], v1[1]); w.w = cvt_pk_bf16(v1[2], v1[3]);
                    *(u32x4*)(base + roff + bj * HALF) = w; } }
    }
};
struct EpiMerge {
    static constexpr bool PERM = true, AFTER_DRAIN = false, SEG = true;
    __host__ __device__ static constexpr bool keep_acc(int sg) { return sg == 3; }
    bf16_t* O; int ldc; bf16_t* GR; bf16_t* GD;
    __device__ __forceinline__ void operator()(f32x4 (&acc)[2][2][4][2], const Unit& u, int wr, int wc, int fr, int fq) const {
        const int row0 = u.pm * BM + wr * 64 + fr, col0 = u.pn * BM + wc * 32 + 8 * fq;
#pragma unroll
        for (int ai = 0; ai < 2; ++ai)
#pragma unroll
            for (int m = 0; m < 4; ++m) { const size_t roff = (size_t)(row0 + ai * HALF + m * 16) * ldc + col0;
#pragma unroll
                for (int bj = 0; bj < 2; ++bj) {
                    if (u.seg < 2) {
                        float v[8];
#pragma unroll
                        for (int e = 0; e < 8; ++e) v[e] = __builtin_fmaxf(acc[ai][bj][m][e >> 2][e & 3], -3.0e38f);
                        u32x4 w; w.x = cvt_pk_bf16(v[0], v[1]); w.y = cvt_pk_bf16(v[2], v[3]); w.z = cvt_pk_bf16(v[4], v[5]); w.w = cvt_pk_bf16(v[6], v[7]);
                        *(u32x4*)((u.seg == 0 ? GR : GD) + roff + bj * HALF) = w;
                    } else {
                        const u32x4 gd = *(const u32x4*)(GD + roff + bj * HALF);
                        const float d[8] = {bf_lo(gd.x), bf_hi(gd.x), bf_lo(gd.y), bf_hi(gd.y), bf_lo(gd.z), bf_hi(gd.z), bf_lo(gd.w), bf_hi(gd.w)};
                        if (u.seg == 2) {
                            const u32x4 gr = *(const u32x4*)(GR + roff + bj * HALF);
                            const float r[8] = {bf_lo(gr.x), bf_hi(gr.x), bf_lo(gr.y), bf_hi(gr.y), bf_lo(gr.z), bf_hi(gr.z), bf_lo(gr.w), bf_hi(gr.w)};
#pragma unroll
                            for (int e = 0; e < 8; ++e) { const float ed = __builtin_amdgcn_exp2f(-1.4426950408889634f * d[e]), er = __builtin_amdgcn_exp2f(-1.4426950408889634f * r[e]);
                                acc[ai][bj][m][e >> 2][e & 3] *= (1.0f + ed) * __builtin_amdgcn_rcpf(1.0f + er); }
                        } else {
                            float v[8];
#pragma unroll
                            for (int e = 0; e < 8; ++e) v[e] = acc[ai][bj][m][e >> 2][e & 3] * sigmoid_f(d[e]);
                            u32x4 w; w.x = cvt_pk_bf16(v[0], v[1]); w.y = cvt_pk_bf16(v[2], v[3]); w.z = cvt_pk_bf16(v[4], v[5]); w.w = cvt_pk_bf16(v[6], v[7]);
                            *(u32x4*)(O + roff + bj * HALF) = w; }
                    }
                } }
    }
};


template <class Epi, class Sched, bool ALIGN_EPI = false, bool SP2 = false>
__device__ __forceinline__ void gemm_phase(PG8_LAS unsigned char* lds, const Gemm g, const Sched& S, const Epi& E, const int wave_s) {
    const int lane = hw_lane(), wid = wave_s, tid = wave_s * 64 + lane, wr = wid >> 2, wc = wid & 3, fr = lane & 15, fq = lane >> 4;
    const int K = g.K, nt = K / BK;
    unsigned voffA[2], voffB[2];
#pragma unroll
    for (int i = 0; i < 2; ++i) { int R, C; stage_rc(tid * 16 + i * 8192, R, C); const int Rb = Epi::PERM ? ((R & ~31) + perm32(R & 31)) : R;
        voffA[i] = (unsigned)(R * K + C) * 2u; voffB[i] = (unsigned)(Rb * K + C) * 2u; }
    const size_t kstep = (size_t)(BK * 2);
    const size_t hstep = (size_t)HALF * K * 2;
    const size_t tstep = 2 * hstep;
    const unsigned ldsw = (unsigned)wid * 1024u;
    const int aoff = lds_byte(wr * 64 + fr, fq * 8), boff = lds_byte(wc * 32 + fr, fq * 8);
#define PG8_SA(b, h) (((b) * 2 + (h)) * HTB)
#define PG8_SB(b, h) ((4 + (b) * 2 + (h)) * HTB)
#define PG8_STAGE(bufoff, gbase, voff) do { _Pragma("unroll") for (int _i = 0; _i < 2; ++_i) \
        __builtin_amdgcn_global_load_lds((const unsigned*)((const char*)(gbase) + (voff)[_i]), (PG8_LAS unsigned*)(lds + (bufoff) + ldsw + _i * 8192), 16, 0, 0); } while (0)
#define PG8_LDA(dst, b, h) do { _Pragma("unroll") for (int m = 0; m < 4; ++m) _Pragma("unroll") for (int k = 0; k < 2; ++k) dst[m][k] = *(const PG8_LAS bf16x8*)(lds + PG8_SA(b, h) + aoff + m * 2048 + k * 1024); } while (0)
#define PG8_LDB(dst, b, h) do { _Pragma("unroll") for (int n = 0; n < 2; ++n) _Pragma("unroll") for (int k = 0; k < 2; ++k) dst[n][k] = *(const PG8_LAS bf16x8*)(lds + PG8_SB(b, h) + boff + n * 2048 + k * 1024); } while (0)
#define PG8_MMA(ai, bj, At, Bt) do { __builtin_amdgcn_s_setprio(1); _Pragma("unroll") for (int m = 0; m < 4; ++m) _Pragma("unroll") for (int n = 0; n < 2; ++n) _Pragma("unroll") for (int k = 0; k < 2; ++k) \
        acc[ai][bj][m][n] = __builtin_amdgcn_mfma_f32_16x16x32_bf16(Bt[n][k], At[m][k], acc[ai][bj][m][n], 0, 0, 0); __builtin_amdgcn_s_setprio(0); } while (0)
#define PG8_WAIT_V(n) asm volatile("s_waitcnt vmcnt(" #n ")" ::: "memory")
#define PG8_WAIT_L(n) asm volatile("s_waitcnt lgkmcnt(" #n ")" ::: "memory")
#define PG8_BAR __builtin_amdgcn_s_barrier()
#define PG8_SCHED __builtin_amdgcn_sched_barrier(0)
    Unit cur, nxt; int ui = 0;
    if (!S.next(0, cur)) return;
    f32x4 acc[2][2][4][2];
#pragma unroll
    for (int a = 0; a < 2; ++a)
#pragma unroll
        for (int b = 0; b < 2; ++b)
#pragma unroll
            for (int m = 0; m < 4; ++m)
#pragma unroll
                for (int n = 0; n < 2; ++n) acc[a][b][m][n] = (f32x4){0.f, 0.f, 0.f, 0.f};
    bf16x8 At[4][2], B0[2][2], B1[2][2];
    const char* cA = (const char*)seg_a(g, cur.seg) + (size_t)cur.pm * tstep; const char* cB = (const char*)seg_b(g, cur.seg) + (size_t)cur.pn * tstep;
    S.a_ready(cur);
    if constexpr (SP2) {
        PG8_STAGE(PG8_SB(0, 0), cB, voffB); PG8_STAGE(PG8_SB(0, 1), cB + hstep, voffB); PG8_STAGE(PG8_SA(0, 0), cA, voffA); PG8_STAGE(PG8_SA(0, 1), cA + hstep, voffA);
        if (wr == 1) PG8_BAR;
        PG8_WAIT_V(2); PG8_BAR;
        PG8_STAGE(PG8_SB(1, 0), cB + kstep, voffB); PG8_STAGE(PG8_SA(1, 0), cA + kstep, voffA); PG8_STAGE(PG8_SB(1, 1), cB + hstep + kstep, voffB);
        PG8_WAIT_V(6); PG8_BAR;
    } else {
        PG8_STAGE(PG8_SB(0, 0), cB, voffB); PG8_STAGE(PG8_SA(0, 0), cA, voffA); PG8_STAGE(PG8_SB(0, 1), cB + hstep, voffB); PG8_STAGE(PG8_SA(0, 1), cA + hstep, voffA);
        if (wr == 1) PG8_BAR;
        PG8_WAIT_V(4); PG8_BAR;
        PG8_STAGE(PG8_SB(1, 0), cB + kstep, voffB); PG8_STAGE(PG8_SA(1, 0), cA + kstep, voffA); PG8_STAGE(PG8_SB(1, 1), cB + hstep + kstep, voffB);
        PG8_WAIT_V(6); PG8_BAR;
    }
    for (;;) {
        const bool has_next = S.next(ui + 1, nxt);
        const char* nA = has_next ? (const char*)seg_a(g, nxt.seg) + (size_t)nxt.pm * tstep : cA; const char* nB = has_next ? (const char*)seg_b(g, nxt.seg) + (size_t)nxt.pn * tstep : cB;
        for (int t = 0; t < nt; t += 2) {
            const bool last = (t == nt - 2);
            const char* a1 = cA + (size_t)(t + 1) * kstep;
            const char* a2 = last ? nA : cA + (size_t)(t + 2) * kstep; const char* b2 = last ? nB : cB + (size_t)(t + 2) * kstep;
            const char* a3 = a2 + kstep; const char* b3 = b2 + kstep;
            if (last && has_next) S.a_ready(nxt);
            if constexpr (SP2) {
            PG8_LDB(B0, 0, 0); PG8_LDB(B1, 0, 1); PG8_SCHED; PG8_LDA(At, 0, 0); PG8_STAGE(PG8_SA(1, 1), a1 + hstep, voffA);
            PG8_WAIT_V(8); PG8_WAIT_L(0); PG8_BAR; PG8_MMA(0, 0, At, B0); PG8_MMA(0, 1, At, B1); PG8_BAR; PG8_SCHED;
            PG8_LDA(At, 0, 1); PG8_STAGE(PG8_SB(0, 0), b2, voffB); PG8_STAGE(PG8_SB(0, 1), b2 + hstep, voffB); PG8_STAGE(PG8_SA(0, 0), a2, voffA);
            PG8_WAIT_V(8); PG8_WAIT_L(0); PG8_BAR; PG8_MMA(1, 0, At, B0); PG8_MMA(1, 1, At, B1); PG8_BAR; PG8_SCHED;
            PG8_LDB(B0, 1, 0); PG8_LDB(B1, 1, 1); PG8_SCHED; PG8_LDA(At, 1, 0); PG8_STAGE(PG8_SA(0, 1), a2 + hstep, voffA);
            PG8_WAIT_V(8); PG8_WAIT_L(0); PG8_BAR; PG8_MMA(0, 0, At, B0); PG8_MMA(0, 1, At, B1); PG8_BAR; PG8_SCHED;
            PG8_LDA(At, 1, 1); PG8_STAGE(PG8_SB(1, 0), b3, voffB); PG8_STAGE(PG8_SB(1, 1), b3 + hstep, voffB); PG8_STAGE(PG8_SA(1, 0), a3, voffA);
            PG8_WAIT_V(8); PG8_WAIT_L(0); PG8_BAR; PG8_MMA(1, 0, At, B0); PG8_MMA(1, 1, At, B1); PG8_BAR; PG8_SCHED;
            } else {
            PG8_LDB(B0, 0, 0); PG8_SCHED; PG8_LDA(At, 0, 0); PG8_STAGE(PG8_SA(1, 1), a1 + hstep, voffA);
            PG8_WAIT_L(8); PG8_BAR; PG8_WAIT_L(0); PG8_MMA(0, 0, At, B0); PG8_BAR; PG8_SCHED;
            PG8_LDB(B1, 0, 1); PG8_STAGE(PG8_SB(0, 0), b2, voffB);
            PG8_BAR; PG8_WAIT_L(0); PG8_MMA(0, 1, At, B1); PG8_BAR;
            PG8_LDA(At, 0, 1); PG8_STAGE(PG8_SA(0, 0), a2, voffA);
            PG8_BAR; PG8_WAIT_L(0); PG8_MMA(1, 0, At, B0); PG8_BAR; PG8_SCHED;
            PG8_STAGE(PG8_SB(0, 1), b2 + hstep, voffB);
            PG8_WAIT_V(6); PG8_BAR; PG8_MMA(1, 1, At, B1); PG8_BAR;
            PG8_LDB(B0, 1, 0); PG8_SCHED; PG8_LDA(At, 1, 0); PG8_STAGE(PG8_SA(0, 1), a2 + hstep, voffA);
            PG8_WAIT_L(8); PG8_BAR; PG8_WAIT_L(0); PG8_MMA(0, 0, At, B0); PG8_BAR; PG8_SCHED;
            PG8_LDB(B1, 1, 1); PG8_STAGE(PG8_SB(1, 0), b3, voffB);
            PG8_BAR; PG8_WAIT_L(0); PG8_MMA(0, 1, At, B1); PG8_BAR;
            PG8_LDA(At, 1, 1); PG8_STAGE(PG8_SA(1, 0), a3, voffA);
            PG8_BAR; PG8_WAIT_L(0); PG8_MMA(1, 0, At, B0); PG8_BAR; PG8_SCHED;
            PG8_STAGE(PG8_SB(1, 1), b3 + hstep, voffB);
            PG8_WAIT_V(6); PG8_BAR; PG8_MMA(1, 1, At, B1); PG8_BAR;
            }
        }
        if constexpr (ALIGN_EPI) { if (wr == 0) PG8_BAR; }
        if constexpr (!Epi::AFTER_DRAIN) { E(acc, cur, wr, wc, fr, fq); S.done(cur); }
        if (!has_next) break;
        if (!epi_keep<Epi>(nxt.seg)) {
#pragma unroll
        for (int a = 0; a < 2; ++a)
#pragma unroll
            for (int b = 0; b < 2; ++b)
#pragma unroll
                for (int m = 0; m < 4; ++m)
#pragma unroll
                    for (int n = 0; n < 2; ++n) acc[a][b][m][n] = (f32x4){0.f, 0.f, 0.f, 0.f};
        }
        cur = nxt; cA = nA; cB = nB; ++ui;
        if constexpr (ALIGN_EPI) { if (wr == 1) PG8_BAR; }
    }
    PG8_WAIT_V(0);
    if constexpr (!ALIGN_EPI) { if (wr == 0) PG8_BAR; }
    PG8_BAR;
    if constexpr (Epi::AFTER_DRAIN) { E.fused(acc, cur, wr, wc, fr, fq, lds, wid, lane); S.done(cur); }
#undef PG8_SA
#undef PG8_SB
#undef PG8_STAGE
#undef PG8_LDA
#undef PG8_LDB
#undef PG8_MMA
#undef PG8_WAIT_V
#undef PG8_WAIT_L
#undef PG8_BAR
#undef PG8_SCHED
}
}

#define LAS __attribute__((address_space(3)))
typedef unsigned short bf16;
typedef float f32x4 __attribute__((ext_vector_type(4)));
typedef float f32x16 __attribute__((ext_vector_type(16)));
typedef short bf16x8 __attribute__((ext_vector_type(8)));
typedef short s16x4 __attribute__((ext_vector_type(4)));
typedef unsigned u32x4 __attribute__((ext_vector_type(4)));
typedef unsigned u32x2 __attribute__((ext_vector_type(2)));

constexpr int DM = 1024, NB = 8, SEQ = 8192, DEPTH = 4, MROWS = NB * SEQ, DFF = 2816, INW = 8192, NMOD = 9 * DM;
constexpr int NWAVES = 8, NTHR = 512;
constexpr float NORM_EPS = 1e-6f, LOG2E = 1.4426950408889634f;
constexpr size_t MiB = 1u << 20;
constexpr size_t WS_CTL = 0;
constexpr size_t WS_MOD = 1 * MiB;
constexpr size_t WS_WT = 4 * MiB;
constexpr size_t W_UPA = 0, W_DNA = W_UPA + (size_t)2 * DFF * DM, W_UPB = W_DNA + (size_t)DM * DFF, W_DNB = W_UPB + (size_t)2 * DFF * DM,
                 W_IN = W_DNB + (size_t)DM * DFF, W_RET = W_IN + (size_t)INW * DM, W_DIF = W_RET + (size_t)DM * DM, W_OUT = W_DIF + (size_t)DM * DM, W_END = W_OUT + (size_t)DM * DM;
constexpr size_t WS_H = 64 * MiB;
constexpr size_t ACT = (size_t)MROWS * DM * 2;
constexpr size_t WS_B0 = 192 * MiB;
constexpr size_t WS_HID = WS_B0;
constexpr size_t WS_END = WS_B0 + 6 * ACT;
static_assert(WS_WT + W_END * 2 <= WS_H && WS_END <= 1024 * MiB, "d_ws map");

struct Args { const float* in[18]; float* out; unsigned char* ws; };

__device__ __forceinline__ float shx(float v, int m, int lane) { return __int_as_float(__builtin_amdgcn_ds_bpermute((lane ^ m) << 2, __float_as_int(v))); }
__device__ __forceinline__ float wave_sum(float v, int lane) {
#pragma unroll
    for (int o = 1; o < 64; o <<= 1) v += shx(v, o, lane);
    return v;
}
__device__ __forceinline__ unsigned f2bf(float f) { unsigned u = __float_as_uint(f); return (u + 0x7fffu + ((u >> 16) & 1u)) >> 16; }
__device__ __forceinline__ unsigned pk2(float lo, float hi) { return pg8::cvt_pk_bf16(lo, hi); }
typedef __bf16 bf16x2_cv __attribute__((ext_vector_type(2))); typedef float f32x2_cv __attribute__((ext_vector_type(2)));
__device__ __forceinline__ unsigned pk2v(float lo, float hi) { f32x2_cv v = {lo, hi}; bf16x2_cv b = __builtin_convertvector(v, bf16x2_cv); return __builtin_bit_cast(unsigned, b); }
__device__ __forceinline__ float bflo(unsigned w) { return __uint_as_float(w << 16); }
__device__ __forceinline__ float bfhi(unsigned w) { return __uint_as_float(w & 0xffff0000u); }
__device__ __forceinline__ float sgpr_f(float v) { return __int_as_float(__builtin_amdgcn_readfirstlane(__float_as_int(v))); }
__device__ __forceinline__ int launder(int v) { asm volatile("" : "+v"(v)); return v; }
#define LDS_WAIT() asm volatile("s_waitcnt lgkmcnt(0)" ::: "memory")
#define LDS_BARRIER() do { asm volatile("s_waitcnt lgkmcnt(0)" ::: "memory"); __builtin_amdgcn_s_barrier(); asm volatile("" ::: "memory"); } while (0)
#define MFMA32(a, b, c) __builtin_amdgcn_mfma_f32_32x32x16_bf16((a), (b), (c), 0, 0, 0)
__device__ __forceinline__ int crow(int r, int hi) { return (r & 3) + 8 * (r >> 2) + 4 * hi; }
typedef short v4i16_t __attribute__((ext_vector_type(4)));
__device__ __forceinline__ s16x4 tr_read(const LAS unsigned char* p) { return __builtin_bit_cast(s16x4, __builtin_amdgcn_ds_read_tr16_b64_v4i16((LAS v4i16_t*)p)); }
__device__ __forceinline__ bf16x8 cat8(s16x4 lo, s16x4 hi) { return (bf16x8){lo[0], lo[1], lo[2], lo[3], hi[0], hi[1], hi[2], hi[3]}; }
__device__ __forceinline__ bf16x8 pack8v(const f32x16& x, int s) {
    u32x4 p; p.x = pk2v(x[8 * s], x[8 * s + 1]); p.y = pk2v(x[8 * s + 2], x[8 * s + 3]); p.z = pk2v(x[8 * s + 4], x[8 * s + 5]); p.w = pk2v(x[8 * s + 6], x[8 * s + 7]);
    return __builtin_bit_cast(bf16x8, p);
}
__device__ __forceinline__ bf16x8 pack8(const f32x16& x, int s) {
    u32x4 p; p.x = pk2(x[8 * s], x[8 * s + 1]); p.y = pk2(x[8 * s + 2], x[8 * s + 3]); p.z = pk2(x[8 * s + 4], x[8 * s + 5]); p.w = pk2(x[8 * s + 6], x[8 * s + 7]);
    return __builtin_bit_cast(bf16x8, p);
}

template <bool UPPERM>
__device__ __forceinline__ void transpose_item(const float* W, int K, int N, bf16* WT, LAS float* scr, int item, int lane) {
    const int nblk = N / 32, kb = item / nblk, nb = item % nblk, k0 = 64 * kb, n0 = 32 * nb;
#pragma unroll 8
    for (int i = 0; i < 32; ++i) { const int kk = 2 * i + (lane >> 5); scr[kk * 33 + (lane & 31)] = W[(size_t)(k0 + kk) * N + n0 + (lane & 31)]; }
    LDS_WAIT(); asm volatile("" ::: "memory");
    int d0 = n0;
    if (UPPERM) { const int half = n0 / DFF, j = n0 % DFF; d0 = (j / 128) * 256 + half * 128 + (j % 128); }
    const int c = lane & 7;
#pragma unroll
    for (int j = 0; j < 4; ++j) { const int n = (lane >> 3) + 8 * j; const LAS float* s = scr + (8 * c) * 33 + n;
        u32x4 o; o.x = pk2(s[0 * 33], s[1 * 33]); o.y = pk2(s[2 * 33], s[3 * 33]); o.z = pk2(s[4 * 33], s[5 * 33]); o.w = pk2(s[6 * 33], s[7 * 33]);
        *(u32x4*)(WT + (size_t)(d0 + n) * K + k0 + 8 * c) = o; }
    LDS_WAIT(); asm volatile("" ::: "memory");
}
__device__ __forceinline__ void convert_weights(const Args& a, int l, LAS unsigned char* lds, int gw, int ngw, int wave, int lane) {
    lane = launder(lane);
    LAS float* scr = (LAS float*)(lds + wave * 16384);
    bf16* WT = (bf16*)(a.ws + WS_WT);
    const float* up = a.in[5] + (size_t)l * 2 * DM * 2 * DFF; const float* dn = a.in[6] + (size_t)l * 2 * DFF * DM;
    const float* win = a.in[7] + (size_t)l * DM * INW; const float* wr = a.in[14] + (size_t)l * DM * DM; const float* wd = a.in[15] + (size_t)l * DM * DM; const float* wo = a.in[16] + (size_t)l * DM * DM;
    constexpr int I_UP = (DM / 64) * (2 * DFF / 32), I_DN = (DFF / 64) * (DM / 32), I_IN = (DM / 64) * (INW / 32), I_SQ = (DM / 64) * (DM / 32);
    constexpr int NITEMS = 2 * I_UP + 2 * I_DN + I_IN + 3 * I_SQ;
    for (int it = gw; it < NITEMS; it += ngw) {
        int r = it;
        if (r < I_UP) { transpose_item<true>(up, DM, 2 * DFF, WT + W_UPA, scr, r, lane); continue; } r -= I_UP;
        if (r < I_UP) { transpose_item<true>(up + (size_t)DM * 2 * DFF, DM, 2 * DFF, WT + W_UPB, scr, r, lane); continue; } r -= I_UP;
        if (r < I_DN) { transpose_item<false>(dn, DFF, DM, WT + W_DNA, scr, r, lane); continue; } r -= I_DN;
        if (r < I_DN) { transpose_item<false>(dn + (size_t)DFF * DM, DFF, DM, WT + W_DNB, scr, r, lane); continue; } r -= I_DN;
        if (r < I_IN) { transpose_item<false>(win, DM, INW, WT + W_IN, scr, r, lane); continue; } r -= I_IN;
        if (r < I_SQ) { transpose_item<false>(wr, DM, DM, WT + W_RET, scr, r, lane); continue; } r -= I_SQ;
        if (r < I_SQ) { transpose_item<false>(wd, DM, DM, WT + W_DIF, scr, r, lane); continue; } r -= I_SQ;
        transpose_item<false>(wo, DM, DM, WT + W_OUT, scr, r, lane);
    }
}
__device__ __forceinline__ void ada_phase(const Args& a, LAS unsigned char* lds, int wave, int lane) {
    lane = launder(lane);
    LAS float* sc = (LAS float*)lds; LAS float* part = (LAS float*)(lds + 32768);
    const float* c = a.in[1];
    for (int i = wave * 64 + lane; i < NB * DM; i += NTHR) { const float v = c[i]; sc[i] = v * pg8::sigmoid_f(v); }
    __syncthreads();
    float* mod = (float*)(a.ws + WS_MOD);
    constexpr int NIT = DEPTH * (NMOD / 64);
    for (int it = blockIdx.x; it < NIT; it += gridDim.x) {
        const int l = it / (NMOD / 64), j = (it % (NMOD / 64)) * 64 + lane;
        const float* w = a.in[2] + (size_t)l * DM * NMOD + j;
        float acc[NB];
#pragma unroll
        for (int b = 0; b < NB; ++b) acc[b] = 0.f;
        const int k0 = wave * 128;
#pragma unroll 8
        for (int k = 0; k < 128; ++k) { const float wv = w[(size_t)(k0 + k) * NMOD];
#pragma unroll
            for (int b = 0; b < NB; ++b) acc[b] += sc[b * DM + k0 + k] * wv; }
#pragma unroll
        for (int b = 0; b < NB; ++b) part[(wave * NB + b) * 64 + lane] = acc[b];
        __syncthreads();
        { const int b = wave; float s = a.in[3][(size_t)l * NMOD + j];
#pragma unroll
            for (int w8 = 0; w8 < 8; ++w8) s += part[(w8 * NB + b) * 64 + lane];
            mod[((size_t)l * NB + b) * NMOD + j] = s; }
        __syncthreads();
    }
}
template <int NR>
__device__ __forceinline__ void norm_mod_rows(const float* x, bf16* Hout, const float* const* mbp, const float* nw, const int* rows, int lane) {
    f32x4 v[NR][4]; float ss[NR];
#pragma unroll
    for (int r = 0; r < NR; ++r) { const f32x4* xr = (const f32x4*)(x + (size_t)rows[r] * DM) + lane;
#pragma unroll
        for (int j = 0; j < 4; ++j) v[r][j] = __builtin_nontemporal_load(xr + 64 * j); }
#pragma unroll
    for (int r = 0; r < NR; ++r) { float s = 0.f;
#pragma unroll
        for (int j = 0; j < 4; ++j) s += (v[r][j].x * v[r][j].x + v[r][j].y * v[r][j].y) + (v[r][j].z * v[r][j].z + v[r][j].w * v[r][j].w);
        ss[r] = s; }
#pragma unroll
    for (int o = 1; o < 64; o <<= 1)
#pragma unroll
        for (int r = 0; r < NR; ++r) ss[r] += shx(ss[r], o, lane);
#pragma unroll
    for (int r = 0; r < NR; ++r) { const float rstd = 1.0f / sqrtf(ss[r] * (1.f / DM) + NORM_EPS); const float* shift = mbp[r]; const float* scale = mbp[r] + DM;
        u32x2* o8 = (u32x2*)(Hout + (size_t)rows[r] * DM) + lane;
#pragma unroll
        for (int j = 0; j < 4; ++j) { const int c4 = lane + 64 * j; const f32x4 w = ((const f32x4*)nw)[c4], sc = ((const f32x4*)scale)[c4], sh = ((const f32x4*)shift)[c4];
            const f32x4 o = v[r][j] * rstd * w * (sc + 1.0f) + sh; u32x2 p; p.x = pk2(o.x, o.y); p.y = pk2(o.z, o.w); o8[64 * j] = p; } }
}
__device__ __forceinline__ void norm_phase(const Args& a, const float* x, int l, int sub, int gw, int ngw, int lane) {
    lane = launder(lane);
    bf16* H = (bf16*)(a.ws + WS_H); const float* mod = (const float*)(a.ws + WS_MOD); const float* nw = a.in[4] + ((size_t)l * 3 + sub) * DM;
    constexpr int NR = 4;
    for (int m = gw; m < MROWS; m += NR * ngw) { int rows[NR]; const float* mbp[NR];
#pragma unroll
        for (int r = 0; r < NR; ++r) { rows[r] = m + r * ngw; if (rows[r] >= MROWS) rows[r] = m; mbp[r] = mod + ((size_t)l * NB + (rows[r] >> 13)) * NMOD + sub * 3 * DM; }
        norm_mod_rows<NR>(x, H, mbp, nw, rows, lane); }
}
__device__ __forceinline__ void final_norm_phase(const Args& a, int gw, int ngw, int lane) {
    lane = launder(lane);
    const float* fw = a.in[17];
#ifdef DBG_CHECK
    const float dbgs = 1.0f + (float)((const unsigned*)(a.ws + WS_CTL))[32];
#else
    const float dbgs = 1.0f;
#endif
    for (int m = gw; m < MROWS; m += ngw) { f32x4* xr = (f32x4*)(a.out + (size_t)m * DM) + lane;
        f32x4 v[4]; float s = 0.f;
#pragma unroll
        for (int j = 0; j < 4; ++j) { v[j] = xr[64 * j]; s += (v[j].x * v[j].x + v[j].y * v[j].y) + (v[j].z * v[j].z + v[j].w * v[j].w); }
        const float rstd = 1.0f / sqrtf(wave_sum(s, lane) * (1.f / DM) + NORM_EPS);
#pragma unroll
        for (int j = 0; j < 4; ++j) xr[64 * j] = v[j] * (rstd * dbgs) * ((const f32x4*)fw)[lane + 64 * j]; }
}

constexpr int R_Q = 0, R_K = R_Q + 64 * 272, R_QD = R_K + 64 * 272, R_KD = R_QD + 64 * 272, R_SC = R_KD + 64 * 320, R_V = R_SC + 64 * 144, R_DEC = R_V + 64 * 576, R_END = R_DEC + 256;
static_assert(R_END <= 131072 && 64 * 1040 <= R_DEC, "retention LDS");
__device__ __forceinline__ void retention_unit(const Args& a, int l, int b, int h, LAS unsigned char* lds, const int wave_s, const bool dummy = false) {
    asm volatile("" : "+s"(h));
    const int lane = hw_lane(), wave = wave_s, tid = wave_s * 64 + lane, r32 = lane & 31, hh = lane >> 5;
    const int q4 = (lane & 15) >> 2, p4 = lane & 3, g1 = (lane >> 4) & 1;
    const bf16* RQK = (const bf16*)(a.ws + WS_B0); const bf16* RV = (const bf16*)(a.ws + WS_B0 + ACT); bf16* RG = (bf16*)(a.ws + WS_B0 + 2 * ACT);
    const float* gn = a.in[8] + (size_t)l * DM + h * 256;
    const float lg = sgpr_f(log2f(1.0f - exp2f(-5.0f - (float)h)));
    const float sc_qk = 0.08838834764831845f;
    const float cdec = sgpr_f(exp2f(lg * 64.f));
    const size_t row0 = (size_t)b * SEQ;
    f32x16 S[4];
#pragma unroll
    for (int i = 0; i < 4; ++i) S[i] = f32x16{};
    u32x4 pq[2], pk[2], pv[4]; u32x2 prg[8];
    const int er = tid >> 3, es = tid & 7;
#ifdef USE_RSB
#define RSB() __builtin_amdgcn_sched_barrier(0)
#else
#define RSB() do {} while (0)
#endif
#define R_PREFETCH(ci) do { const size_t t0 = row0 + (size_t)(ci) * 64; \
        _Pragma("unroll") for (int i = 0; i < 2; ++i) { const int idx = tid + 512 * i, rr = idx >> 4, ch = idx & 15; \
            pq[i] = *(const u32x4*)(RQK + (t0 + rr) * DM + h * 128 + ch * 8); pk[i] = *(const u32x4*)(RQK + (t0 + rr) * DM + 512 + h * 128 + ch * 8); } \
        _Pragma("unroll") for (int i = 0; i < 4; ++i) { const int idx = tid + 512 * i, rr = idx >> 5, ch = idx & 31; pv[i] = *(const u32x4*)(RV + (t0 + rr) * DM + h * 256 + ch * 8); } } while (0)
#define R_STORE() do { \
        _Pragma("unroll") for (int i = 0; i < 2; ++i) { const int idx = tid + 512 * i, rr = idx >> 4, ch = idx & 15; \
            *(LAS u32x4*)(lds + R_Q + rr * 272 + ch * 16) = pq[i]; *(LAS u32x4*)(lds + R_K + rr * 272 + ch * 16) = pk[i]; \
            const float fqd = exp2f(lg * (float)rr); u32x4 qd; \
            qd.x = pk2(bflo(pq[i].x) * fqd, bfhi(pq[i].x) * fqd); qd.y = pk2(bflo(pq[i].y) * fqd, bfhi(pq[i].y) * fqd); qd.z = pk2(bflo(pq[i].z) * fqd, bfhi(pq[i].z) * fqd); qd.w = pk2(bflo(pq[i].w) * fqd, bfhi(pq[i].w) * fqd); \
            *(LAS u32x4*)(lds + R_QD + rr * 272 + ch * 16) = qd; \
            const float f = sc_qk * exp2f(lg * (float)(64 - rr)); u32x4 kd; \
            kd.x = pk2(bflo(pk[i].x) * f, bfhi(pk[i].x) * f); kd.y = pk2(bflo(pk[i].y) * f, bfhi(pk[i].y) * f); kd.z = pk2(bflo(pk[i].z) * f, bfhi(pk[i].z) * f); kd.w = pk2(bflo(pk[i].w) * f, bfhi(pk[i].w) * f); \
            *(LAS u32x4*)(lds + R_KD + rr * 320 + ch * 16) = kd; } \
        _Pragma("unroll") for (int i = 0; i < 4; ++i) { const int idx = tid + 512 * i, rr = idx >> 5, ch = idx & 31; *(LAS u32x4*)(lds + R_V + rr * 576 + ch * 16) = pv[i]; } } while (0)
    R_PREFETCH(0);
    if (tid < 64) *(LAS float*)(lds + R_DEC + tid * 4) = sc_qk * exp2f(lg * (float)tid);
    R_STORE();
    LDS_BARRIER();
    for (int ci = 0; ci < SEQ / 64; ++ci) {
        const size_t t0 = row0 + (size_t)ci * 64;
        float lgl = lg;
#ifdef LGL
        asm volatile("" : "+v"(lgl));
#endif
        if (ci + 1 < SEQ / 64) R_PREFETCH(ci + 1);
#ifndef RG_LATE
#pragma unroll
        for (int j = 0; j < 8; ++j) prg[j] = *(const u32x2*)(RG + (t0 + er) * DM + h * 256 + 4 * (es + 8 * j));
#endif
        RSB();
        if (wave < 4) {
            const int qb = wave >> 1, kb = wave & 1; f32x16 x = f32x16{};
#pragma unroll
            for (int ks = 0; ks < 8; ++ks) { const bf16x8 af = *(const LAS bf16x8*)(lds + R_Q + (32 * qb + r32) * 272 + (16 * ks + 8 * hh) * 2);
                const bf16x8 bfr = *(const LAS bf16x8*)(lds + R_K + (32 * kb + r32) * 272 + (16 * ks + 8 * hh) * 2); x = MFMA32(af, bfr, x); }
#pragma unroll
            for (int i = 0; i < 16; ++i) { const int q = 32 * qb + crow(i, hh), k = 32 * kb + r32; const int d = q > k ? q - k : k - q;
                const float v = x[i] * *(const LAS float*)(lds + R_DEC + d * 4); *(LAS unsigned short*)(lds + R_SC + q * 144 + k * 2) = (unsigned short)f2bf(v); }
        }
        RSB();
        f32x16 y[2]; y[0] = f32x16{}; y[1] = f32x16{};
#pragma unroll
        for (int dkb = 0; dkb < 4; ++dkb)
#pragma unroll
            for (int s = 0; s < 2; ++s) { const bf16x8 sp = pack8(S[dkb], s);
#pragma unroll
                for (int qb = 0; qb < 2; ++qb) { const LAS unsigned char* qp = lds + R_QD + (32 * qb + r32) * 272 + (32 * dkb + 16 * s + 4 * hh) * 2;
                    const s16x4 lo = *(const LAS s16x4*)qp, hi = *(const LAS s16x4*)(qp + 16); y[qb] = MFMA32(cat8(lo, hi), sp, y[qb]); } }
        RSB();
        LDS_BARRIER();
        bf16x8 vf[4];
#pragma unroll
        for (int ks = 0; ks < 4; ++ks) { const LAS unsigned char* vp = lds + R_V + (16 * ks + 8 * hh + q4) * 576 + (32 * wave + 16 * g1) * 2 + 8 * p4; vf[ks] = cat8(tr_read(vp), tr_read(vp + 4 * 576)); }
#pragma unroll
        for (int ks = 0; ks < 4; ++ks)
#pragma unroll
            for (int qb = 0; qb < 2; ++qb) { const bf16x8 af = *(const LAS bf16x8*)(lds + R_SC + (32 * qb + r32) * 144 + (16 * ks + 8 * hh) * 2); y[qb] = MFMA32(af, vf[ks], y[qb]); }
        RSB();
#pragma unroll
        for (int dkb = 0; dkb < 4; ++dkb) {
#pragma unroll
            for (int i = 0; i < 16; ++i) S[dkb][i] *= cdec;
#pragma unroll
            for (int ks = 0; ks < 4; ++ks) { const LAS unsigned char* kp = lds + R_KD + (16 * ks + 8 * hh + q4) * 320 + (32 * dkb + 16 * g1) * 2 + 8 * p4;
                S[dkb] = MFMA32(cat8(tr_read(kp), tr_read(kp + 4 * 320)), vf[ks], S[dkb]); } }
        LDS_BARRIER();
#ifdef RG_LATE
#pragma unroll
        for (int j = 0; j < 8; ++j) prg[j] = *(const u32x2*)(RG + (t0 + er) * DM + h * 256 + 4 * (es + 8 * j));
#endif
#pragma unroll
        for (int qb = 0; qb < 2; ++qb)
#pragma unroll
            for (int i = 0; i < 16; ++i) *(LAS float*)(lds + (32 * qb + crow(i, hh)) * 1040 + (32 * wave + r32) * 4) = y[qb][i];
        LDS_BARRIER();
        { f32x4 yv[8]; float ss = 0.f;
#pragma unroll
            for (int j = 0; j < 8; ++j) { yv[j] = *(const LAS f32x4*)(lds + er * 1040 + 16 * (es + 8 * j)); ss += (yv[j].x * yv[j].x + yv[j].y * yv[j].y) + (yv[j].z * yv[j].z + yv[j].w * yv[j].w); }
            ss += shx(ss, 1, lane); ss += shx(ss, 2, lane); ss += shx(ss, 4, lane);
            const float rstd = 1.0f / sqrtf(ss * (1.f / 256.f) + NORM_EPS);
#pragma unroll
            for (int j = 0; j < 8; ++j) { const int c = 4 * (es + 8 * j); const f32x4 w = *(const f32x4*)(gn + c);
                const float g0 = bflo(prg[j].x), g1v = bfhi(prg[j].x), g2 = bflo(prg[j].y), g3 = bfhi(prg[j].y);
                u32x2 o; o.x = pk2(yv[j].x * rstd * w.x * g0 * pg8::sigmoid_f(g0), yv[j].y * rstd * w.y * g1v * pg8::sigmoid_f(g1v));
                o.y = pk2(yv[j].z * rstd * w.z * g2 * pg8::sigmoid_f(g2), yv[j].w * rstd * w.w * g3 * pg8::sigmoid_f(g3));
                if (!dummy || rstd == -12345.f) *(u32x2*)(RG + (t0 + er) * DM + h * 256 + c) = o; } }
        LDS_BARRIER();
        if (ci + 1 < SEQ / 64) R_STORE();
        LDS_BARRIER();
    }
#undef R_PREFETCH
#undef R_STORE
}

constexpr int A_KS = 272, A_VS = 320, A_KB = 64 * A_KS, A_VB = 64 * A_VS, A_BUF = A_KB + A_VB, A_X = 0;
static_assert(2 * A_BUF <= 131072 && 4 * 64 * 64 * 4 <= 131072, "attention LDS");
__device__ __forceinline__ void attn_unit(const Args& a, int l, int b, int h, int qb, float lam, float post, LAS unsigned char* lds, const int wave_s, const bool dummy = false) {
    asm volatile("" : "+s"(h));
    const int lane = hw_lane(), wave = wave_s, tid = wave_s * 64 + lane, r32 = lane & 31, hh = lane >> 5;
    const int q4 = (lane & 15) >> 2, p4 = lane & 3, g1 = (lane >> 4) & 1;
    const int sub = wave >> 2, wq = wave & 3;
    bf16* DQ = (bf16*)(a.ws + WS_B0 + 3 * ACT); const bf16* DK = (const bf16*)(a.ws + WS_B0 + 4 * ACT); const bf16* DV = (const bf16*)(a.ws + WS_B0 + 5 * ACT);
    const size_t row0 = (size_t)b * SEQ; const int q0 = qb * 128;
    const int NT = 2 * qb + 2;
    const float sl2 = sgpr_f(exp2f(-(float)(h + 1)) * LOG2E);
    bf16x8 qf[4];
    { const bf16* qp = DQ + (row0 + q0 + 32 * wq + r32) * DM + h * 128 + sub * 64 + 8 * hh;
#pragma unroll
        for (int ks = 0; ks < 4; ++ks) qf[ks] = *(const bf16x8*)(qp + 16 * ks); }
    u32x4 pk[2], pv[2];
#define A_PREFETCH(t) do { const size_t t0 = row0 + (size_t)(t) * 64; \
        _Pragma("unroll") for (int i = 0; i < 2; ++i) { const int idx = tid + 512 * i, rr = idx >> 4, ch = idx & 15; \
            pk[i] = *(const u32x4*)(DK + (t0 + rr) * DM + h * 128 + ch * 8); pv[i] = *(const u32x4*)(DV + (t0 + rr) * DM + h * 128 + ch * 8); } } while (0)
#define A_STORE(bufo) do { \
        _Pragma("unroll") for (int i = 0; i < 2; ++i) { const int idx = tid + 512 * i, rr = idx >> 4, ch = idx & 15; \
            *(LAS u32x4*)(lds + (bufo) + rr * A_KS + ch * 16) = pk[i]; *(LAS u32x4*)(lds + (bufo) + A_KB + rr * A_VS + ch * 16) = pv[i]; } } while (0)
    f32x16 o[4];
#pragma unroll
    for (int i = 0; i < 4; ++i) o[i] = f32x16{};
    float mrun = -1e30f, lrun = 0.f;
    f32x16 cb;
#pragma unroll
    for (int i = 0; i < 16; ++i) cb[i] = sl2 * (float)((i & 3) + 8 * (i >> 2) + 4 * hh);
    const float c32 = sgpr_f(32.f * sl2);
    const int tq = NT - 2 + (wq >> 1);
    const float qin = (float)(32 * (wq & 1) + r32), qs = sl2 * qin;
    const int tmin = max(0, (int)ceilf((128.f * (float)qb - 63.f - 220.f / sl2) * (1.f / 64.f)));
    A_PREFETCH(NT - 1);
    A_STORE(0);
    LDS_BARRIER();
    for (int it = 0; it < NT - tmin; ++it) {
        const int t = NT - 1 - it, bufo = (it & 1) * A_BUF;
        if (t > tmin) A_PREFETCH(t - 1);
        if (t <= tq) {
            f32x16 s[2];
            s[0] = cb;
#pragma unroll
            for (int i = 0; i < 16; ++i) s[1][i] = cb[i] + c32;
#pragma unroll
            for (int kb = 0; kb < 2; ++kb)
#pragma unroll
                for (int ks = 0; ks < 4; ++ks) { const bf16x8 kf = *(const LAS bf16x8*)(lds + bufo + (32 * kb + r32) * A_KS + (sub * 64 + 16 * ks + 8 * hh) * 2); s[kb] = MFMA32(kf, qf[ks], s[kb]); }
            float ut = -sl2 * (qin + 64.f * (float)(tq - t));
            if (t == tq) {
                ut = 0.f;
#pragma unroll
                for (int i = 0; i < 16; ++i) { const float c0 = cb[i], c1 = cb[i] + c32; s[0][i] = s[0][i] - c0 - fabsf(qs - c0); s[1][i] = s[1][i] - c1 - fabsf(qs - c1); }
            }
            float mt = fmaxf(s[0][0], s[1][0]);
#pragma unroll
            for (int i = 1; i < 16; ++i) mt = fmaxf(fmaxf(mt, s[0][i]), s[1][i]);
            mt = fmaxf(mt, shx(mt, 32, lane)) + ut;
            if (__any(mt > mrun)) {
                const float mnew = fmaxf(mrun, mt), alpha = __builtin_amdgcn_exp2f(mrun - mnew); mrun = mnew; lrun *= alpha;
#pragma unroll
                for (int d4 = 0; d4 < 4; ++d4)
#pragma unroll
                    for (int i = 0; i < 16; ++i) o[d4][i] *= alpha;
            }
            const float ml = mrun - ut;
            float ps = 0.f;
#pragma unroll
            for (int kb = 0; kb < 2; ++kb)
#pragma unroll
                for (int i = 0; i < 16; ++i) { s[kb][i] = __builtin_amdgcn_exp2f(s[kb][i] - ml); ps += s[kb][i]; }
            lrun += ps;
            __builtin_amdgcn_sched_barrier(0);
            {
                const LAS unsigned char* vbase = lds + bufo + A_KB + (4 * hh + q4) * A_VS + (16 * g1) * 2 + 8 * p4;
                bf16x8 vcur[4], vnxt[4];
#pragma unroll
                for (int d4 = 0; d4 < 4; ++d4) vcur[d4] = cat8(tr_read(vbase + 64 * d4), tr_read(vbase + 64 * d4 + 8 * A_VS));
#pragma unroll
                for (int g = 0; g < 4; ++g) {
                    if (g < 3) {
#pragma unroll
                        for (int d4 = 0; d4 < 4; ++d4) vnxt[d4] = cat8(tr_read(vbase + (g + 1) * 16 * A_VS + 64 * d4), tr_read(vbase + (g + 1) * 16 * A_VS + 64 * d4 + 8 * A_VS)); }
                    const bf16x8 pf = pack8v(s[g >> 1], g & 1);
#pragma unroll
                    for (int d4 = 0; d4 < 4; ++d4) o[d4] = MFMA32(vcur[d4], pf, o[d4]);
                    __builtin_amdgcn_sched_barrier(0);
#pragma unroll
                    for (int d4 = 0; d4 < 4; ++d4) vcur[d4] = vnxt[d4];
                }
            }
        }
        if (t > tmin) A_STORE(((it + 1) & 1) * A_BUF);
        LDS_BARRIER();
    }
    lrun += shx(lrun, 32, lane);
    const float rl = 1.0f / lrun;
    if (sub == 1) {
#pragma unroll
        for (int d4 = 0; d4 < 4; ++d4)
#pragma unroll
            for (int i = 0; i < 16; ++i) *(LAS float*)(lds + A_X + ((wq * 64 + d4 * 16 + i) * 64 + lane) * 4) = o[d4][i] * rl;
    }
    __syncthreads();
    if (sub == 0) {
        float ss = 0.f;
#pragma unroll
        for (int d4 = 0; d4 < 4; ++d4)
#pragma unroll
            for (int i = 0; i < 16; ++i) { const float v = o[d4][i] * rl - lam * *(const LAS float*)(lds + A_X + ((wq * 64 + d4 * 16 + i) * 64 + lane) * 4); o[d4][i] = v; ss += v * v; }
        ss += shx(ss, 32, lane);
        const float rstd = post / sqrtf(ss * (1.f / 128.f) + NORM_EPS);
        const float* sw = a.in[13] + (size_t)l * 128;
        bf16* op = DQ + (row0 + q0 + 32 * wq + r32) * DM + h * 128;
#pragma unroll
        for (int d4 = 0; d4 < 4; ++d4)
#pragma unroll
            for (int g = 0; g < 4; ++g) { const int dv = 32 * d4 + 8 * g + 4 * hh; const f32x4 w = *(const f32x4*)(sw + dv);
                u32x2 pkd; pkd.x = pk2(o[d4][4 * g] * rstd * w.x, o[d4][4 * g + 1] * rstd * w.y); pkd.y = pk2(o[d4][4 * g + 2] * rstd * w.z, o[d4][4 * g + 3] * rstd * w.w);
                if (!dummy || rstd == -12345.f) *(u32x2*)(op + dv) = pkd; }
    }
    __syncthreads();
#undef A_PREFETCH
#undef A_STORE
}


#define XB_TMO      128
#define XB_XCNT(j)  (256  + 64 * (j))
#define XB_XSUB(j)  (1280 + 64 * (j))
#define XB_XGEN(j)  (2304 + 64 * (j))
#define XB_TOP      3328
#define XB_TOPGEN   3392
#define XCD_BAR_WORDS 3456
#define XB_SPIN_CAP (1u << 24)

__device__ __forceinline__ unsigned xb_ld(unsigned* p)              { return __hip_atomic_load(p, __ATOMIC_RELAXED, __HIP_MEMORY_SCOPE_AGENT); }
__device__ __forceinline__ unsigned xb_add(unsigned* p, unsigned v) { return __hip_atomic_fetch_add(p, v, __ATOMIC_RELAXED, __HIP_MEMORY_SCOPE_AGENT); }
__device__ __forceinline__ unsigned xb_xcc_id() { return (unsigned)__builtin_amdgcn_s_getreg((3 << 11) | 20) & 0xFu; }
#define XB_SPIN(cond, bar) do { unsigned _sp = 0; while (cond) { __builtin_amdgcn_s_sleep(1); \
    if ((++_sp & 255u) == 0u) { if (xb_ld(&(bar)[XB_TMO])) break; if (_sp > XB_SPIN_CAP) { atomicAdd(&(bar)[XB_TMO], 1u); break; } } } } while (0)

struct XcdBarrier {
    unsigned* bar; unsigned x;
    volatile LAS unsigned* st;
};

__device__ __forceinline__ XcdBarrier xcd_barrier_post(unsigned* bar, volatile LAS unsigned* st, bool first) {
    XcdBarrier b; b.bar = bar; b.x = xb_xcc_id(); b.st = st;
    if (first) (void)xb_add(&bar[XB_XCNT(b.x)], 1u);
    return b;
}
__device__ __forceinline__ void xcd_barrier_complete(unsigned* bar, unsigned x, unsigned& nloc, unsigned& nx) {
    const unsigned G = gridDim.x * gridDim.y * gridDim.z;
    unsigned sum, cnt, mine, sp = 0u;
    for (;;) {
        sum = 0u; cnt = 0u; mine = 0u;
#pragma unroll
        for (unsigned j = 0; j < 16; ++j) { const unsigned c = xb_ld(&bar[XB_XCNT(j)]); sum += c; cnt += (c > 0u) ? 1u : 0u; mine = (j == x) ? c : mine; }
        if (sum == G) break;
        __builtin_amdgcn_s_sleep(1);
        if ((++sp & 255u) == 0u) { if (xb_ld(&bar[XB_TMO])) break; if (sp > XB_SPIN_CAP) { atomicAdd(&bar[XB_TMO], 1u); break; } }
    }
    nloc = mine > 0u ? mine : 1u; nx = cnt > 0u ? cnt : 1u;
}

__device__ __forceinline__ void xcd_barrier(const XcdBarrier& b, const bool first) {
    asm volatile("s_waitcnt vmcnt(0)" ::: "memory");
    __syncthreads();
    if (first) {
        unsigned* bar = b.bar;
        __builtin_amdgcn_s_waitcnt(0);
        unsigned nloc = b.st[0], nx = b.st[1];
        if (nloc == 0u) { xcd_barrier_complete(bar, b.x, nloc, nx); b.st[0] = nloc; b.st[1] = nx; }
        const unsigned old = xb_add(&bar[XB_XSUB(b.x)], 1u);
        const unsigned gen = old / nloc;
        if (old + 1u == (gen + 1u) * nloc) {
            __builtin_amdgcn_fence(__ATOMIC_RELEASE, "agent");
            asm volatile("s_waitcnt vmcnt(0)" ::: "memory");
            const unsigned og = xb_add(&bar[XB_TOP], 1u);
            const unsigned tg = og / nx;
            if (og + 1u == (tg + 1u) * nx) xb_add(&bar[XB_TOPGEN], 1u);
            else XB_SPIN(xb_ld(&bar[XB_TOPGEN]) == tg, bar);
            __builtin_amdgcn_fence(__ATOMIC_ACQUIRE, "agent");
            xb_add(&bar[XB_XGEN(b.x)], 1u);
            asm volatile("s_waitcnt vmcnt(0)" ::: "memory");
        } else {
            XB_SPIN(xb_ld(&bar[XB_XGEN(b.x)]) == gen, bar);
            __builtin_amdgcn_fence(__ATOMIC_ACQUIRE, "agent");
            asm volatile("s_waitcnt vmcnt(0)" ::: "memory");
        }
    }
    __syncthreads();
}

#define CG_SYNC() do { asm volatile("s_waitcnt vmcnt(0) lgkmcnt(0)" ::: "memory"); __syncthreads(); grid.sync(); \
    __builtin_amdgcn_fence(__ATOMIC_ACQUIRE, "agent"); asm volatile("s_waitcnt vmcnt(0)" ::: "memory"); __syncthreads(); } while (0)
#define IS_T0 (wave_s == 0 && hw_lane() == 0)
#define GRID_SYNC() xcd_barrier(xbar, IS_T0)
constexpr int CW_BAR = 4096;
typedef const __attribute__((address_space(4))) Args* KArgsPtr;
#define PHASE_BEGIN Args a; { KArgsPtr ka_ = (KArgsPtr)__builtin_amdgcn_kernarg_segment_ptr(); asm volatile("" : "+s"(ka_)); _Pragma("unroll") for (int i_ = 0; i_ < 18; ++i_) a.in[i_] = ka_->in[i_]; a.out = ka_->out; a.ws = ka_->ws; } \
    const int lane = hw_lane(), wave = wave_s, tid = wave_s * 64 + lane; const int G = gridDim.x, gw = blockIdx.x * NWAVES + wave, ngw = G * NWAVES; \
    unsigned* ctl = (unsigned*)(a.ws + WS_CTL); const float* mod = (const float*)(a.ws + WS_MOD); bf16* WT = (bf16*)(a.ws + WS_WT); bf16* H = (bf16*)(a.ws + WS_H); bf16* HID = (bf16*)(a.ws + WS_HID); bf16* B0 = (bf16*)(a.ws + WS_B0); \
    (void)tid; (void)lane; (void)wave; (void)G; (void)gw; (void)ngw; (void)ctl; (void)mod; (void)WT; (void)H; (void)HID; (void)B0;
#define GEMM_RUN(EPI, ...) do { pg8::StaticOrder S; S.init(MROWS, g.N, G, (int)blockIdx.x); EPI E{__VA_ARGS__}; pg8::gemm_phase<EPI, pg8::StaticOrder, true, true>(lds, g, S, E, wave_s); } while (0)

__global__ void __launch_bounds__(NTHR, 2) hybrid_fwd(Args args_unused) {
    extern __shared__ __attribute__((aligned(16))) unsigned char lds_raw[];
    LAS unsigned char* lds = (LAS unsigned char*)lds_raw;
    cg::grid_group grid = cg::this_grid();
    const int wave_s = __builtin_amdgcn_readfirstlane((int)threadIdx.x >> 6);
    LAS unsigned* qslot = (LAS unsigned*)(lds + 131072);

    {
        PHASE_BEGIN
        if (blockIdx.x == 0) { if (tid < 64) ctl[tid] = 0u; for (int i = tid; i < XCD_BAR_WORDS; i += NTHR) ctl[CW_BAR + i] = 0u; }
        ada_phase(a, lds, wave, lane);
        convert_weights(a, 0, lds, gw, ngw, wave, lane);
    }
    CG_SYNC();
    XcdBarrier xbar;
    {   PHASE_BEGIN
        volatile LAS unsigned* st = (volatile LAS unsigned*)(lds + 131072 + 16);
        if (tid < 2) st[tid] = 0u;
        __syncthreads();
        xbar = xcd_barrier_post(ctl + CW_BAR, st, tid == 0);
    }

    for (int l = 0; l < DEPTH; ++l) {
        {
            PHASE_BEGIN
            if (l > 0) convert_weights(a, l, lds, gw, ngw, wave, lane);
            norm_phase(a, (l == 0) ? a.in[0] : a.out, l, 0, gw, ngw, lane);
        }
        GRID_SYNC();
        { PHASE_BEGIN pg8::Gemm g{H, WT + W_UPA, MROWS, 2 * DFF, DM}; GEMM_RUN(pg8::EpiSwiGLU, HID, DFF); }
        GRID_SYNC();
        { PHASE_BEGIN pg8::Gemm g{HID, WT + W_DNA, MROWS, DM, DFF}; GEMM_RUN(pg8::EpiResid, (l == 0) ? a.in[0] : a.out, a.out, mod + (size_t)l * NB * NMOD + 0 * 3 * DM + 2 * DM, NMOD, 0.5f, DM); }
        GRID_SYNC();
        { PHASE_BEGIN norm_phase(a, a.out, l, 1, gw, ngw, lane); }
        GRID_SYNC();
        { PHASE_BEGIN pg8::Gemm g{H, WT + W_IN, MROWS, 6 * DM, DM}; GEMM_RUN(pg8::EpiBf<0>, B0, DM, DM, (size_t)MROWS * DM, 3, 0.125f * LOG2E, nullptr); }
        GRID_SYNC();
        {
            PHASE_BEGIN
            if (blockIdx.x < 32) retention_unit(a, l, blockIdx.x >> 2, blockIdx.x & 3, lds, wave_s);
            const float s1 = wave_sum(a.in[9][l * 64 + lane] * a.in[10][l * 64 + lane], lane), s2 = wave_sum(a.in[11][l * 64 + lane] * a.in[12][l * 64 + lane], lane);
            const float lam_init = sgpr_f(0.8f - 0.6f * expf(-0.3f * (float)l)), lam = sgpr_f(expf(s1) - expf(s2) + lam_init);
            const int q0 = (int)(xb_xcc_id() & 7u);
            for (int k = 0; k < NB; ++k) {
                const int bq = (q0 + k) & 7;
                for (;;) {
                    if (tid == 0) *qslot = atomicAdd(ctl + l * NB + bq, 1u);
                    __syncthreads();
                    const unsigned item = *qslot;
                    __syncthreads();
                    if (item >= 8u * 64u) break;
                    attn_unit(a, l, bq, 7 - (int)(item >> 6), 63 - (int)(item & 63u), lam, 1.0f - lam_init, lds, wave_s);
                }
            }
        }
        GRID_SYNC();
        {
            PHASE_BEGIN pg8::Gemm g{H, WT + W_IN + (size_t)6 * DM * DM, MROWS, DM, DM, H, WT + W_IN + (size_t)7 * DM * DM, B0 + (size_t)2 * MROWS * DM, WT + W_RET, B0 + (size_t)3 * MROWS * DM, WT + W_DIF};
            pg8::SegOrderN<2> S; S.init(MROWS, g.N, G, (int)blockIdx.x); pg8::EpiMerge E{B0 + (size_t)1 * MROWS * DM, DM, B0, B0 + (size_t)4 * MROWS * DM};
            pg8::gemm_phase<pg8::EpiMerge, pg8::SegOrderN<2>, true, true>(lds, g, S, E, wave_s); }
        GRID_SYNC();
        { PHASE_BEGIN pg8::Gemm g{B0 + (size_t)1 * MROWS * DM, WT + W_OUT, MROWS, DM, DM}; GEMM_RUN(pg8::EpiResid, a.out, a.out, mod + (size_t)l * NB * NMOD + 1 * 3 * DM + 2 * DM, NMOD, 1.0f, DM); }
        GRID_SYNC();
        { PHASE_BEGIN norm_phase(a, a.out, l, 2, gw, ngw, lane); }
        GRID_SYNC();
        { PHASE_BEGIN pg8::Gemm g{H, WT + W_UPB, MROWS, 2 * DFF, DM}; GEMM_RUN(pg8::EpiSwiGLU, HID, DFF); }
        GRID_SYNC();
        { PHASE_BEGIN pg8::Gemm g{HID, WT + W_DNB, MROWS, DM, DFF}; GEMM_RUN(pg8::EpiResid, a.out, a.out, mod + (size_t)l * NB * NMOD + 2 * 3 * DM + 2 * DM, NMOD, 0.5f, DM); }
        GRID_SYNC();
    }
    { PHASE_BEGIN final_norm_phase(a, gw, ngw, lane); }
}

constexpr int LDS_BYTES = 147456;
extern "C" void kernel_launch(void* const* d_in, const int* in_sizes, int n_in, void* d_out, int out_size, void* d_ws, size_t ws_size, hipStream_t stream) {
    static int grid = 0;
    if (grid == 0) {
        if (n_in != 18 || ws_size < WS_END) { fprintf(stderr, "kernel_launch: unexpected n_in %d / ws_size %zu (need %zu)\n", n_in, ws_size, (size_t)WS_END); grid = -1; return; }
        int dev = 0, cus = 0, per_cu = 0;
        (void)hipGetDevice(&dev); (void)hipDeviceGetAttribute(&cus, hipDeviceAttributeMultiprocessorCount, dev);
        if (hipFuncSetAttribute((const void*)hybrid_fwd, hipFuncAttributeMaxDynamicSharedMemorySize, LDS_BYTES) != hipSuccess) { fprintf(stderr, "kernel_launch: hipFuncSetAttribute failed\n"); grid = -1; return; }
        if (hipOccupancyMaxActiveBlocksPerMultiprocessor(&per_cu, (const void*)hybrid_fwd, NTHR, LDS_BYTES) != hipSuccess || per_cu < 1) { fprintf(stderr, "kernel_launch: occupancy query says %d\n", per_cu); per_cu = 1; }
        (void)hipGetLastError();
        grid = cus * 1;
    }
    if (grid < 0) return;
    Args a{};
    for (int i = 0; i < 18; ++i) a.in[i] = (const float*)d_in[i];
    a.out = (float*)d_out; a.ws = (unsigned char*)d_ws;
    void* kargs[] = {&a};
    hipError_t e = hipLaunchCooperativeKernel((const void*)hybrid_fwd, dim3(grid), dim3(NTHR), kargs, LDS_BYTES, stream);
    if (e != hipSuccess) fprintf(stderr, "cooperative launch failed: %s (grid %d)\n", hipGetErrorString(e), grid);
}
```

```cpp
#define GATE_LOGITS 1
#include <hip/hip_runtime.h>
#include <hip/hip_cooperative_groups.h>
#include <cstdio>
#include <cstdint>
namespace cg = cooperative_groups;
#define USE_RSB 1
__device__ __forceinline__ int hw_lane() { int l = (int)__builtin_amdgcn_mbcnt_hi(~0u, __builtin_amdgcn_mbcnt_lo(~0u, 0u)); asm volatile("" : "+v"(l)); return l; }
namespace pg8 {
#define PG8_LAS __attribute__((address_space(3)))
typedef unsigned short bf16_t;
typedef short bf16x8 __attribute__((ext_vector_type(8)));
typedef float f32x4 __attribute__((ext_vector_type(4)));
typedef unsigned u32x4 __attribute__((ext_vector_type(4)));
constexpr int BM = 256, BK = 64, HALF = 128, HTB = HALF * BK * 2  , STAGE_BYTES = 8 * HTB, NXCD = 8, WGM = 8;

__host__ __device__ __forceinline__ int lds_byte(int r, int c) { const int st = (r >> 4) * 2 + (c >> 5), rr = r & 15, cc = c & 31, ob = rr * 64 + cc * 2; return st * 1024 + (ob ^ (((ob >> 9) & 1) << 5)); }
__host__ __device__ __forceinline__ void stage_rc(int b, int& R, int& C) { const int st = b / 1024, sb = b % 1024, swz = sb ^ (((sb >> 9) & 1) << 5); R = (st >> 1) * 16 + swz / 64; C = (st & 1) * 32 + (swz % 64) / 2; }
__host__ __device__ __forceinline__ int perm32(int rho) { const int n = rho >> 4, i = rho & 15; return 8 * (i >> 2) + 4 * n + (i & 3); }

struct Unit { int pm, pn, seg; };
struct Gemm { const bf16_t* A; const bf16_t* Bt; int M, N, K; const bf16_t* A2; const bf16_t* Bt2; const bf16_t* A3; const bf16_t* Bt3; const bf16_t* A4; const bf16_t* Bt4; };
__host__ __device__ __forceinline__ const bf16_t* seg_a(const Gemm& g, int sg) { return sg == 0 ? g.A : sg == 1 ? g.A2 : sg == 2 ? g.A3 : g.A4; }
__host__ __device__ __forceinline__ const bf16_t* seg_b(const Gemm& g, int sg) { return sg == 0 ? g.Bt : sg == 1 ? g.Bt2 : sg == 2 ? g.Bt3 : g.Bt4; }

struct StaticOrder {
    int nM, nN, nwg, G, c;
    __host__ __device__ void init(int M, int N, int G_, int c_) { nM = M / BM; nN = N / BM; nwg = nM * nN; G = G_; c = c_; }
    __host__ __device__ bool next(int i, Unit& u) const {
        const long L = (long)i * G + c; if (L >= nwg) return false;
        int wgid = (int)L; { const int q = nwg / NXCD, r = nwg % NXCD, xcd = wgid % NXCD, off = wgid / NXCD; wgid = (xcd < r ? xcd * (q + 1) : r * (q + 1) + (xcd - r) * q) + off; }
        const int nig = WGM * nN, gid = wgid / nig, fm = gid * WGM, gsz = (nM - fm) < WGM ? (nM - fm) : WGM;
        u.pm = fm + ((wgid % nig) % gsz); u.pn = (wgid % nig) / gsz; u.seg = 0; return true;
    }
    __device__ __forceinline__ void a_ready(const Unit&) const {}
    __device__ __forceinline__ void done(const Unit&) const {}
};
template <int LOG2SEG> struct SegOrderN {
    StaticOrder base;
    __host__ __device__ void init(int M, int N, int G_, int c_) { base.init(M, N, G_, c_); }
    __host__ __device__ bool next(int i, Unit& u) const { const bool ok = base.next(i >> LOG2SEG, u); u.seg = i & ((1 << LOG2SEG) - 1); return ok; }
    __device__ __forceinline__ void a_ready(const Unit&) const {}
    __device__ __forceinline__ void done(const Unit&) const {}
};
template <class E, class = void> struct epi_seg { static constexpr bool value = false; };
template <class E> struct epi_seg<E, decltype((void)E::SEG)> { static constexpr bool value = E::SEG; };
template <class E> __host__ __device__ __forceinline__ bool epi_keep(int sg) { if constexpr (epi_seg<E>::value) return E::keep_acc(sg); else return false; }


__device__ __forceinline__ unsigned cvt_pk_bf16(float lo, float hi) { unsigned r; asm volatile("v_cvt_pk_bf16_f32 %0, %1, %2" : "=v"(r) : "v"(lo), "v"(hi)); return r; }
typedef float f32x2 __attribute__((ext_vector_type(2)));

__device__ __forceinline__ float sigmoid_f(float v) { return __builtin_amdgcn_rcpf(1.0f + __builtin_amdgcn_exp2f(-1.4426950408889634f * v)); }
__device__ __forceinline__ float bf_lo(unsigned w) { return __uint_as_float(w << 16); }
__device__ __forceinline__ float bf_hi(unsigned w) { return __uint_as_float(w & 0xffff0000u); }

struct EpiSwiGLU {
    static constexpr bool PERM = true, AFTER_DRAIN = false;
    bf16_t* O; int ldc;
    __device__ __forceinline__ void operator()(const f32x4 (&acc)[2][2][4][2], const Unit& u, int wr, int wc, int fr, int fq) const {
        const int row0 = u.pm * BM + wr * 64 + fr, col0 = u.pn * HALF + wc * 32 + 8 * fq;
#pragma unroll
        for (int ai = 0; ai < 2; ++ai)
#pragma unroll
            for (int m = 0; m < 4; ++m) {
                bf16_t* rowp = O + (size_t)(row0 + ai * HALF + m * 16) * ldc + col0;
                float v[8];
#pragma unroll
                for (int n = 0; n < 2; ++n)
#pragma unroll
                    for (int e = 0; e < 4; ++e) { const float a = acc[ai][0][m][n][e], b = acc[ai][1][m][n][e]; v[4 * n + e] = a * sigmoid_f(a) * b; }
                u32x4 w; w.x = cvt_pk_bf16(v[0], v[1]); w.y = cvt_pk_bf16(v[2], v[3]); w.z = cvt_pk_bf16(v[4], v[5]); w.w = cvt_pk_bf16(v[6], v[7]);
                *(u32x4*)rowp = w;
            }
    }
};
struct EpiResid {
    static constexpr bool PERM = false, AFTER_DRAIN = false;
    const float* base; float* out; const float* gate; int gate_bstride; float coef; int ldc;
    __device__ __forceinline__ void operator()(const f32x4 (&acc)[2][2][4][2], const Unit& u, int wr, int wc, int fr, int fq) const {
        const int col0 = u.pn * BM + wc * 32 + 4 * fq;
        const float* g = gate + (size_t)(u.pm >> 5) * gate_bstride;
        f32x4 gv[2][2];
#pragma unroll
        for (int bj = 0; bj < 2; ++bj)
#pragma unroll
            for (int n = 0; n < 2; ++n) gv[bj][n] = *(const f32x4*)(g + col0 + bj * HALF + n * 16) * coef;
#pragma unroll
        for (int ai = 0; ai < 2; ++ai)
#pragma unroll
            for (int m = 0; m < 4; ++m) { const size_t off = (size_t)(u.pm * BM + ai * HALF + wr * 64 + m * 16 + fr) * ldc + col0;
#pragma unroll
                for (int bj = 0; bj < 2; ++bj)
#pragma unroll
                    for (int n = 0; n < 2; ++n) { const f32x4 bs = *(const f32x4*)(base + off + bj * HALF + n * 16); *(f32x4*)(out + off + bj * HALF + n * 16) = bs + gv[bj][n] * acc[ai][bj][m][n]; } }
    }
};
#ifdef GATE_LOGITS
#define GSIG(x) sigmoid_f(x)
#else
#define GSIG(x) (x)
#endif
template <int MODE> struct EpiBf {
    static constexpr bool PERM = true, AFTER_DRAIN = false;
    bf16_t* O; int ldc; int split_cols; size_t split_stride; int qt; float qscale; const bf16_t* G;
    __device__ __forceinline__ void operator()(const f32x4 (&acc)[2][2][4][2], const Unit& u, int wr, int wc, int fr, int fq) const {
        const int row0 = u.pm * BM + wr * 64 + fr; int colt = u.pn * BM; bf16_t* base = O; float sc = 1.f;
        if (MODE <= 1) { const int t = colt / split_cols; base += (size_t)t * split_stride; colt -= t * split_cols; if (MODE == 0 && t == qt) sc = qscale; }
        const int col0 = colt + wc * 32 + 8 * fq;
#pragma unroll
        for (int ai = 0; ai < 2; ++ai)
#pragma unroll
            for (int m = 0; m < 4; ++m) { const size_t roff = (size_t)(row0 + ai * HALF + m * 16) * ldc + col0;
#pragma unroll
                for (int bj = 0; bj < 2; ++bj) {
                    f32x4 v0 = acc[ai][bj][m][0], v1 = acc[ai][bj][m][1];
                    if (MODE == 0) { v0 = v0 * sc; v1 = v1 * sc; }
                    if (MODE == 1) {
#pragma unroll
                        for (int e = 0; e < 4; ++e) { v0[e] = sigmoid_f(v0[e]); v1[e] = sigmoid_f(v1[e]); } }
                    if (MODE >= 2) { const u32x4 g = *(const u32x4*)(G + roff + bj * HALF);
                        v0[0] *= GSIG(bf_lo(g.x)); v0[1] *= GSIG(bf_hi(g.x)); v0[2] *= GSIG(bf_lo(g.y)); v0[3] *= GSIG(bf_hi(g.y)); v1[0] *= GSIG(bf_lo(g.z)); v1[1] *= GSIG(bf_hi(g.z)); v1[2] *= GSIG(bf_lo(g.w)); v1[3] *= GSIG(bf_hi(g.w)); }
                    if (MODE == 3) { const u32x4 t = *(const u32x4*)(base + roff + bj * HALF);
                        v0[0] += bf_lo(t.x); v0[1] += bf_hi(t.x); v0[2] += bf_lo(t.y); v0[3] += bf_hi(t.y); v1[0] += bf_lo(t.z); v1[1] += bf_hi(t.z); v1[2] += bf_lo(t.w); v1[3] += bf_hi(t.w); }
                    u32x4 w; w.x = cvt_pk_bf16(v0[0], v0[1]); w.y = cvt_pk_bf16(v0[2], v0[3]); w.z = cvt_pk_bf16(v1[0], v1[1]); w.w = cvt_pk_bf16(v1[2], v1[3]);
                    *(u32x4*)(base + roff + bj * HALF) = w; } }
    }
};
struct EpiMerge {
    static constexpr bool PERM = true, AFTER_DRAIN = false, SEG = true;
    __host__ __device__ static constexpr bool keep_acc(int sg) { return sg == 3; }
    bf16_t* O; int ldc; bf16_t* GR; bf16_t* GD;
    __device__ __forceinline__ void operator()(f32x4 (&acc)[2][2][4][2], const Unit& u, int wr, int wc, int fr, int fq) const {
        const int row0 = u.pm * BM + wr * 64 + fr, col0 = u.pn * BM + wc * 32 + 8 * fq;
#pragma unroll
        for (int ai = 0; ai < 2; ++ai)
#pragma unroll
            for (int m = 0; m < 4; ++m) { const size_t roff = (size_t)(row0 + ai * HALF + m * 16) * ldc + col0;
#pragma unroll
                for (int bj = 0; bj < 2; ++bj) {
                    if (u.seg < 2) {
                        float v[8];
#pragma unroll
                        for (int e = 0; e < 8; ++e) v[e] = __builtin_fmaxf(acc[ai][bj][m][e >> 2][e & 3], -3.0e38f);
                        u32x4 w; w.x = cvt_pk_bf16(v[0], v[1]); w.y = cvt_pk_bf16(v[2], v[3]); w.z = cvt_pk_bf16(v[4], v[5]); w.w = cvt_pk_bf16(v[6], v[7]);
                        *(u32x4*)((u.seg == 0 ? GR : GD) + roff + bj * HALF) = w;
                    } else {
                        const u32x4 gd = *(const u32x4*)(GD + roff + bj * HALF);
                        const float d[8] = {bf_lo(gd.x), bf_hi(gd.x), bf_lo(gd.y), bf_hi(gd.y), bf_lo(gd.z), bf_hi(gd.z), bf_lo(gd.w), bf_hi(gd.w)};
                        if (u.seg == 2) {
                            const u32x4 gr = *(const u32x4*)(GR + roff + bj * HALF);
                            const float r[8] = {bf_lo(gr.x), bf_hi(gr.x), bf_lo(gr.y), bf_hi(gr.y), bf_lo(gr.z), bf_hi(gr.z), bf_lo(gr.w), bf_hi(gr.w)};
#pragma unroll
                            for (int e = 0; e < 8; ++e) { const float ed = __builtin_amdgcn_exp2f(-1.4426950408889634f * d[e]), er = __builtin_amdgcn_exp2f(-1.4426950408889634f * r[e]);
                                acc[ai][bj][m][e >> 2][e & 3] *= (1.0f + ed) * __builtin_amdgcn_rcpf(1.0f + er); }
                        } else {
                            float v[8];
#pragma unroll
                            for (int e = 0; e < 8; ++e) v[e] = acc[ai][bj][m][e >> 2][e & 3] * sigmoid_f(d[e]);
                            u32x4 w; w.x = cvt_pk_bf16(v[0], v[1]); w.y = cvt_pk_bf16(v[2], v[3]); w.z = cvt_pk_bf16(v[4], v[5]); w.w = cvt_pk_bf16(v[6], v[7]);
                            *(u32x4*)(O + roff + bj * HALF) = w; }
                    }
                } }
    }
};


template <class Epi, class Sched, bool ALIGN_EPI = false, bool SP2 = false>
__device__ __forceinline__ void gemm_phase(PG8_LAS unsigned char* lds, const Gemm g, const Sched& S, const Epi& E, const int wave_s) {
    const int lane = hw_lane(), wid = wave_s, tid = wave_s * 64 + lane, wr = wid >> 2, wc = wid & 3, fr = lane & 15, fq = lane >> 4;
    const int K = g.K, nt = K / BK;
    unsigned voffA[2], voffB[2];
#pragma unroll
    for (int i = 0; i < 2; ++i) { int R, C; stage_rc(tid * 16 + i * 8192, R, C); const int Rb = Epi::PERM ? ((R & ~31) + perm32(R & 31)) : R;
        voffA[i] = (unsigned)(R * K + C) * 2u; voffB[i] = (unsigned)(Rb * K + C) * 2u; }
    const size_t kstep = (size_t)(BK * 2);
    const size_t hstep = (size_t)HALF * K * 2;
    const size_t tstep = 2 * hstep;
    const unsigned ldsw = (unsigned)wid * 1024u;
    const int aoff = lds_byte(wr * 64 + fr, fq * 8), boff = lds_byte(wc * 32 + fr, fq * 8);
#define PG8_SA(b, h) (((b) * 2 + (h)) * HTB)
#define PG8_SB(b, h) ((4 + (b) * 2 + (h)) * HTB)
#define PG8_STAGE(bufoff, gbase, voff) do { _Pragma("unroll") for (int _i = 0; _i < 2; ++_i) \
        __builtin_amdgcn_global_load_lds((const unsigned*)((const char*)(gbase) + (voff)[_i]), (PG8_LAS unsigned*)(lds + (bufoff) + ldsw + _i * 8192), 16, 0, 0); } while (0)
#define PG8_LDA(dst, b, h) do { _Pragma("unroll") for (int m = 0; m < 4; ++m) _Pragma("unroll") for (int k = 0; k < 2; ++k) dst[m][k] = *(const PG8_LAS bf16x8*)(lds + PG8_SA(b, h) + aoff + m * 2048 + k * 1024); } while (0)
#define PG8_LDB(dst, b, h) do { _Pragma("unroll") for (int n = 0; n < 2; ++n) _Pragma("unroll") for (int k = 0; k < 2; ++k) dst[n][k] = *(const PG8_LAS bf16x8*)(lds + PG8_SB(b, h) + boff + n * 2048 + k * 1024); } while (0)
#define PG8_MMA(ai, bj, At, Bt) do { __builtin_amdgcn_s_setprio(1); _Pragma("unroll") for (int m = 0; m < 4; ++m) _Pragma("unroll") for (int n = 0; n < 2; ++n) _Pragma("unroll") for (int k = 0; k < 2; ++k) \
        acc[ai][bj][m][n] = __builtin_amdgcn_mfma_f32_16x16x32_bf16(Bt[n][k], At[m][k], acc[ai][bj][m][n], 0, 0, 0); __builtin_amdgcn_s_setprio(0); } while (0)
#define PG8_WAIT_V(n) asm volatile("s_waitcnt vmcnt(" #n ")" ::: "memory")
#define PG8_WAIT_L(n) asm volatile("s_waitcnt lgkmcnt(" #n ")" ::: "memory")
#define PG8_BAR __builtin_amdgcn_s_barrier()
#define PG8_SCHED __builtin_amdgcn_sched_barrier(0)
    Unit cur, nxt; int ui = 0;
    if (!S.next(0, cur)) return;
    f32x4 acc[2][2][4][2];
#pragma unroll
    for (int a = 0; a < 2; ++a)
#pragma unroll
        for (int b = 0; b < 2; ++b)
#pragma unroll
            for (int m = 0; m < 4; ++m)
#pragma unroll
                for (int n = 0; n < 2; ++n) acc[a][b][m][n] = (f32x4){0.f, 0.f, 0.f, 0.f};
    bf16x8 At[4][2], B0[2][2], B1[2][2];
    const char* cA = (const char*)seg_a(g, cur.seg) + (size_t)cur.pm * tstep; const char* cB = (const char*)seg_b(g, cur.seg) + (size_t)cur.pn * tstep;
    S.a_ready(cur);
    if constexpr (SP2) {
        PG8_STAGE(PG8_SB(0, 0), cB, voffB); PG8_STAGE(PG8_SB(0, 1), cB + hstep, voffB); PG8_STAGE(PG8_SA(0, 0), cA, voffA); PG8_STAGE(PG8_SA(0, 1), cA + hstep, voffA);
        if (wr == 1) PG8_BAR;
        PG8_WAIT_V(2); PG8_BAR;
        PG8_STAGE(PG8_SB(1, 0), cB + kstep, voffB); PG8_STAGE(PG8_SA(1, 0), cA + kstep, voffA); PG8_STAGE(PG8_SB(1, 1), cB + hstep + kstep, voffB);
        PG8_WAIT_V(6); PG8_BAR;
    } else {
        PG8_STAGE(PG8_SB(0, 0), cB, voffB); PG8_STAGE(PG8_SA(0, 0), cA, voffA); PG8_STAGE(PG8_SB(0, 1), cB + hstep, voffB); PG8_STAGE(PG8_SA(0, 1), cA + hstep, voffA);
        if (wr == 1) PG8_BAR;
        PG8_WAIT_V(4); PG8_BAR;
        PG8_STAGE(PG8_SB(1, 0), cB + kstep, voffB); PG8_STAGE(PG8_SA(1, 0), cA + kstep, voffA); PG8_STAGE(PG8_SB(1, 1), cB + hstep + kstep, voffB);
        PG8_WAIT_V(6); PG8_BAR;
    }
    for (;;) {
        const bool has_next = S.next(ui + 1, nxt);
        const char* nA = has_next ? (const char*)seg_a(g, nxt.seg) + (size_t)nxt.pm * tstep : cA; const char* nB = has_next ? (const char*)seg_b(g, nxt.seg) + (size_t)nxt.pn * tstep : cB;
        for (int t = 0; t < nt; t += 2) {
            const bool last = (t == nt - 2);
            const char* a1 = cA + (size_t)(t + 1) * kstep;
            const char* a2 = last ? nA : cA + (size_t)(t + 2) * kstep; const char* b2 = last ? nB : cB + (size_t)(t + 2) * kstep;
            const char* a3 = a2 + kstep; const char* b3 = b2 + kstep;
            if (last && has_next) S.a_ready(nxt);
            if constexpr (SP2) {
            PG8_LDB(B0, 0, 0); PG8_LDB(B1, 0, 1); PG8_SCHED; PG8_LDA(At, 0, 0); PG8_STAGE(PG8_SA(1, 1), a1 + hstep, voffA);
            PG8_WAIT_V(8); PG8_WAIT_L(0); PG8_BAR; PG8_MMA(0, 0, At, B0); PG8_MMA(0, 1, At, B1); PG8_BAR; PG8_SCHED;
            PG8_LDA(At, 0, 1); PG8_STAGE(PG8_SB(0, 0), b2, voffB); PG8_STAGE(PG8_SB(0, 1), b2 + hstep, voffB); PG8_STAGE(PG8_SA(0, 0), a2, voffA);
            PG8_WAIT_V(8); PG8_WAIT_L(0); PG8_BAR; PG8_MMA(1, 0, At, B0); PG8_MMA(1, 1, At, B1); PG8_BAR; PG8_SCHED;
            PG8_LDB(B0, 1, 0); PG8_LDB(B1, 1, 1); PG8_SCHED; PG8_LDA(At, 1, 0); PG8_STAGE(PG8_SA(0, 1), a2 + hstep, voffA);
            PG8_WAIT_V(8); PG8_WAIT_L(0); PG8_BAR; PG8_MMA(0, 0, At, B0); PG8_MMA(0, 1, At, B1); PG8_BAR; PG8_SCHED;
            PG8_LDA(At, 1, 1); PG8_STAGE(PG8_SB(1, 0), b3, voffB); PG8_STAGE(PG8_SB(1, 1), b3 + hstep, voffB); PG8_STAGE(PG8_SA(1, 0), a3, voffA);
            PG8_WAIT_V(8); PG8_WAIT_L(0); PG8_BAR; PG8_MMA(1, 0, At, B0); PG8_MMA(1, 1, At, B1); PG8_BAR; PG8_SCHED;
            } else {
            PG8_LDB(B0, 0, 0); PG8_SCHED; PG8_LDA(At, 0, 0); PG8_STAGE(PG8_SA(1, 1), a1 + hstep, voffA);
            PG8_WAIT_L(8); PG8_BAR; PG8_WAIT_L(0); PG8_MMA(0, 0, At, B0); PG8_BAR; PG8_SCHED;
            PG8_LDB(B1, 0, 1); PG8_STAGE(PG8_SB(0, 0), b2, voffB);
            PG8_BAR; PG8_WAIT_L(0); PG8_MMA(0, 1, At, B1); PG8_BAR;
            PG8_LDA(At, 0, 1); PG8_STAGE(PG8_SA(0, 0), a2, voffA);
            PG8_BAR; PG8_WAIT_L(0); PG8_MMA(1, 0, At, B0); PG8_BAR; PG8_SCHED;
            PG8_STAGE(PG8_SB(0, 1), b2 + hstep, voffB);
            PG8_WAIT_V(6); PG8_BAR; PG8_MMA(1, 1, At, B1); PG8_BAR;
            PG8_LDB(B0, 1, 0); PG8_SCHED; PG8_LDA(At, 1, 0); PG8_STAGE(PG8_SA(0, 1), a2 + hstep, voffA);
            PG8_WAIT_L(8); PG8_BAR; PG8_WAIT_L(0); PG8_MMA(0, 0, At, B0); PG8_BAR; PG8_SCHED;
            PG8_LDB(B1, 1, 1); PG8_STAGE(PG8_SB(1, 0), b3, voffB);
            PG8_BAR; PG8_WAIT_L(0); PG8_MMA(0, 1, At, B1); PG8_BAR;
            PG8_LDA(At, 1, 1); PG8_STAGE(PG8_SA(1, 0), a3, voffA);
            PG8_BAR; PG8_WAIT_L(0); PG8_MMA(1, 0, At, B0); PG8_BAR; PG8_SCHED;
            PG8_STAGE(PG8_SB(1, 1), b3 + hstep, voffB);
            PG8_WAIT_V(6); PG8_BAR; PG8_MMA(1, 1, At, B1); PG8_BAR;
            }
        }
        if constexpr (ALIGN_EPI) { if (wr == 0) PG8_BAR; }
        if constexpr (!Epi::AFTER_DRAIN) { E(acc, cur, wr, wc, fr, fq); S.done(cur); }
        if (!has_next) break;
        if (!epi_keep<Epi>(nxt.seg)) {
#pragma unroll
        for (int a = 0; a < 2; ++a)
#pragma unroll
            for (int b = 0; b < 2; ++b)
#pragma unroll
                for (int m = 0; m < 4; ++m)
#pragma unroll
                    for (int n = 0; n < 2; ++n) acc[a][b][m][n] = (f32x4){0.f, 0.f, 0.f, 0.f};
        }
        cur = nxt; cA = nA; cB = nB; ++ui;
        if constexpr (ALIGN_EPI) { if (wr == 1) PG8_BAR; }
    }
    PG8_WAIT_V(0);
    if constexpr (!ALIGN_EPI) { if (wr == 0) PG8_BAR; }
    PG8_BAR;
    if constexpr (Epi::AFTER_DRAIN) { E.fused(acc, cur, wr, wc, fr, fq, lds, wid, lane); S.done(cur); }
#undef PG8_SA
#undef PG8_SB
#undef PG8_STAGE
#undef PG8_LDA
#undef PG8_LDB
#undef PG8_MMA
#undef PG8_WAIT_V
#undef PG8_WAIT_L
#undef PG8_BAR
#undef PG8_SCHED
}
}

#define LAS __attribute__((address_space(3)))
typedef unsigned short bf16;
typedef float f32x4 __attribute__((ext_vector_type(4)));
typedef float f32x16 __attribute__((ext_vector_type(16)));
typedef short bf16x8 __attribute__((ext_vector_type(8)));
typedef short s16x4 __attribute__((ext_vector_type(4)));
typedef unsigned u32x4 __attribute__((ext_vector_type(4)));
typedef unsigned u32x2 __attribute__((ext_vector_type(2)));

constexpr int DM = 1024, NB = 8, SEQ = 8192, DEPTH = 4, MROWS = NB * SEQ, DFF = 2816, INW = 8192, NMOD = 9 * DM;
constexpr int NWAVES = 8, NTHR = 512;
constexpr float NORM_EPS = 1e-6f, LOG2E = 1.4426950408889634f;
constexpr size_t MiB = 1u << 20;
constexpr size_t WS_CTL = 0;
constexpr size_t WS_MOD = 1 * MiB;
constexpr size_t WS_WT = 4 * MiB;
constexpr size_t W_UPA = 0, W_DNA = W_UPA + (size_t)2 * DFF * DM, W_UPB = W_DNA + (size_t)DM * DFF, W_DNB = W_UPB + (size_t)2 * DFF * DM,
                 W_IN = W_DNB + (size_t)DM * DFF, W_RET = W_IN + (size_t)INW * DM, W_DIF = W_RET + (size_t)DM * DM, W_OUT = W_DIF + (size_t)DM * DM, W_END = W_OUT + (size_t)DM * DM;
constexpr size_t WS_H = 64 * MiB;
constexpr size_t ACT = (size_t)MROWS * DM * 2;
constexpr size_t WS_B0 = 192 * MiB;
constexpr size_t WS_HID = WS_B0;
constexpr size_t WS_END = WS_B0 + 6 * ACT;
static_assert(WS_WT + W_END * 2 <= WS_H && WS_END <= 1024 * MiB, "d_ws map");

struct Args { const float* in[18]; float* out; unsigned char* ws; };

__device__ __forceinline__ float shx(float v, int m, int lane) { return __int_as_float(__builtin_amdgcn_ds_bpermute((lane ^ m) << 2, __float_as_int(v))); }
__device__ __forceinline__ float wave_sum(float v, int lane) {
#pragma unroll
    for (int o = 1; o < 64; o <<= 1) v += shx(v, o, lane);
    return v;
}
__device__ __forceinline__ unsigned f2bf(float f) { unsigned u = __float_as_uint(f); return (u + 0x7fffu + ((u >> 16) & 1u)) >> 16; }
__device__ __forceinline__ unsigned pk2(float lo, float hi) { return pg8::cvt_pk_bf16(lo, hi); }
typedef __bf16 bf16x2_cv __attribute__((ext_vector_type(2))); typedef float f32x2_cv __attribute__((ext_vector_type(2)));
__device__ __forceinline__ unsigned pk2v(float lo, float hi) { f32x2_cv v = {lo, hi}; bf16x2_cv b = __builtin_convertvector(v, bf16x2_cv); return __builtin_bit_cast(unsigned, b); }
__device__ __forceinline__ float bflo(unsigned w) { return __uint_as_float(w << 16); }
__device__ __forceinline__ float bfhi(unsigned w) { return __uint_as_float(w & 0xffff0000u); }
__device__ __forceinline__ float sgpr_f(float v) { return __int_as_float(__builtin_amdgcn_readfirstlane(__float_as_int(v))); }
__device__ __forceinline__ int launder(int v) { asm volatile("" : "+v"(v)); return v; }
#define LDS_WAIT() asm volatile("s_waitcnt lgkmcnt(0)" ::: "memory")
#define LDS_BARRIER() do { asm volatile("s_waitcnt lgkmcnt(0)" ::: "memory"); __builtin_amdgcn_s_barrier(); asm volatile("" ::: "memory"); } while (0)
#define MFMA32(a, b, c) __builtin_amdgcn_mfma_f32_32x32x16_bf16((a), (b), (c), 0, 0, 0)
__device__ __forceinline__ int crow(int r, int hi) { return (r & 3) + 8 * (r >> 2) + 4 * hi; }
typedef short v4i16_t __attribute__((ext_vector_type(4)));
__device__ __forceinline__ s16x4 tr_read(const LAS unsigned char* p) { return __builtin_bit_cast(s16x4, __builtin_amdgcn_ds_read_tr16_b64_v4i16((LAS v4i16_t*)p)); }
__device__ __forceinline__ bf16x8 cat8(s16x4 lo, s16x4 hi) { return (bf16x8){lo[0], lo[1], lo[2], lo[3], hi[0], hi[1], hi[2], hi[3]}; }
__device__ __forceinline__ bf16x8 pack8v(const f32x16& x, int s) {
    u32x4 p; p.x = pk2v(x[8 * s], x[8 * s + 1]); p.y = pk2v(x[8 * s + 2], x[8 * s + 3]); p.z = pk2v(x[8 * s + 4], x[8 * s + 5]); p.w = pk2v(x[8 * s + 6], x[8 * s + 7]);
    return __builtin_bit_cast(bf16x8, p);
}
__device__ __forceinline__ bf16x8 pack8(const f32x16& x, int s) {
    u32x4 p; p.x = pk2(x[8 * s], x[8 * s + 1]); p.y = pk2(x[8 * s + 2], x[8 * s + 3]); p.z = pk2(x[8 * s + 4], x[8 * s + 5]); p.w = pk2(x[8 * s + 6], x[8 * s + 7]);
    return __builtin_bit_cast(bf16x8, p);
}

template <bool UPPERM>
__device__ __forceinline__ void transpose_item(const float* W, int K, int N, bf16* WT, LAS float* scr, int item, int lane) {
    const int nblk = N / 32, kb = item / nblk, nb = item % nblk, k0 = 64 * kb, n0 = 32 * nb;
#pragma unroll 8
    for (int i = 0; i < 32; ++i) { const int kk = 2 * i + (lane >> 5); scr[kk * 33 + (lane & 31)] = W[(size_t)(k0 + kk) * N + n0 + (lane & 31)]; }
    LDS_WAIT(); asm volatile("" ::: "memory");
    int d0 = n0;
    if (UPPERM) { const int half = n0 / DFF, j = n0 % DFF; d0 = (j / 128) * 256 + half * 128 + (j % 128); }
    const int c = lane & 7;
#pragma unroll
    for (int j = 0; j < 4; ++j) { const int n = (lane >> 3) + 8 * j; const LAS float* s = scr + (8 * c) * 33 + n;
        u32x4 o; o.x = pk2(s[0 * 33], s[1 * 33]); o.y = pk2(s[2 * 33], s[3 * 33]); o.z = pk2(s[4 * 33], s[5 * 33]); o.w = pk2(s[6 * 33], s[7 * 33]);
        *(u32x4*)(WT + (size_t)(d0 + n) * K + k0 + 8 * c) = o; }
    LDS_WAIT(); asm volatile("" ::: "memory");
}
__device__ __forceinline__ void convert_weights(const Args& a, int l, LAS unsigned char* lds, int gw, int ngw, int wave, int lane) {
    lane = launder(lane);
    LAS float* scr = (LAS float*)(lds + wave * 16384);
    bf16* WT = (bf16*)(a.ws + WS_WT);
    const float* up = a.in[5] + (size_t)l * 2 * DM * 2 * DFF; const float* dn = a.in[6] + (size_t)l * 2 * DFF * DM;
    const float* win = a.in[7] + (size_t)l * DM * INW; const float* wr = a.in[14] + (size_t)l * DM * DM; const float* wd = a.in[15] + (size_t)l * DM * DM; const float* wo = a.in[16] + (size_t)l * DM * DM;
    constexpr int I_UP = (DM / 64) * (2 * DFF / 32), I_DN = (DFF / 64) * (DM / 32), I_IN = (DM / 64) * (INW / 32), I_SQ = (DM / 64) * (DM / 32);
    constexpr int NITEMS = 2 * I_UP + 2 * I_DN + I_IN + 3 * I_SQ;
    for (int it = gw; it < NITEMS; it += ngw) {
        int r = it;
        if (r < I_UP) { transpose_item<true>(up, DM, 2 * DFF, WT + W_UPA, scr, r, lane); continue; } r -= I_UP;
        if (r < I_UP) { transpose_item<true>(up + (size_t)DM * 2 * DFF, DM, 2 * DFF, WT + W_UPB, scr, r, lane); continue; } r -= I_UP;
        if (r < I_DN) { transpose_item<false>(dn, DFF, DM, WT + W_DNA, scr, r, lane); continue; } r -= I_DN;
        if (r < I_DN) { transpose_item<false>(dn + (size_t)DFF * DM, DFF, DM, WT + W_DNB, scr, r, lane); continue; } r -= I_DN;
        if (r < I_IN) { transpose_item<false>(win, DM, INW, WT + W_IN, scr, r, lane); continue; } r -= I_IN;
        if (r < I_SQ) { transpose_item<false>(wr, DM, DM, WT + W_RET, scr, r, lane); continue; } r -= I_SQ;
        if (r < I_SQ) { transpose_item<false>(wd, DM, DM, WT + W_DIF, scr, r, lane); continue; } r -= I_SQ;
        transpose_item<false>(wo, DM, DM, WT + W_OUT, scr, r, lane);
    }
}
__device__ __forceinline__ void ada_phase(const Args& a, LAS unsigned char* lds, int wave, int lane) {
    lane = launder(lane);
    LAS float* sc = (LAS float*)lds; LAS float* part = (LAS float*)(lds + 32768);
    const float* c = a.in[1];
    for (int i = wave * 64 + lane; i < NB * DM; i += NTHR) { const float v = c[i]; sc[i] = v * pg8::sigmoid_f(v); }
    __syncthreads();
    float* mod = (float*)(a.ws + WS_MOD);
    constexpr int NIT = DEPTH * (NMOD / 64);
    for (int it = blockIdx.x; it < NIT; it += gridDim.x) {
        const int l = it / (NMOD / 64), j = (it % (NMOD / 64)) * 64 + lane;
        const float* w = a.in[2] + (size_t)l * DM * NMOD + j;
        float acc[NB];
#pragma unroll
        for (int b = 0; b < NB; ++b) acc[b] = 0.f;
        const int k0 = wave * 128;
#pragma unroll 8
        for (int k = 0; k < 128; ++k) { const float wv = w[(size_t)(k0 + k) * NMOD];
#pragma unroll
            for (int b = 0; b < NB; ++b) acc[b] += sc[b * DM + k0 + k] * wv; }
#pragma unroll
        for (int b = 0; b < NB; ++b) part[(wave * NB + b) * 64 + lane] = acc[b];
        __syncthreads();
        { const int b = wave; float s = a.in[3][(size_t)l * NMOD + j];
#pragma unroll
            for (int w8 = 0; w8 < 8; ++w8) s += part[(w8 * NB + b) * 64 + lane];
            mod[((size_t)l * NB + b) * NMOD + j] = s; }
        __syncthreads();
    }
}
template <int NR>
__device__ __forceinline__ void norm_mod_rows(const float* x, bf16* Hout, const float* const* mbp, const float* nw, const int* rows, int lane) {
    f32x4 v[NR][4]; float ss[NR];
#pragma unroll
    for (int r = 0; r < NR; ++r) { const f32x4* xr = (const f32x4*)(x + (size_t)rows[r] * DM) + lane;
#pragma unroll
        for (int j = 0; j < 4; ++j) v[r][j] = __builtin_nontemporal_load(xr + 64 * j); }
#pragma unroll
    for (int r = 0; r < NR; ++r) { float s = 0.f;
#pragma unroll
        for (int j = 0; j < 4; ++j) s += (v[r][j].x * v[r][j].x + v[r][j].y * v[r][j].y) + (v[r][j].z * v[r][j].z + v[r][j].w * v[r][j].w);
        ss[r] = s; }
#pragma unroll
    for (int o = 1; o < 64; o <<= 1)
#pragma unroll
        for (int r = 0; r < NR; ++r) ss[r] += shx(ss[r], o, lane);
#pragma unroll
    for (int r = 0; r < NR; ++r) { const float rstd = 1.0f / sqrtf(ss[r] * (1.f / DM) + NORM_EPS); const float* shift = mbp[r]; const float* scale = mbp[r] + DM;
        u32x2* o8 = (u32x2*)(Hout + (size_t)rows[r] * DM) + lane;
#pragma unroll
        for (int j = 0; j < 4; ++j) { const int c4 = lane + 64 * j; const f32x4 w = ((const f32x4*)nw)[c4], sc = ((const f32x4*)scale)[c4], sh = ((const f32x4*)shift)[c4];
            const f32x4 o = v[r][j] * rstd * w * (sc + 1.0f) + sh; u32x2 p; p.x = pk2(o.x, o.y); p.y = pk2(o.z, o.w); o8[64 * j] = p; } }
}
__device__ __forceinline__ void norm_phase(const Args& a, const float* x, int l, int sub, int gw, int ngw, int lane) {
    lane = launder(lane);
    bf16* H = (bf16*)(a.ws + WS_H); const float* mod = (const float*)(a.ws + WS_MOD); const float* nw = a.in[4] + ((size_t)l * 3 + sub) * DM;
    constexpr int NR = 4;
    const int G = ngw / NWAVES, blk = gw / NWAVES, wv = gw % NWAVES;
    if (G >= 8 && (G & 7) == 0) {
        const int b = blk & 7, stride = (G >> 3) * NWAVES, ws0 = (blk >> 3) * NWAVES + wv, niter = (SEQ + NR * stride - 1) / (NR * stride);
        for (int k = niter - 1; k >= 0; --k) { const int idx = ws0 + k * NR * stride; if (idx >= SEQ) continue; int rows[NR]; const float* mbp[NR];
#pragma unroll
            for (int r = 0; r < NR; ++r) { const int ir = idx + r * stride; rows[r] = b * SEQ + (ir < SEQ ? ir : idx); mbp[r] = mod + ((size_t)l * NB + b) * NMOD + sub * 3 * DM; }
            norm_mod_rows<NR>(x, H, mbp, nw, rows, lane); }
    } else {
    for (int m = gw; m < MROWS; m += NR * ngw) { int rows[NR]; const float* mbp[NR];
#pragma unroll
        for (int r = 0; r < NR; ++r) { rows[r] = m + r * ngw; if (rows[r] >= MROWS) rows[r] = m; mbp[r] = mod + ((size_t)l * NB + (rows[r] >> 13)) * NMOD + sub * 3 * DM; }
        norm_mod_rows<NR>(x, H, mbp, nw, rows, lane); }
    }
}
__device__ __forceinline__ void final_norm_phase(const Args& a, int gw, int ngw, int lane) {
    lane = launder(lane);
    const float* fw = a.in[17];
#ifdef DBG_CHECK
    const float dbgs = 1.0f + (float)((const unsigned*)(a.ws + WS_CTL))[32];
#else
    const float dbgs = 1.0f;
#endif
    for (int m = gw; m < MROWS; m += ngw) { f32x4* xr = (f32x4*)(a.out + (size_t)m * DM) + lane;
        f32x4 v[4]; float s = 0.f;
#pragma unroll
        for (int j = 0; j < 4; ++j) { v[j] = xr[64 * j]; s += (v[j].x * v[j].x + v[j].y * v[j].y) + (v[j].z * v[j].z + v[j].w * v[j].w); }
        const float rstd = 1.0f / sqrtf(wave_sum(s, lane) * (1.f / DM) + NORM_EPS);
#pragma unroll
        for (int j = 0; j < 4; ++j) xr[64 * j] = v[j] * (rstd * dbgs) * ((const f32x4*)fw)[lane + 64 * j]; }
}

constexpr int R_Q = 0, R_K = R_Q + 64 * 272, R_QD = R_K + 64 * 272, R_KD = R_QD + 64 * 272, R_SC = R_KD + 64 * 320, R_V = R_SC + 64 * 144, R_DEC = R_V + 64 * 576, R_END = R_DEC + 256;
static_assert(R_END <= 131072 && 64 * 1040 <= R_DEC, "retention LDS");
__device__ __forceinline__ void retention_unit(const Args& a, int l, int b, int h, LAS unsigned char* lds, const int wave_s, const bool dummy = false) {
    asm volatile("" : "+s"(h));
    const int lane = hw_lane(), wave = wave_s, tid = wave_s * 64 + lane, r32 = lane & 31, hh = lane >> 5;
    const int q4 = (lane & 15) >> 2, p4 = lane & 3, g1 = (lane >> 4) & 1;
    const bf16* RQK = (const bf16*)(a.ws + WS_B0); const bf16* RV = (const bf16*)(a.ws + WS_B0 + ACT); bf16* RG = (bf16*)(a.ws + WS_B0 + 2 * ACT);
    const float* gn = a.in[8] + (size_t)l * DM + h * 256;
    const float lg = sgpr_f(log2f(1.0f - exp2f(-5.0f - (float)h)));
    const float sc_qk = 0.08838834764831845f;
    const float cdec = sgpr_f(exp2f(lg * 64.f));
    const size_t row0 = (size_t)b * SEQ;
    f32x16 S[4];
#pragma unroll
    for (int i = 0; i < 4; ++i) S[i] = f32x16{};
    u32x4 pq[2], pk[2], pv[4]; u32x2 prg[8];
    const int er = tid >> 3, es = tid & 7;
#ifdef USE_RSB
#define RSB() __builtin_amdgcn_sched_barrier(0)
#else
#define RSB() do {} while (0)
#endif
#define R_PREFETCH(ci) do { const size_t t0 = row0 + (size_t)(ci) * 64; \
        _Pragma("unroll") for (int i = 0; i < 2; ++i) { const int idx = tid + 512 * i, rr = idx >> 4, ch = idx & 15; \
            pq[i] = *(const u32x4*)(RQK + (t0 + rr) * DM + h * 128 + ch * 8); pk[i] = *(const u32x4*)(RQK + (t0 + rr) * DM + 512 + h * 128 + ch * 8); } \
        _Pragma("unroll") for (int i = 0; i < 4; ++i) { const int idx = tid + 512 * i, rr = idx >> 5, ch = idx & 31; pv[i] = *(const u32x4*)(RV + (t0 + rr) * DM + h * 256 + ch * 8); } } while (0)
#define R_STORE() do { \
        _Pragma("unroll") for (int i = 0; i < 2; ++i) { const int idx = tid + 512 * i, rr = idx >> 4, ch = idx & 15; \
            *(LAS u32x4*)(lds + R_Q + rr * 272 + ch * 16) = pq[i]; *(LAS u32x4*)(lds + R_K + rr * 272 + ch * 16) = pk[i]; \
            const float fqd = exp2f(lg * (float)rr); u32x4 qd; \
            qd.x = pk2(bflo(pq[i].x) * fqd, bfhi(pq[i].x) * fqd); qd.y = pk2(bflo(pq[i].y) * fqd, bfhi(pq[i].y) * fqd); qd.z = pk2(bflo(pq[i].z) * fqd, bfhi(pq[i].z) * fqd); qd.w = pk2(bflo(pq[i].w) * fqd, bfhi(pq[i].w) * fqd); \
            *(LAS u32x4*)(lds + R_QD + rr * 272 + ch * 16) = qd; \
            const float f = sc_qk * exp2f(lg * (float)(64 - rr)); u32x4 kd; \
            kd.x = pk2(bflo(pk[i].x) * f, bfhi(pk[i].x) * f); kd.y = pk2(bflo(pk[i].y) * f, bfhi(pk[i].y) * f); kd.z = pk2(bflo(pk[i].z) * f, bfhi(pk[i].z) * f); kd.w = pk2(bflo(pk[i].w) * f, bfhi(pk[i].w) * f); \
            *(LAS u32x4*)(lds + R_KD + rr * 320 + ch * 16) = kd; } \
        _Pragma("unroll") for (int i = 0; i < 4; ++i) { const int idx = tid + 512 * i, rr = idx >> 5, ch = idx & 31; *(LAS u32x4*)(lds + R_V + rr * 576 + ch * 16) = pv[i]; } } while (0)
    R_PREFETCH(0);
    if (tid < 64) *(LAS float*)(lds + R_DEC + tid * 4) = sc_qk * exp2f(lg * (float)tid);
    R_STORE();
    LDS_BARRIER();
    for (int ci = 0; ci < SEQ / 64; ++ci) {
        const size_t t0 = row0 + (size_t)ci * 64;
        float lgl = lg;
#ifdef LGL
        asm volatile("" : "+v"(lgl));
#endif
        if (ci + 1 < SEQ / 64) R_PREFETCH(ci + 1);
#ifndef RG_LATE
#pragma unroll
        for (int j = 0; j < 8; ++j) prg[j] = *(const u32x2*)(RG + (t0 + er) * DM + h * 256 + 4 * (es + 8 * j));
#endif
        RSB();
        if (wave < 4) {
            const int qb = wave >> 1, kb = wave & 1; f32x16 x = f32x16{};
#pragma unroll
            for (int ks = 0; ks < 8; ++ks) { const bf16x8 af = *(const LAS bf16x8*)(lds + R_Q + (32 * qb + r32) * 272 + (16 * ks + 8 * hh) * 2);
                const bf16x8 bfr = *(const LAS bf16x8*)(lds + R_K + (32 * kb + r32) * 272 + (16 * ks + 8 * hh) * 2); x = MFMA32(af, bfr, x); }
#pragma unroll
            for (int i = 0; i < 16; ++i) { const int q = 32 * qb + crow(i, hh), k = 32 * kb + r32; const int d = q > k ? q - k : k - q;
                const float v = x[i] * *(const LAS float*)(lds + R_DEC + d * 4); *(LAS unsigned short*)(lds + R_SC + q * 144 + k * 2) = (unsigned short)f2bf(v); }
        }
        RSB();
        f32x16 y[2]; y[0] = f32x16{}; y[1] = f32x16{};
#pragma unroll
        for (int dkb = 0; dkb < 4; ++dkb)
#pragma unroll
            for (int s = 0; s < 2; ++s) { const bf16x8 sp = pack8(S[dkb], s);
#pragma unroll
                for (int qb = 0; qb < 2; ++qb) { const LAS unsigned char* qp = lds + R_QD + (32 * qb + r32) * 272 + (32 * dkb + 16 * s + 4 * hh) * 2;
                    const s16x4 lo = *(const LAS s16x4*)qp, hi = *(const LAS s16x4*)(qp + 16); y[qb] = MFMA32(cat8(lo, hi), sp, y[qb]); } }
        RSB();
        LDS_BARRIER();
        bf16x8 vf[4];
#pragma unroll
        for (int ks = 0; ks < 4; ++ks) { const LAS unsigned char* vp = lds + R_V + (16 * ks + 8 * hh + q4) * 576 + (32 * wave + 16 * g1) * 2 + 8 * p4; vf[ks] = cat8(tr_read(vp), tr_read(vp + 4 * 576)); }
#pragma unroll
        for (int ks = 0; ks < 4; ++ks)
#pragma unroll
            for (int qb = 0; qb < 2; ++qb) { const bf16x8 af = *(const LAS bf16x8*)(lds + R_SC + (32 * qb + r32) * 144 + (16 * ks + 8 * hh) * 2); y[qb] = MFMA32(af, vf[ks], y[qb]); }
        RSB();
#pragma unroll
        for (int dkb = 0; dkb < 4; ++dkb) {
#pragma unroll
            for (int i = 0; i < 16; ++i) S[dkb][i] *= cdec;
#pragma unroll
            for (int ks = 0; ks < 4; ++ks) { const LAS unsigned char* kp = lds + R_KD + (16 * ks + 8 * hh + q4) * 320 + (32 * dkb + 16 * g1) * 2 + 8 * p4;
                S[dkb] = MFMA32(cat8(tr_read(kp), tr_read(kp + 4 * 320)), vf[ks], S[dkb]); } }
        LDS_BARRIER();
#ifdef RG_LATE
#pragma unroll
        for (int j = 0; j < 8; ++j) prg[j] = *(const u32x2*)(RG + (t0 + er) * DM + h * 256 + 4 * (es + 8 * j));
#endif
#pragma unroll
        for (int qb = 0; qb < 2; ++qb)
#pragma unroll
            for (int i = 0; i < 16; ++i) *(LAS float*)(lds + (32 * qb + crow(i, hh)) * 1040 + (32 * wave + r32) * 4) = y[qb][i];
        LDS_BARRIER();
        { f32x4 yv[8]; float ss = 0.f;
#pragma unroll
            for (int j = 0; j < 8; ++j) { yv[j] = *(const LAS f32x4*)(lds + er * 1040 + 16 * (es + 8 * j)); ss += (yv[j].x * yv[j].x + yv[j].y * yv[j].y) + (yv[j].z * yv[j].z + yv[j].w * yv[j].w); }
            ss += shx(ss, 1, lane); ss += shx(ss, 2, lane); ss += shx(ss, 4, lane);
            const float rstd = 1.0f / sqrtf(ss * (1.f / 256.f) + NORM_EPS);
#pragma unroll
            for (int j = 0; j < 8; ++j) { const int c = 4 * (es + 8 * j); const f32x4 w = *(const f32x4*)(gn + c);
                const float g0 = bflo(prg[j].x), g1v = bfhi(prg[j].x), g2 = bflo(prg[j].y), g3 = bfhi(prg[j].y);
                u32x2 o; o.x = pk2(yv[j].x * rstd * w.x * g0 * pg8::sigmoid_f(g0), yv[j].y * rstd * w.y * g1v * pg8::sigmoid_f(g1v));
                o.y = pk2(yv[j].z * rstd * w.z * g2 * pg8::sigmoid_f(g2), yv[j].w * rstd * w.w * g3 * pg8::sigmoid_f(g3));
                if (!dummy || rstd == -12345.f) *(u32x2*)(RG + (t0 + er) * DM + h * 256 + c) = o; } }
        LDS_BARRIER();
        if (ci + 1 < SEQ / 64) R_STORE();
        LDS_BARRIER();
    }
#undef R_PREFETCH
#undef R_STORE
}

constexpr int A_KS = 272, A_VS = 320, A_KB = 64 * A_KS, A_VB = 64 * A_VS, A_BUF = A_KB + A_VB, A_X = 0;
static_assert(2 * A_BUF <= 131072 && 4 * 64 * 64 * 4 <= 131072, "attention LDS");
__device__ __forceinline__ void attn_unit(const Args& a, int l, int b, int h, int qb, float lam, float post, LAS unsigned char* lds, const int wave_s, const bool dummy = false) {
    asm volatile("" : "+s"(h));
    const int lane = hw_lane(), wave = wave_s, tid = wave_s * 64 + lane, r32 = lane & 31, hh = lane >> 5;
    const int q4 = (lane & 15) >> 2, p4 = lane & 3, g1 = (lane >> 4) & 1;
    const int sub = wave >> 2, wq = wave & 3;
    bf16* DQ = (bf16*)(a.ws + WS_B0 + 3 * ACT); const bf16* DK = (const bf16*)(a.ws + WS_B0 + 4 * ACT); const bf16* DV = (const bf16*)(a.ws + WS_B0 + 5 * ACT);
    const size_t row0 = (size_t)b * SEQ; const int q0 = qb * 128;
    const int NT = 2 * qb + 2;
    const float sl2 = sgpr_f(exp2f(-(float)(h + 1)) * LOG2E);
    bf16x8 qf[4];
    { const bf16* qp = DQ + (row0 + q0 + 32 * wq + r32) * DM + h * 128 + sub * 64 + 8 * hh;
#pragma unroll
        for (int ks = 0; ks < 4; ++ks) qf[ks] = *(const bf16x8*)(qp + 16 * ks); }
    u32x4 pk[2], pv[2];
#define A_PREFETCH(t) do { const size_t t0 = row0 + (size_t)(t) * 64; \
        _Pragma("unroll") for (int i = 0; i < 2; ++i) { const int idx = tid + 512 * i, rr = idx >> 4, ch = idx & 15; \
            pk[i] = *(const u32x4*)(DK + (t0 + rr) * DM + h * 128 + ch * 8); pv[i] = *(const u32x4*)(DV + (t0 + rr) * DM + h * 128 + ch * 8); } } while (0)
#define A_STORE(bufo) do { \
        _Pragma("unroll") for (int i = 0; i < 2; ++i) { const int idx = tid + 512 * i, rr = idx >> 4, ch = idx & 15; \
            *(LAS u32x4*)(lds + (bufo) + rr * A_KS + ch * 16) = pk[i]; *(LAS u32x4*)(lds + (bufo) + A_KB + rr * A_VS + ch * 16) = pv[i]; } } while (0)
    f32x16 o[4];
#pragma unroll
    for (int i = 0; i < 4; ++i) o[i] = f32x16{};
    float mrun = -1e30f, lrun = 0.f;
    f32x16 cb;
#pragma unroll
    for (int i = 0; i < 16; ++i) cb[i] = sl2 * (float)((i & 3) + 8 * (i >> 2) + 4 * hh);
    const float c32 = sgpr_f(32.f * sl2);
    const int tq = NT - 2 + (wq >> 1);
    const float qin = (float)(32 * (wq & 1) + r32), qs = sl2 * qin;
    const int tmin = max(0, (int)ceilf((128.f * (float)qb - 63.f - 220.f / sl2) * (1.f / 64.f)));
    A_PREFETCH(NT - 1);
    A_STORE(0);
    LDS_BARRIER();
    for (int it = 0; it < NT - tmin; ++it) {
        const int t = NT - 1 - it, bufo = (it & 1) * A_BUF;
        if (t > tmin) A_PREFETCH(t - 1);
        if (t <= tq) {
            f32x16 s[2];
            s[0] = cb;
#pragma unroll
            for (int i = 0; i < 16; ++i) s[1][i] = cb[i] + c32;
#pragma unroll
            for (int kb = 0; kb < 2; ++kb)
#pragma unroll
                for (int ks = 0; ks < 4; ++ks) { const bf16x8 kf = *(const LAS bf16x8*)(lds + bufo + (32 * kb + r32) * A_KS + (sub * 64 + 16 * ks + 8 * hh) * 2); s[kb] = MFMA32(kf, qf[ks], s[kb]); }
            float ut = -sl2 * (qin + 64.f * (float)(tq - t));
            if (t == tq) {
                ut = 0.f;
#pragma unroll
                for (int i = 0; i < 16; ++i) { const float c0 = cb[i], c1 = cb[i] + c32; s[0][i] = s[0][i] - c0 - fabsf(qs - c0); s[1][i] = s[1][i] - c1 - fabsf(qs - c1); }
            }
            float mt = fmaxf(s[0][0], s[1][0]);
#pragma unroll
            for (int i = 1; i < 16; ++i) mt = fmaxf(fmaxf(mt, s[0][i]), s[1][i]);
            mt = fmaxf(mt, shx(mt, 32, lane)) + ut;
            if (__any(mt > mrun)) {
                const float mnew = fmaxf(mrun, mt), alpha = __builtin_amdgcn_exp2f(mrun - mnew); mrun = mnew; lrun *= alpha;
#pragma unroll
                for (int d4 = 0; d4 < 4; ++d4)
#pragma unroll
                    for (int i = 0; i < 16; ++i) o[d4][i] *= alpha;
            }
            const float ml = mrun - ut;
            float ps = 0.f;
#pragma unroll
            for (int kb = 0; kb < 2; ++kb)
#pragma unroll
                for (int i = 0; i < 16; ++i) { s[kb][i] = __builtin_amdgcn_exp2f(s[kb][i] - ml); ps += s[kb][i]; }
            lrun += ps;
            __builtin_amdgcn_sched_barrier(0);
            {
                const LAS unsigned char* vbase = lds + bufo + A_KB + (4 * hh + q4) * A_VS + (16 * g1) * 2 + 8 * p4;
                bf16x8 vcur[4], vnxt[4];
#pragma unroll
                for (int d4 = 0; d4 < 4; ++d4) vcur[d4] = cat8(tr_read(vbase + 64 * d4), tr_read(vbase + 64 * d4 + 8 * A_VS));
#pragma unroll
                for (int g = 0; g < 4; ++g) {
                    if (g < 3) {
#pragma unroll
                        for (int d4 = 0; d4 < 4; ++d4) vnxt[d4] = cat8(tr_read(vbase + (g + 1) * 16 * A_VS + 64 * d4), tr_read(vbase + (g + 1) * 16 * A_VS + 64 * d4 + 8 * A_VS)); }
                    const bf16x8 pf = pack8v(s[g >> 1], g & 1);
#pragma unroll
                    for (int d4 = 0; d4 < 4; ++d4) o[d4] = MFMA32(vcur[d4], pf, o[d4]);
                    __builtin_amdgcn_sched_barrier(0);
#pragma unroll
                    for (int d4 = 0; d4 < 4; ++d4) vcur[d4] = vnxt[d4];
                }
            }
        }
        if (t > tmin) A_STORE(((it + 1) & 1) * A_BUF);
        LDS_BARRIER();
    }
    lrun += shx(lrun, 32, lane);
    const float rl = 1.0f / lrun;
    if (sub == 1) {
#pragma unroll
        for (int d4 = 0; d4 < 4; ++d4)
#pragma unroll
            for (int i = 0; i < 16; ++i) *(LAS float*)(lds + A_X + ((wq * 64 + d4 * 16 + i) * 64 + lane) * 4) = o[d4][i] * rl;
    }
    __syncthreads();
    if (sub == 0) {
        float ss = 0.f;
#pragma unroll
        for (int d4 = 0; d4 < 4; ++d4)
#pragma unroll
            for (int i = 0; i < 16; ++i) { const float v = o[d4][i] * rl - lam * *(const LAS float*)(lds + A_X + ((wq * 64 + d4 * 16 + i) * 64 + lane) * 4); o[d4][i] = v; ss += v * v; }
        ss += shx(ss, 32, lane);
        const float rstd = post / sqrtf(ss * (1.f / 128.f) + NORM_EPS);
        const float* sw = a.in[13] + (size_t)l * 128;
        bf16* op = DQ + (row0 + q0 + 32 * wq + r32) * DM + h * 128;
#pragma unroll
        for (int d4 = 0; d4 < 4; ++d4)
#pragma unroll
            for (int g = 0; g < 4; ++g) { const int dv = 32 * d4 + 8 * g + 4 * hh; const f32x4 w = *(const f32x4*)(sw + dv);
                u32x2 pkd; pkd.x = pk2(o[d4][4 * g] * rstd * w.x, o[d4][4 * g + 1] * rstd * w.y); pkd.y = pk2(o[d4][4 * g + 2] * rstd * w.z, o[d4][4 * g + 3] * rstd * w.w);
                if (!dummy || rstd == -12345.f) *(u32x2*)(op + dv) = pkd; }
    }
    __syncthreads();
#undef A_PREFETCH
#undef A_STORE
}


#define XB_TMO      128
#define XB_XCNT(j)  (256  + 64 * (j))
#define XB_XSUB(j)  (1280 + 64 * (j))
#define XB_XGEN(j)  (2304 + 64 * (j))
#define XB_TOP      3328
#define XB_TOPGEN   3392
#define XCD_BAR_WORDS 3456
#define XB_SPIN_CAP (1u << 24)

__device__ __forceinline__ unsigned xb_ld(unsigned* p)              { return __hip_atomic_load(p, __ATOMIC_RELAXED, __HIP_MEMORY_SCOPE_AGENT); }
__device__ __forceinline__ unsigned xb_add(unsigned* p, unsigned v) { return __hip_atomic_fetch_add(p, v, __ATOMIC_RELAXED, __HIP_MEMORY_SCOPE_AGENT); }
__device__ __forceinline__ unsigned xb_xcc_id() { return (unsigned)__builtin_amdgcn_s_getreg((3 << 11) | 20) & 0xFu; }
#define XB_SPIN(cond, bar) do { unsigned _sp = 0; while (cond) { __builtin_amdgcn_s_sleep(1); \
    if ((++_sp & 255u) == 0u) { if (xb_ld(&(bar)[XB_TMO])) break; if (_sp > XB_SPIN_CAP) { atomicAdd(&(bar)[XB_TMO], 1u); break; } } } } while (0)

struct XcdBarrier {
    unsigned* bar; unsigned x;
    volatile LAS unsigned* st;
};

__device__ __forceinline__ XcdBarrier xcd_barrier_post(unsigned* bar, volatile LAS unsigned* st, bool first) {
    XcdBarrier b; b.bar = bar; b.x = xb_xcc_id(); b.st = st;
    if (first) (void)xb_add(&bar[XB_XCNT(b.x)], 1u);
    return b;
}
__device__ __forceinline__ void xcd_barrier_complete(unsigned* bar, unsigned x, unsigned& nloc, unsigned& nx) {
    const unsigned G = gridDim.x * gridDim.y * gridDim.z;
    unsigned sum, cnt, mine, sp = 0u;
    for (;;) {
        sum = 0u; cnt = 0u; mine = 0u;
#pragma unroll
        for (unsigned j = 0; j < 16; ++j) { const unsigned c = xb_ld(&bar[XB_XCNT(j)]); sum += c; cnt += (c > 0u) ? 1u : 0u; mine = (j == x) ? c : mine; }
        if (sum == G) break;
        __builtin_amdgcn_s_sleep(1);
        if ((++sp & 255u) == 0u) { if (xb_ld(&bar[XB_TMO])) break; if (sp > XB_SPIN_CAP) { atomicAdd(&bar[XB_TMO], 1u); break; } }
    }
    nloc = mine > 0u ? mine : 1u; nx = cnt > 0u ? cnt : 1u;
}

__device__ __forceinline__ void xcd_barrier(const XcdBarrier& b, const bool first) {
    asm volatile("s_waitcnt vmcnt(0)" ::: "memory");
    __syncthreads();
    if (first) {
        unsigned* bar = b.bar;
        __builtin_amdgcn_s_waitcnt(0);
        unsigned nloc = b.st[0], nx = b.st[1];
        if (nloc == 0u) { xcd_barrier_complete(bar, b.x, nloc, nx); b.st[0] = nloc; b.st[1] = nx; }
        const unsigned old = xb_add(&bar[XB_XSUB(b.x)], 1u);
        const unsigned gen = old / nloc;
        if (old + 1u == (gen + 1u) * nloc) {
            __builtin_amdgcn_fence(__ATOMIC_RELEASE, "agent");
            asm volatile("s_waitcnt vmcnt(0)" ::: "memory");
            const unsigned og = xb_add(&bar[XB_TOP], 1u);
            const unsigned tg = og / nx;
            if (og + 1u == (tg + 1u) * nx) xb_add(&bar[XB_TOPGEN], 1u);
            else XB_SPIN(xb_ld(&bar[XB_TOPGEN]) == tg, bar);
            __builtin_amdgcn_fence(__ATOMIC_ACQUIRE, "agent");
            xb_add(&bar[XB_XGEN(b.x)], 1u);
            asm volatile("s_waitcnt vmcnt(0)" ::: "memory");
        } else {
            XB_SPIN(xb_ld(&bar[XB_XGEN(b.x)]) == gen, bar);
            __builtin_amdgcn_fence(__ATOMIC_ACQUIRE, "agent");
            asm volatile("s_waitcnt vmcnt(0)" ::: "memory");
        }
    }
    __syncthreads();
}

#define CG_SYNC() do { asm volatile("s_waitcnt vmcnt(0) lgkmcnt(0)" ::: "memory"); __syncthreads(); grid.sync(); \
    __builtin_amdgcn_fence(__ATOMIC_ACQUIRE, "agent"); asm volatile("s_waitcnt vmcnt(0)" ::: "memory"); __syncthreads(); } while (0)
#define IS_T0 (wave_s == 0 && hw_lane() == 0)
#define GRID_SYNC() xcd_barrier(xbar, IS_T0)
constexpr int CW_BAR = 4096;
typedef const __attribute__((address_space(4))) Args* KArgsPtr;
#define PHASE_BEGIN Args a; { KArgsPtr ka_ = (KArgsPtr)__builtin_amdgcn_kernarg_segment_ptr(); asm volatile("" : "+s"(ka_)); _Pragma("unroll") for (int i_ = 0; i_ < 18; ++i_) a.in[i_] = ka_->in[i_]; a.out = ka_->out; a.ws = ka_->ws; } \
    const int lane = hw_lane(), wave = wave_s, tid = wave_s * 64 + lane; const int G = gridDim.x, gw = blockIdx.x * NWAVES + wave, ngw = G * NWAVES; \
    unsigned* ctl = (unsigned*)(a.ws + WS_CTL); const float* mod = (const float*)(a.ws + WS_MOD); bf16* WT = (bf16*)(a.ws + WS_WT); bf16* H = (bf16*)(a.ws + WS_H); bf16* HID = (bf16*)(a.ws + WS_HID); bf16* B0 = (bf16*)(a.ws + WS_B0); \
    (void)tid; (void)lane; (void)wave; (void)G; (void)gw; (void)ngw; (void)ctl; (void)mod; (void)WT; (void)H; (void)HID; (void)B0;
#define GEMM_RUN(EPI, ...) do { pg8::StaticOrder S; S.init(MROWS, g.N, G, (int)blockIdx.x); EPI E{__VA_ARGS__}; pg8::gemm_phase<EPI, pg8::StaticOrder, true, true>(lds, g, S, E, wave_s); } while (0)

__global__ void __launch_bounds__(NTHR, 2) hybrid_fwd(Args args_unused) {
    extern __shared__ __attribute__((aligned(16))) unsigned char lds_raw[];
    LAS unsigned char* lds = (LAS unsigned char*)lds_raw;
    cg::grid_group grid = cg::this_grid();
    const int wave_s = __builtin_amdgcn_readfirstlane((int)threadIdx.x >> 6);
    LAS unsigned* qslot = (LAS unsigned*)(lds + 131072);

    {
        PHASE_BEGIN
        if (blockIdx.x == 0) { if (tid < 64) ctl[tid] = 0u; for (int i = tid; i < XCD_BAR_WORDS; i += NTHR) ctl[CW_BAR + i] = 0u; }
        ada_phase(a, lds, wave, lane);
        convert_weights(a, 0, lds, gw, ngw, wave, lane);
    }
    CG_SYNC();
    XcdBarrier xbar;
    {   PHASE_BEGIN
        volatile LAS unsigned* st = (volatile LAS unsigned*)(lds + 131072 + 16);
        if (tid < 2) st[tid] = 0u;
        __syncthreads();
        xbar = xcd_barrier_post(ctl + CW_BAR, st, tid == 0);
    }

    for (int l = 0; l < DEPTH; ++l) {
        {
            PHASE_BEGIN
            if (l > 0) convert_weights(a, l, lds, gw, ngw, wave, lane);
            norm_phase(a, (l == 0) ? a.in[0] : a.out, l, 0, gw, ngw, lane);
        }
        GRID_SYNC();
        { PHASE_BEGIN pg8::Gemm g{H, WT + W_UPA, MROWS, 2 * DFF, DM}; GEMM_RUN(pg8::EpiSwiGLU, HID, DFF); }
        GRID_SYNC();
        { PHASE_BEGIN pg8::Gemm g{HID, WT + W_DNA, MROWS, DM, DFF}; GEMM_RUN(pg8::EpiResid, (l == 0) ? a.in[0] : a.out, a.out, mod + (size_t)l * NB * NMOD + 0 * 3 * DM + 2 * DM, NMOD, 0.5f, DM); }
        GRID_SYNC();
        { PHASE_BEGIN norm_phase(a, a.out, l, 1, gw, ngw, lane); }
        GRID_SYNC();
        { PHASE_BEGIN pg8::Gemm g{H, WT + W_IN, MROWS, 6 * DM, DM}; GEMM_RUN(pg8::EpiBf<0>, B0, DM, DM, (size_t)MROWS * DM, 3, 0.125f * LOG2E, nullptr); }
        GRID_SYNC();
        {
            PHASE_BEGIN
            if (blockIdx.x < 32) retention_unit(a, l, blockIdx.x & 7, blockIdx.x >> 3, lds, wave_s);
            const float s1 = wave_sum(a.in[9][l * 64 + lane] * a.in[10][l * 64 + lane], lane), s2 = wave_sum(a.in[11][l * 64 + lane] * a.in[12][l * 64 + lane], lane);
            const float lam_init = sgpr_f(0.8f - 0.6f * expf(-0.3f * (float)l)), lam = sgpr_f(expf(s1) - expf(s2) + lam_init);
            const int q0 = (int)(xb_xcc_id() & 7u);
            for (int k = 0; k < NB; ++k) {
                const int bq = (q0 + k) & 7;
                for (;;) {
                    if (tid == 0) *qslot = atomicAdd(ctl + l * NB + bq, 1u);
                    __syncthreads();
                    const unsigned item = *qslot;
                    __syncthreads();
                    if (item >= 8u * 64u) break;
                    attn_unit(a, l, bq, 7 - (int)(item >> 6), 63 - (int)(item & 63u), lam, 1.0f - lam_init, lds, wave_s);
                }
            }
        }
        GRID_SYNC();
        {
            PHASE_BEGIN pg8::Gemm g{H, WT + W_IN + (size_t)6 * DM * DM, MROWS, DM, DM, H, WT + W_IN + (size_t)7 * DM * DM, B0 + (size_t)2 * MROWS * DM, WT + W_RET, B0 + (size_t)3 * MROWS * DM, WT + W_DIF};
            pg8::SegOrderN<2> S; S.init(MROWS, g.N, G, (int)blockIdx.x); pg8::EpiMerge E{B0 + (size_t)1 * MROWS * DM, DM, B0, B0 + (size_t)4 * MROWS * DM};
            pg8::gemm_phase<pg8::EpiMerge, pg8::SegOrderN<2>, true, true>(lds, g, S, E, wave_s); }
        GRID_SYNC();
        { PHASE_BEGIN pg8::Gemm g{B0 + (size_t)1 * MROWS * DM, WT + W_OUT, MROWS, DM, DM}; GEMM_RUN(pg8::EpiResid, a.out, a.out, mod + (size_t)l * NB * NMOD + 1 * 3 * DM + 2 * DM, NMOD, 1.0f, DM); }
        GRID_SYNC();
        { PHASE_BEGIN norm_phase(a, a.out, l, 2, gw, ngw, lane); }
        GRID_SYNC();
        { PHASE_BEGIN pg8::Gemm g{H, WT + W_UPB, MROWS, 2 * DFF, DM}; GEMM_RUN(pg8::EpiSwiGLU, HID, DFF); }
        GRID_SYNC();
        { PHASE_BEGIN pg8::Gemm g{HID, WT + W_DNB, MROWS, DM, DFF}; GEMM_RUN(pg8::EpiResid, a.out, a.out, mod + (size_t)l * NB * NMOD + 2 * 3 * DM + 2 * DM, NMOD, 0.5f, DM); }
        GRID_SYNC();
    }
    { PHASE_BEGIN final_norm_phase(a, gw, ngw, lane); }
}

constexpr int LDS_BYTES = 147456;
extern "C" void kernel_launch(void* const* d_in, const int* in_sizes, int n_in, void* d_out, int out_size, void* d_ws, size_t ws_size, hipStream_t stream) {
    static int grid = 0;
    if (grid == 0) {
        if (n_in != 18 || ws_size < WS_END) { fprintf(stderr, "kernel_launch: unexpected n_in %d / ws_size %zu (need %zu)\n", n_in, ws_size, (size_t)WS_END); grid = -1; return; }
        int dev = 0, cus = 0, per_cu = 0;
        (void)hipGetDevice(&dev); (void)hipDeviceGetAttribute(&cus, hipDeviceAttributeMultiprocessorCount, dev);
        if (hipFuncSetAttribute((const void*)hybrid_fwd, hipFuncAttributeMaxDynamicSharedMemorySize, LDS_BYTES) != hipSuccess) { fprintf(stderr, "kernel_launch: hipFuncSetAttribute failed\n"); grid = -1; return; }
        if (hipOccupancyMaxActiveBlocksPerMultiprocessor(&per_cu, (const void*)hybrid_fwd, NTHR, LDS_BYTES) != hipSuccess || per_cu < 1) { fprintf(stderr, "kernel_launch: occupancy query says %d\n", per_cu); per_cu = 1; }
        (void)hipGetLastError();
        grid = cus * 1;
    }
    if (grid < 0) return;
    Args a{};
    for (int i = 0; i < 18; ++i) a.in[i] = (const float*)d_in[i];
    a.out = (float*)d_out; a.ws = (unsigned char*)d_ws;
    void* kargs[] = {&a};
    hipError_t e = hipLaunchCooperativeKernel((const void*)hybrid_fwd, dim3(grid), dim3(NTHR), kargs, LDS_BYTES, stream);
    if (e != hipSuccess) fprintf(stderr, "cooperative launch failed: %s (grid %d)\n", hipGetErrorString(e), grid);
}
```

```cpp
#define GATE_LOGITS 1
#include <hip/hip_runtime.h>
#include <hip/hip_cooperative_groups.h>
#include <cstdio>
#include <cstdint>
namespace cg = cooperative_groups;
#define USE_RSB 1
__device__ __forceinline__ int hw_lane() { int l = (int)__builtin_amdgcn_mbcnt_hi(~0u, __builtin_amdgcn_mbcnt_lo(~0u, 0u)); asm volatile("" : "+v"(l)); return l; }
namespace pg8 {
#define PG8_LAS __attribute__((address_space(3)))
typedef unsigned short bf16_t;
typedef short bf16x8 __attribute__((ext_vector_type(8)));
typedef float f32x4 __attribute__((ext_vector_type(4)));
typedef unsigned u32x4 __attribute__((ext_vector_type(4)));
constexpr int BM = 256, BK = 64, HALF = 128, HTB = HALF * BK * 2  , STAGE_BYTES = 8 * HTB, NXCD = 8, WGM = 8;

__host__ __device__ __forceinline__ int lds_byte(int r, int c) { const int st = (r >> 4) * 2 + (c >> 5), rr = r & 15, cc = c & 31, ob = rr * 64 + cc * 2; return st * 1024 + (ob ^ (((ob >> 9) & 1) << 5)); }
__host__ __device__ __forceinline__ void stage_rc(int b, int& R, int& C) { const int st = b / 1024, sb = b % 1024, swz = sb ^ (((sb >> 9) & 1) << 5); R = (st >> 1) * 16 + swz / 64; C = (st & 1) * 32 + (swz % 64) / 2; }
__host__ __device__ __forceinline__ int perm32(int rho) { const int n = rho >> 4, i = rho & 15; return 8 * (i >> 2) + 4 * n + (i & 3); }

struct Unit { int pm, pn, seg; };
struct Gemm { const bf16_t* A; const bf16_t* Bt; int M, N, K; const bf16_t* A2; const bf16_t* Bt2; const bf16_t* A3; const bf16_t* Bt3; const bf16_t* A4; const bf16_t* Bt4; };
__host__ __device__ __forceinline__ const bf16_t* seg_a(const Gemm& g, int sg) { return sg == 0 ? g.A : sg == 1 ? g.A2 : sg == 2 ? g.A3 : g.A4; }
__host__ __device__ __forceinline__ const bf16_t* seg_b(const Gemm& g, int sg) { return sg == 0 ? g.Bt : sg == 1 ? g.Bt2 : sg == 2 ? g.Bt3 : g.Bt4; }

struct StaticOrder {
    int nM, nN, nwg, G, c, rev;
    __host__ __device__ void init(int M, int N, int G_, int c_, int rev_ = 0) { nM = M / BM; nN = N / BM; nwg = nM * nN; G = G_; c = c_; rev = (rev_ && nwg % G_ == 0) ? 1 : 0; }
    __host__ __device__ bool next(int i, Unit& u) const {
        const long L = (long)(rev ? nwg / G - 1 - i : i) * G + c; if (L >= nwg || L < 0) return false;
        int wgid = (int)L; { const int q = nwg / NXCD, r = nwg % NXCD, xcd = wgid % NXCD, off = wgid / NXCD; wgid = (xcd < r ? xcd * (q + 1) : r * (q + 1) + (xcd - r) * q) + off; }
        const int nig = WGM * nN, gid = wgid / nig, fm = gid * WGM, gsz = (nM - fm) < WGM ? (nM - fm) : WGM;
        u.pm = fm + ((wgid % nig) % gsz); u.pn = (wgid % nig) / gsz; u.seg = 0; return true;
    }
    __device__ __forceinline__ void a_ready(const Unit&) const {}
    __device__ __forceinline__ void done(const Unit&) const {}
};
template <int LOG2SEG> struct SegOrderN {
    StaticOrder base;
    __host__ __device__ void init(int M, int N, int G_, int c_, int rev_ = 0) { base.init(M, N, G_, c_, rev_); }
    __host__ __device__ bool next(int i, Unit& u) const { const bool ok = base.next(i >> LOG2SEG, u); u.seg = i & ((1 << LOG2SEG) - 1); return ok; }
    __device__ __forceinline__ void a_ready(const Unit&) const {}
    __device__ __forceinline__ void done(const Unit&) const {}
};
template <class E, class = void> struct epi_seg { static constexpr bool value = false; };
template <class E> struct epi_seg<E, decltype((void)E::SEG)> { static constexpr bool value = E::SEG; };
template <class E> __host__ __device__ __forceinline__ bool epi_keep(int sg) { if constexpr (epi_seg<E>::value) return E::keep_acc(sg); else return false; }


__device__ __forceinline__ unsigned cvt_pk_bf16(float lo, float hi) { unsigned r; asm volatile("v_cvt_pk_bf16_f32 %0, %1, %2" : "=v"(r) : "v"(lo), "v"(hi)); return r; }
typedef float f32x2 __attribute__((ext_vector_type(2)));

__device__ __forceinline__ float sigmoid_f(float v) { return __builtin_amdgcn_rcpf(1.0f + __builtin_amdgcn_exp2f(-1.4426950408889634f * v)); }
__device__ __forceinline__ float bf_lo(unsigned w) { return __uint_as_float(w << 16); }
__device__ __forceinline__ float bf_hi(unsigned w) { return __uint_as_float(w & 0xffff0000u); }

struct EpiSwiGLU {
    static constexpr bool PERM = true, AFTER_DRAIN = false;
    bf16_t* O; int ldc;
    __device__ __forceinline__ void operator()(const f32x4 (&acc)[2][2][4][2], const Unit& u, int wr, int wc, int fr, int fq) const {
        const int row0 = u.pm * BM + wr * 64 + fr, col0 = u.pn * HALF + wc * 32 + 8 * fq;
#pragma unroll
        for (int ai = 0; ai < 2; ++ai)
#pragma unroll
            for (int m = 0; m < 4; ++m) {
                bf16_t* rowp = O + (size_t)(row0 + ai * HALF + m * 16) * ldc + col0;
                float v[8];
#pragma unroll
                for (int n = 0; n < 2; ++n)
#pragma unroll
                    for (int e = 0; e < 4; ++e) { const float a = acc[ai][0][m][n][e], b = acc[ai][1][m][n][e]; v[4 * n + e] = a * sigmoid_f(a) * b; }
                u32x4 w; w.x = cvt_pk_bf16(v[0], v[1]); w.y = cvt_pk_bf16(v[2], v[3]); w.z = cvt_pk_bf16(v[4], v[5]); w.w = cvt_pk_bf16(v[6], v[7]);
                *(u32x4*)rowp = w;
            }
    }
};
struct EpiResid {
    static constexpr bool PERM = false, AFTER_DRAIN = false;
    const float* base; float* out; const float* gate; int gate_bstride; float coef; int ldc;
    __device__ __forceinline__ void operator()(const f32x4 (&acc)[2][2][4][2], const Unit& u, int wr, int wc, int fr, int fq) const {
        const int col0 = u.pn * BM + wc * 32 + 4 * fq;
        const float* g = gate + (size_t)(u.pm >> 5) * gate_bstride;
        f32x4 gv[2][2];
#pragma unroll
        for (int bj = 0; bj < 2; ++bj)
#pragma unroll
            for (int n = 0; n < 2; ++n) gv[bj][n] = *(const f32x4*)(g + col0 + bj * HALF + n * 16) * coef;
#pragma unroll
        for (int ai = 0; ai < 2; ++ai)
#pragma unroll
            for (int m = 0; m < 4; ++m) { const size_t off = (size_t)(u.pm * BM + ai * HALF + wr * 64 + m * 16 + fr) * ldc + col0;
#pragma unroll
                for (int bj = 0; bj < 2; ++bj)
#pragma unroll
                    for (int n = 0; n < 2; ++n) { const f32x4 bs = *(const f32x4*)(base + off + bj * HALF + n * 16); *(f32x4*)(out + off + bj * HALF + n * 16) = bs + gv[bj][n] * acc[ai][bj][m][n]; } }
    }
};
#ifdef GATE_LOGITS
#define GSIG(x) sigmoid_f(x)
#else
#define GSIG(x) (x)
#endif
template <int MODE> struct EpiBf {
    static constexpr bool PERM = true, AFTER_DRAIN = false;
    bf16_t* O; int ldc; int split_cols; size_t split_stride; int qt; float qscale; const bf16_t* G;
    __device__ __forceinline__ void operator()(const f32x4 (&acc)[2][2][4][2], const Unit& u, int wr, int wc, int fr, int fq) const {
        const int row0 = u.pm * BM + wr * 64 + fr; int colt = u.pn * BM; bf16_t* base = O; float sc = 1.f;
        if (MODE <= 1) { const int t = colt / split_cols; base += (size_t)t * split_stride; colt -= t * split_cols; if (MODE == 0 && t == qt) sc = qscale; }
        const int col0 = colt + wc * 32 + 8 * fq;
#pragma unroll
        for (int ai = 0; ai < 2; ++ai)
#pragma unroll
            for (int m = 0; m < 4; ++m) { const size_t roff = (size_t)(row0 + ai * HALF + m * 16) * ldc + col0;
#pragma unroll
                for (int bj = 0; bj < 2; ++bj) {
                    f32x4 v0 = acc[ai][bj][m][0], v1 = acc[ai][bj][m][1];
                    if (MODE == 0) { v0 = v0 * sc; v1 = v1 * sc; }
                    if (MODE == 1) {
#pragma unroll
                        for (int e = 0; e < 4; ++e) { v0[e] = sigmoid_f(v0[e]); v1[e] = sigmoid_f(v1[e]); } }
                    if (MODE >= 2) { const u32x4 g = *(const u32x4*)(G + roff + bj * HALF);
                        v0[0] *= GSIG(bf_lo(g.x)); v0[1] *= GSIG(bf_hi(g.x)); v0[2] *= GSIG(bf_lo(g.y)); v0[3] *= GSIG(bf_hi(g.y)); v1[0] *= GSIG(bf_lo(g.z)); v1[1] *= GSIG(bf_hi(g.z)); v1[2] *= GSIG(bf_lo(g.w)); v1[3] *= GSIG(bf_hi(g.w)); }
                    if (MODE == 3) { const u32x4 t = *(const u32x4*)(base + roff + bj * HALF);
                        v0[0] += bf_lo(t.x); v0[1] += bf_hi(t.x); v0[2] += bf_lo(t.y); v0[3] += bf_hi(t.y); v1[0] += bf_lo(t.z); v1[1] += bf_hi(t.z); v1[2] += bf_lo(t.w); v1[3] += bf_hi(t.w); }
                    u32x4 w; w.x = cvt_pk_bf16(v0[0], v0[1]); w.y = cvt_pk_bf16(v0[2], v0[3]); w.z = cvt_pk_bf16(v1[0], v1[1]); w.w = cvt_pk_bf16(v1[2], v1[3]);
                    *(u32x4*)(base + roff + bj * HALF) = w; } }
    }
};
struct EpiMerge {
    static constexpr bool PERM = true, AFTER_DRAIN = false, SEG = true;
    __host__ __device__ static constexpr bool keep_acc(int sg) { return sg == 3; }
    bf16_t* O; int ldc; bf16_t* GR; bf16_t* GD;
    __device__ __forceinline__ void operator()(f32x4 (&acc)[2][2][4][2], const Unit& u, int wr, int wc, int fr, int fq) const {
        const int row0 = u.pm * BM + wr * 64 + fr, col0 = u.pn * BM + wc * 32 + 8 * fq;
#pragma unroll
        for (int ai = 0; ai < 2; ++ai)
#pragma unroll
            for (int m = 0; m < 4; ++m) { const size_t roff = (size_t)(row0 + ai * HALF + m * 16) * ldc + col0;
#pragma unroll
                for (int bj = 0; bj < 2; ++bj) {
                    if (u.seg < 2) {
                        float v[8];
#pragma unroll
                        for (int e = 0; e < 8; ++e) v[e] = __builtin_fmaxf(acc[ai][bj][m][e >> 2][e & 3], -3.0e38f);
                        u32x4 w; w.x = cvt_pk_bf16(v[0], v[1]); w.y = cvt_pk_bf16(v[2], v[3]); w.z = cvt_pk_bf16(v[4], v[5]); w.w = cvt_pk_bf16(v[6], v[7]);
                        *(u32x4*)((u.seg == 0 ? GR : GD) + roff + bj * HALF) = w;
                    } else {
                        const u32x4 gd = *(const u32x4*)(GD + roff + bj * HALF);
                        const float d[8] = {bf_lo(gd.x), bf_hi(gd.x), bf_lo(gd.y), bf_hi(gd.y), bf_lo(gd.z), bf_hi(gd.z), bf_lo(gd.w), bf_hi(gd.w)};
                        if (u.seg == 2) {
                            const u32x4 gr = *(const u32x4*)(GR + roff + bj * HALF);
                            const float r[8] = {bf_lo(gr.x), bf_hi(gr.x), bf_lo(gr.y), bf_hi(gr.y), bf_lo(gr.z), bf_hi(gr.z), bf_lo(gr.w), bf_hi(gr.w)};
#pragma unroll
                            for (int e = 0; e < 8; ++e) { const float ed = __builtin_amdgcn_exp2f(-1.4426950408889634f * d[e]), er = __builtin_amdgcn_exp2f(-1.4426950408889634f * r[e]);
                                acc[ai][bj][m][e >> 2][e & 3] *= (1.0f + ed) * __builtin_amdgcn_rcpf(1.0f + er); }
                        } else {
                            float v[8];
#pragma unroll
                            for (int e = 0; e < 8; ++e) v[e] = acc[ai][bj][m][e >> 2][e & 3] * sigmoid_f(d[e]);
                            u32x4 w; w.x = cvt_pk_bf16(v[0], v[1]); w.y = cvt_pk_bf16(v[2], v[3]); w.z = cvt_pk_bf16(v[4], v[5]); w.w = cvt_pk_bf16(v[6], v[7]);
                            *(u32x4*)(O + roff + bj * HALF) = w; }
                    }
                } }
    }
};


template <class Epi, class Sched, bool ALIGN_EPI = false, bool SP2 = false>
__device__ __forceinline__ void gemm_phase(PG8_LAS unsigned char* lds, const Gemm g, const Sched& S, const Epi& E, const int wave_s) {
    const int lane = hw_lane(), wid = wave_s, tid = wave_s * 64 + lane, wr = wid >> 2, wc = wid & 3, fr = lane & 15, fq = lane >> 4;
    const int K = g.K, nt = K / BK;
    unsigned voffA[2], voffB[2];
#pragma unroll
    for (int i = 0; i < 2; ++i) { int R, C; stage_rc(tid * 16 + i * 8192, R, C); const int Rb = Epi::PERM ? ((R & ~31) + perm32(R & 31)) : R;
        voffA[i] = (unsigned)(R * K + C) * 2u; voffB[i] = (unsigned)(Rb * K + C) * 2u; }
    const size_t kstep = (size_t)(BK * 2);
    const size_t hstep = (size_t)HALF * K * 2;
    const size_t tstep = 2 * hstep;
    const unsigned ldsw = (unsigned)wid * 1024u;
    const int aoff = lds_byte(wr * 64 + fr, fq * 8), boff = lds_byte(wc * 32 + fr, fq * 8);
#define PG8_SA(b, h) (((b) * 2 + (h)) * HTB)
#define PG8_SB(b, h) ((4 + (b) * 2 + (h)) * HTB)
#define PG8_STAGE(bufoff, gbase, voff) do { _Pragma("unroll") for (int _i = 0; _i < 2; ++_i) \
        __builtin_amdgcn_global_load_lds((const unsigned*)((const char*)(gbase) + (voff)[_i]), (PG8_LAS unsigned*)(lds + (bufoff) + ldsw + _i * 8192), 16, 0, 0); } while (0)
#define PG8_LDA(dst, b, h) do { _Pragma("unroll") for (int m = 0; m < 4; ++m) _Pragma("unroll") for (int k = 0; k < 2; ++k) dst[m][k] = *(const PG8_LAS bf16x8*)(lds + PG8_SA(b, h) + aoff + m * 2048 + k * 1024); } while (0)
#define PG8_LDB(dst, b, h) do { _Pragma("unroll") for (int n = 0; n < 2; ++n) _Pragma("unroll") for (int k = 0; k < 2; ++k) dst[n][k] = *(const PG8_LAS bf16x8*)(lds + PG8_SB(b, h) + boff + n * 2048 + k * 1024); } while (0)
#define PG8_MMA(ai, bj, At, Bt) do { __builtin_amdgcn_s_setprio(1); _Pragma("unroll") for (int m = 0; m < 4; ++m) _Pragma("unroll") for (int n = 0; n < 2; ++n) _Pragma("unroll") for (int k = 0; k < 2; ++k) \
        acc[ai][bj][m][n] = __builtin_amdgcn_mfma_f32_16x16x32_bf16(Bt[n][k], At[m][k], acc[ai][bj][m][n], 0, 0, 0); __builtin_amdgcn_s_setprio(0); } while (0)
#define PG8_WAIT_V(n) asm volatile("s_waitcnt vmcnt(" #n ")" ::: "memory")
#define PG8_WAIT_L(n) asm volatile("s_waitcnt lgkmcnt(" #n ")" ::: "memory")
#define PG8_BAR __builtin_amdgcn_s_barrier()
#define PG8_SCHED __builtin_amdgcn_sched_barrier(0)
    Unit cur, nxt; int ui = 0;
    if (!S.next(0, cur)) return;
    f32x4 acc[2][2][4][2];
#pragma unroll
    for (int a = 0; a < 2; ++a)
#pragma unroll
        for (int b = 0; b < 2; ++b)
#pragma unroll
            for (int m = 0; m < 4; ++m)
#pragma unroll
                for (int n = 0; n < 2; ++n) acc[a][b][m][n] = (f32x4){0.f, 0.f, 0.f, 0.f};
    bf16x8 At[4][2], B0[2][2], B1[2][2];
    const char* cA = (const char*)seg_a(g, cur.seg) + (size_t)cur.pm * tstep; const char* cB = (const char*)seg_b(g, cur.seg) + (size_t)cur.pn * tstep;
    S.a_ready(cur);
    if constexpr (SP2) {
        PG8_STAGE(PG8_SB(0, 0), cB, voffB); PG8_STAGE(PG8_SB(0, 1), cB + hstep, voffB); PG8_STAGE(PG8_SA(0, 0), cA, voffA); PG8_STAGE(PG8_SA(0, 1), cA + hstep, voffA);
        if (wr == 1) PG8_BAR;
        PG8_WAIT_V(2); PG8_BAR;
        PG8_STAGE(PG8_SB(1, 0), cB + kstep, voffB); PG8_STAGE(PG8_SA(1, 0), cA + kstep, voffA); PG8_STAGE(PG8_SB(1, 1), cB + hstep + kstep, voffB);
        PG8_WAIT_V(6); PG8_BAR;
    } else {
        PG8_STAGE(PG8_SB(0, 0), cB, voffB); PG8_STAGE(PG8_SA(0, 0), cA, voffA); PG8_STAGE(PG8_SB(0, 1), cB + hstep, voffB); PG8_STAGE(PG8_SA(0, 1), cA + hstep, voffA);
        if (wr == 1) PG8_BAR;
        PG8_WAIT_V(4); PG8_BAR;
        PG8_STAGE(PG8_SB(1, 0), cB + kstep, voffB); PG8_STAGE(PG8_SA(1, 0), cA + kstep, voffA); PG8_STAGE(PG8_SB(1, 1), cB + hstep + kstep, voffB);
        PG8_WAIT_V(6); PG8_BAR;
    }
    for (;;) {
        const bool has_next = S.next(ui + 1, nxt);
        const char* nA = has_next ? (const char*)seg_a(g, nxt.seg) + (size_t)nxt.pm * tstep : cA; const char* nB = has_next ? (const char*)seg_b(g, nxt.seg) + (size_t)nxt.pn * tstep : cB;
        for (int t = 0; t < nt; t += 2) {
            const bool last = (t == nt - 2);
            const char* a1 = cA + (size_t)(t + 1) * kstep;
            const char* a2 = last ? nA : cA + (size_t)(t + 2) * kstep; const char* b2 = last ? nB : cB + (size_t)(t + 2) * kstep;
            const char* a3 = a2 + kstep; const char* b3 = b2 + kstep;
            if (last && has_next) S.a_ready(nxt);
            if constexpr (SP2) {
            PG8_LDB(B0, 0, 0); PG8_LDB(B1, 0, 1); PG8_SCHED; PG8_LDA(At, 0, 0); PG8_STAGE(PG8_SA(1, 1), a1 + hstep, voffA);
            PG8_WAIT_V(8); PG8_WAIT_L(0); PG8_BAR; PG8_MMA(0, 0, At, B0); PG8_MMA(0, 1, At, B1); PG8_BAR; PG8_SCHED;
            PG8_LDA(At, 0, 1); PG8_STAGE(PG8_SB(0, 0), b2, voffB); PG8_STAGE(PG8_SB(0, 1), b2 + hstep, voffB); PG8_STAGE(PG8_SA(0, 0), a2, voffA);
            PG8_WAIT_V(8); PG8_WAIT_L(0); PG8_BAR; PG8_MMA(1, 0, At, B0); PG8_MMA(1, 1, At, B1); PG8_BAR; PG8_SCHED;
            PG8_LDB(B0, 1, 0); PG8_LDB(B1, 1, 1); PG8_SCHED; PG8_LDA(At, 1, 0); PG8_STAGE(PG8_SA(0, 1), a2 + hstep, voffA);
            PG8_WAIT_V(8); PG8_WAIT_L(0); PG8_BAR; PG8_MMA(0, 0, At, B0); PG8_MMA(0, 1, At, B1); PG8_BAR; PG8_SCHED;
            PG8_LDA(At, 1, 1); PG8_STAGE(PG8_SB(1, 0), b3, voffB); PG8_STAGE(PG8_SB(1, 1), b3 + hstep, voffB); PG8_STAGE(PG8_SA(1, 0), a3, voffA);
            PG8_WAIT_V(8); PG8_WAIT_L(0); PG8_BAR; PG8_MMA(1, 0, At, B0); PG8_MMA(1, 1, At, B1); PG8_BAR; PG8_SCHED;
            } else {
            PG8_LDB(B0, 0, 0); PG8_SCHED; PG8_LDA(At, 0, 0); PG8_STAGE(PG8_SA(1, 1), a1 + hstep, voffA);
            PG8_WAIT_L(8); PG8_BAR; PG8_WAIT_L(0); PG8_MMA(0, 0, At, B0); PG8_BAR; PG8_SCHED;
            PG8_LDB(B1, 0, 1); PG8_STAGE(PG8_SB(0, 0), b2, voffB);
            PG8_BAR; PG8_WAIT_L(0); PG8_MMA(0, 1, At, B1); PG8_BAR;
            PG8_LDA(At, 0, 1); PG8_STAGE(PG8_SA(0, 0), a2, voffA);
            PG8_BAR; PG8_WAIT_L(0); PG8_MMA(1, 0, At, B0); PG8_BAR; PG8_SCHED;
            PG8_STAGE(PG8_SB(0, 1), b2 + hstep, voffB);
            PG8_WAIT_V(6); PG8_BAR; PG8_MMA(1, 1, At, B1); PG8_BAR;
            PG8_LDB(B0, 1, 0); PG8_SCHED; PG8_LDA(At, 1, 0); PG8_STAGE(PG8_SA(0, 1), a2 + hstep, voffA);
            PG8_WAIT_L(8); PG8_BAR; PG8_WAIT_L(0); PG8_MMA(0, 0, At, B0); PG8_BAR; PG8_SCHED;
            PG8_LDB(B1, 1, 1); PG8_STAGE(PG8_SB(1, 0), b3, voffB);
            PG8_BAR; PG8_WAIT_L(0); PG8_MMA(0, 1, At, B1); PG8_BAR;
            PG8_LDA(At, 1, 1); PG8_STAGE(PG8_SA(1, 0), a3, voffA);
            PG8_BAR; PG8_WAIT_L(0); PG8_MMA(1, 0, At, B0); PG8_BAR; PG8_SCHED;
            PG8_STAGE(PG8_SB(1, 1), b3 + hstep, voffB);
            PG8_WAIT_V(6); PG8_BAR; PG8_MMA(1, 1, At, B1); PG8_BAR;
            }
        }
        if constexpr (ALIGN_EPI) { if (wr == 0) PG8_BAR; }
        if constexpr (!Epi::AFTER_DRAIN) { E(acc, cur, wr, wc, fr, fq); S.done(cur); }
        if (!has_next) break;
        if (!epi_keep<Epi>(nxt.seg)) {
#pragma unroll
        for (int a = 0; a < 2; ++a)
#pragma unroll
            for (int b = 0; b < 2; ++b)
#pragma unroll
                for (int m = 0; m < 4; ++m)
#pragma unroll
                    for (int n = 0; n < 2; ++n) acc[a][b][m][n] = (f32x4){0.f, 0.f, 0.f, 0.f};
        }
        cur = nxt; cA = nA; cB = nB; ++ui;
        if constexpr (ALIGN_EPI) { if (wr == 1) PG8_BAR; }
    }
    PG8_WAIT_V(0);
    if constexpr (!ALIGN_EPI) { if (wr == 0) PG8_BAR; }
    PG8_BAR;
    if constexpr (Epi::AFTER_DRAIN) { E.fused(acc, cur, wr, wc, fr, fq, lds, wid, lane); S.done(cur); }
#undef PG8_SA
#undef PG8_SB
#undef PG8_STAGE
#undef PG8_LDA
#undef PG8_LDB
#undef PG8_MMA
#undef PG8_WAIT_V
#undef PG8_WAIT_L
#undef PG8_BAR
#undef PG8_SCHED
}
}

#define LAS __attribute__((address_space(3)))
typedef unsigned short bf16;
typedef float f32x4 __attribute__((ext_vector_type(4)));
typedef float f32x16 __attribute__((ext_vector_type(16)));
typedef short bf16x8 __attribute__((ext_vector_type(8)));
typedef short s16x4 __attribute__((ext_vector_type(4)));
typedef unsigned u32x4 __attribute__((ext_vector_type(4)));
typedef unsigned u32x2 __attribute__((ext_vector_type(2)));

constexpr int DM = 1024, NB = 8, SEQ = 8192, DEPTH = 4, MROWS = NB * SEQ, DFF = 2816, INW = 8192, NMOD = 9 * DM;
constexpr int NWAVES = 8, NTHR = 512;
constexpr float NORM_EPS = 1e-6f, LOG2E = 1.4426950408889634f;
constexpr size_t MiB = 1u << 20;
constexpr size_t WS_CTL = 0;
constexpr size_t WS_MOD = 1 * MiB;
constexpr size_t WS_WT = 4 * MiB;
constexpr size_t W_UPA = 0, W_DNA = W_UPA + (size_t)2 * DFF * DM, W_UPB = W_DNA + (size_t)DM * DFF, W_DNB = W_UPB + (size_t)2 * DFF * DM,
                 W_IN = W_DNB + (size_t)DM * DFF, W_RET = W_IN + (size_t)INW * DM, W_DIF = W_RET + (size_t)DM * DM, W_OUT = W_DIF + (size_t)DM * DM, W_END = W_OUT + (size_t)DM * DM;
constexpr size_t WS_H = 64 * MiB;
constexpr size_t ACT = (size_t)MROWS * DM * 2;
constexpr size_t WS_B0 = 192 * MiB;
constexpr size_t WS_HID = WS_B0;
constexpr size_t WS_END = WS_B0 + 6 * ACT;
static_assert(WS_WT + W_END * 2 <= WS_H && WS_END <= 1024 * MiB, "d_ws map");

struct Args { const float* in[18]; float* out; unsigned char* ws; };

__device__ __forceinline__ float shx(float v, int m, int lane) { return __int_as_float(__builtin_amdgcn_ds_bpermute((lane ^ m) << 2, __float_as_int(v))); }
__device__ __forceinline__ float wave_sum(float v, int lane) {
#pragma unroll
    for (int o = 1; o < 64; o <<= 1) v += shx(v, o, lane);
    return v;
}
__device__ __forceinline__ unsigned f2bf(float f) { unsigned u = __float_as_uint(f); return (u + 0x7fffu + ((u >> 16) & 1u)) >> 16; }
__device__ __forceinline__ unsigned pk2(float lo, float hi) { return pg8::cvt_pk_bf16(lo, hi); }
typedef __bf16 bf16x2_cv __attribute__((ext_vector_type(2))); typedef float f32x2_cv __attribute__((ext_vector_type(2)));
__device__ __forceinline__ unsigned pk2v(float lo, float hi) { f32x2_cv v = {lo, hi}; bf16x2_cv b = __builtin_convertvector(v, bf16x2_cv); return __builtin_bit_cast(unsigned, b); }
__device__ __forceinline__ float bflo(unsigned w) { return __uint_as_float(w << 16); }
__device__ __forceinline__ float bfhi(unsigned w) { return __uint_as_float(w & 0xffff0000u); }
__device__ __forceinline__ float sgpr_f(float v) { return __int_as_float(__builtin_amdgcn_readfirstlane(__float_as_int(v))); }
__device__ __forceinline__ int launder(int v) { asm volatile("" : "+v"(v)); return v; }
#define LDS_WAIT() asm volatile("s_waitcnt lgkmcnt(0)" ::: "memory")
#define LDS_BARRIER() do { asm volatile("s_waitcnt lgkmcnt(0)" ::: "memory"); __builtin_amdgcn_s_barrier(); asm volatile("" ::: "memory"); } while (0)
#define MFMA32(a, b, c) __builtin_amdgcn_mfma_f32_32x32x16_bf16((a), (b), (c), 0, 0, 0)
__device__ __forceinline__ int crow(int r, int hi) { return (r & 3) + 8 * (r >> 2) + 4 * hi; }
typedef short v4i16_t __attribute__((ext_vector_type(4)));
__device__ __forceinline__ s16x4 tr_read(const LAS unsigned char* p) { return __builtin_bit_cast(s16x4, __builtin_amdgcn_ds_read_tr16_b64_v4i16((LAS v4i16_t*)p)); }
__device__ __forceinline__ bf16x8 cat8(s16x4 lo, s16x4 hi) { return (bf16x8){lo[0], lo[1], lo[2], lo[3], hi[0], hi[1], hi[2], hi[3]}; }
__device__ __forceinline__ bf16x8 pack8v(const f32x16& x, int s) {
    u32x4 p; p.x = pk2v(x[8 * s], x[8 * s + 1]); p.y = pk2v(x[8 * s + 2], x[8 * s + 3]); p.z = pk2v(x[8 * s + 4], x[8 * s + 5]); p.w = pk2v(x[8 * s + 6], x[8 * s + 7]);
    return __builtin_bit_cast(bf16x8, p);
}
__device__ __forceinline__ bf16x8 pack8(const f32x16& x, int s) {
    u32x4 p; p.x = pk2(x[8 * s], x[8 * s + 1]); p.y = pk2(x[8 * s + 2], x[8 * s + 3]); p.z = pk2(x[8 * s + 4], x[8 * s + 5]); p.w = pk2(x[8 * s + 6], x[8 * s + 7]);
    return __builtin_bit_cast(bf16x8, p);
}

template <bool UPPERM>
__device__ __forceinline__ void transpose_item(const float* W, int K, int N, bf16* WT, LAS float* scr, int item, int lane) {
    const int nblk = N / 32, kb = item / nblk, nb = item % nblk, k0 = 64 * kb, n0 = 32 * nb;
#pragma unroll 8
    for (int i = 0; i < 32; ++i) { const int kk = 2 * i + (lane >> 5); scr[kk * 33 + (lane & 31)] = W[(size_t)(k0 + kk) * N + n0 + (lane & 31)]; }
    LDS_WAIT(); asm volatile("" ::: "memory");
    int d0 = n0;
    if (UPPERM) { const int half = n0 / DFF, j = n0 % DFF; d0 = (j / 128) * 256 + half * 128 + (j % 128); }
    const int c = lane & 7;
#pragma unroll
    for (int j = 0; j < 4; ++j) { const int n = (lane >> 3) + 8 * j; const LAS float* s = scr + (8 * c) * 33 + n;
        u32x4 o; o.x = pk2(s[0 * 33], s[1 * 33]); o.y = pk2(s[2 * 33], s[3 * 33]); o.z = pk2(s[4 * 33], s[5 * 33]); o.w = pk2(s[6 * 33], s[7 * 33]);
        *(u32x4*)(WT + (size_t)(d0 + n) * K + k0 + 8 * c) = o; }
    LDS_WAIT(); asm volatile("" ::: "memory");
}
__device__ __forceinline__ void convert_weights(const Args& a, int l, LAS unsigned char* lds, int gw, int ngw, int wave, int lane) {
    lane = launder(lane);
    LAS float* scr = (LAS float*)(lds + wave * 16384);
    bf16* WT = (bf16*)(a.ws + WS_WT);
    const float* up = a.in[5] + (size_t)l * 2 * DM * 2 * DFF; const float* dn = a.in[6] + (size_t)l * 2 * DFF * DM;
    const float* win = a.in[7] + (size_t)l * DM * INW; const float* wr = a.in[14] + (size_t)l * DM * DM; const float* wd = a.in[15] + (size_t)l * DM * DM; const float* wo = a.in[16] + (size_t)l * DM * DM;
    constexpr int I_UP = (DM / 64) * (2 * DFF / 32), I_DN = (DFF / 64) * (DM / 32), I_IN = (DM / 64) * (INW / 32), I_SQ = (DM / 64) * (DM / 32);
    constexpr int NITEMS = 2 * I_UP + 2 * I_DN + I_IN + 3 * I_SQ;
    for (int it = gw; it < NITEMS; it += ngw) {
        int r = it;
        if (r < I_UP) { transpose_item<true>(up, DM, 2 * DFF, WT + W_UPA, scr, r, lane); continue; } r -= I_UP;
        if (r < I_UP) { transpose_item<true>(up + (size_t)DM * 2 * DFF, DM, 2 * DFF, WT + W_UPB, scr, r, lane); continue; } r -= I_UP;
        if (r < I_DN) { transpose_item<false>(dn, DFF, DM, WT + W_DNA, scr, r, lane); continue; } r -= I_DN;
        if (r < I_DN) { transpose_item<false>(dn + (size_t)DFF * DM, DFF, DM, WT + W_DNB, scr, r, lane); continue; } r -= I_DN;
        if (r < I_IN) { transpose_item<false>(win, DM, INW, WT + W_IN, scr, r, lane); continue; } r -= I_IN;
        if (r < I_SQ) { transpose_item<false>(wr, DM, DM, WT + W_RET, scr, r, lane); continue; } r -= I_SQ;
        if (r < I_SQ) { transpose_item<false>(wd, DM, DM, WT + W_DIF, scr, r, lane); continue; } r -= I_SQ;
        transpose_item<false>(wo, DM, DM, WT + W_OUT, scr, r, lane);
    }
}
__device__ __forceinline__ void ada_phase(const Args& a, LAS unsigned char* lds, int wave, int lane) {
    lane = launder(lane);
    LAS float* sc = (LAS float*)lds; LAS float* part = (LAS float*)(lds + 32768);
    const float* c = a.in[1];
    for (int i = wave * 64 + lane; i < NB * DM; i += NTHR) { const float v = c[i]; sc[i] = v * pg8::sigmoid_f(v); }
    __syncthreads();
    float* mod = (float*)(a.ws + WS_MOD);
    constexpr int NIT = DEPTH * (NMOD / 64);
    for (int it = blockIdx.x; it < NIT; it += gridDim.x) {
        const int l = it / (NMOD / 64), j = (it % (NMOD / 64)) * 64 + lane;
        const float* w = a.in[2] + (size_t)l * DM * NMOD + j;
        float acc[NB];
#pragma unroll
        for (int b = 0; b < NB; ++b) acc[b] = 0.f;
        const int k0 = wave * 128;
#pragma unroll 8
        for (int k = 0; k < 128; ++k) { const float wv = w[(size_t)(k0 + k) * NMOD];
#pragma unroll
            for (int b = 0; b < NB; ++b) acc[b] += sc[b * DM + k0 + k] * wv; }
#pragma unroll
        for (int b = 0; b < NB; ++b) part[(wave * NB + b) * 64 + lane] = acc[b];
        __syncthreads();
        { const int b = wave; float s = a.in[3][(size_t)l * NMOD + j];
#pragma unroll
            for (int w8 = 0; w8 < 8; ++w8) s += part[(w8 * NB + b) * 64 + lane];
            mod[((size_t)l * NB + b) * NMOD + j] = s; }
        __syncthreads();
    }
}
template <int NR>
__device__ __forceinline__ void norm_mod_rows(const float* x, bf16* Hout, const float* const* mbp, const float* nw, const int* rows, int lane) {
    f32x4 v[NR][4]; float ss[NR];
#pragma unroll
    for (int r = 0; r < NR; ++r) { const f32x4* xr = (const f32x4*)(x + (size_t)rows[r] * DM) + lane;
#pragma unroll
        for (int j = 0; j < 4; ++j) v[r][j] = __builtin_nontemporal_load(xr + 64 * j); }
#pragma unroll
    for (int r = 0; r < NR; ++r) { float s = 0.f;
#pragma unroll
        for (int j = 0; j < 4; ++j) s += (v[r][j].x * v[r][j].x + v[r][j].y * v[r][j].y) + (v[r][j].z * v[r][j].z + v[r][j].w * v[r][j].w);
        ss[r] = s; }
#pragma unroll
    for (int o = 1; o < 64; o <<= 1)
#pragma unroll
        for (int r = 0; r < NR; ++r) ss[r] += shx(ss[r], o, lane);
#pragma unroll
    for (int r = 0; r < NR; ++r) { const float rstd = 1.0f / sqrtf(ss[r] * (1.f / DM) + NORM_EPS); const float* shift = mbp[r]; const float* scale = mbp[r] + DM;
        u32x2* o8 = (u32x2*)(Hout + (size_t)rows[r] * DM) + lane;
#pragma unroll
        for (int j = 0; j < 4; ++j) { const int c4 = lane + 64 * j; const f32x4 w = ((const f32x4*)nw)[c4], sc = ((const f32x4*)scale)[c4], sh = ((const f32x4*)shift)[c4];
            const f32x4 o = v[r][j] * rstd * w * (sc + 1.0f) + sh; u32x2 p; p.x = pk2(o.x, o.y); p.y = pk2(o.z, o.w); o8[64 * j] = p; } }
}
__device__ __forceinline__ void norm_phase(const Args& a, const float* x, int l, int sub, int gw, int ngw, int lane, int rev) {
    lane = launder(lane);
    bf16* H = (bf16*)(a.ws + WS_H); const float* mod = (const float*)(a.ws + WS_MOD); const float* nw = a.in[4] + ((size_t)l * 3 + sub) * DM;
    constexpr int NR = 4;
    const int G = ngw / NWAVES, blk = gw / NWAVES, wv = gw % NWAVES;
    if (G >= 8 && (G & 7) == 0) {
        const int b = blk & 7, stride = (G >> 3) * NWAVES, ws0 = (blk >> 3) * NWAVES + wv, niter = (SEQ + NR * stride - 1) / (NR * stride);
        for (int kk = 0; kk < niter; ++kk) { const int k = rev ? niter - 1 - kk : kk; const int idx = ws0 + k * NR * stride; if (idx >= SEQ) continue; int rows[NR]; const float* mbp[NR];
#pragma unroll
            for (int r = 0; r < NR; ++r) { const int ir = idx + r * stride; rows[r] = b * SEQ + (ir < SEQ ? ir : idx); mbp[r] = mod + ((size_t)l * NB + b) * NMOD + sub * 3 * DM; }
            norm_mod_rows<NR>(x, H, mbp, nw, rows, lane); }
    } else {
    for (int m = gw; m < MROWS; m += NR * ngw) { int rows[NR]; const float* mbp[NR];
#pragma unroll
        for (int r = 0; r < NR; ++r) { rows[r] = m + r * ngw; if (rows[r] >= MROWS) rows[r] = m; mbp[r] = mod + ((size_t)l * NB + (rows[r] >> 13)) * NMOD + sub * 3 * DM; }
        norm_mod_rows<NR>(x, H, mbp, nw, rows, lane); }
    }
}
__device__ __forceinline__ void final_norm_phase(const Args& a, int gw, int ngw, int lane) {
    lane = launder(lane);
    const float* fw = a.in[17];
#ifdef DBG_CHECK
    const float dbgs = 1.0f + (float)((const unsigned*)(a.ws + WS_CTL))[32];
#else
    const float dbgs = 1.0f;
#endif
    for (int m = gw; m < MROWS; m += ngw) { f32x4* xr = (f32x4*)(a.out + (size_t)m * DM) + lane;
        f32x4 v[4]; float s = 0.f;
#pragma unroll
        for (int j = 0; j < 4; ++j) { v[j] = xr[64 * j]; s += (v[j].x * v[j].x + v[j].y * v[j].y) + (v[j].z * v[j].z + v[j].w * v[j].w); }
        const float rstd = 1.0f / sqrtf(wave_sum(s, lane) * (1.f / DM) + NORM_EPS);
#pragma unroll
        for (int j = 0; j < 4; ++j) xr[64 * j] = v[j] * (rstd * dbgs) * ((const f32x4*)fw)[lane + 64 * j]; }
}

constexpr int R_Q = 0, R_K = R_Q + 64 * 272, R_QD = R_K + 64 * 272, R_KD = R_QD + 64 * 272, R_SC = R_KD + 64 * 320, R_V = R_SC + 64 * 144, R_DEC = R_V + 64 * 576, R_END = R_DEC + 256;
static_assert(R_END <= 131072 && 64 * 1040 <= R_DEC, "retention LDS");
__device__ __forceinline__ void retention_unit(const Args& a, int l, int b, int h, LAS unsigned char* lds, const int wave_s, const bool dummy = false) {
    asm volatile("" : "+s"(h));
    const int lane = hw_lane(), wave = wave_s, tid = wave_s * 64 + lane, r32 = lane & 31, hh = lane >> 5;
    const int q4 = (lane & 15) >> 2, p4 = lane & 3, g1 = (lane >> 4) & 1;
    const bf16* RQK = (const bf16*)(a.ws + WS_B0); const bf16* RV = (const bf16*)(a.ws + WS_B0 + ACT); bf16* RG = (bf16*)(a.ws + WS_B0 + 2 * ACT);
    const float* gn = a.in[8] + (size_t)l * DM + h * 256;
    const float lg = sgpr_f(log2f(1.0f - exp2f(-5.0f - (float)h)));
    const float sc_qk = 0.08838834764831845f;
    const float cdec = sgpr_f(exp2f(lg * 64.f));
    const size_t row0 = (size_t)b * SEQ;
    f32x16 S[4];
#pragma unroll
    for (int i = 0; i < 4; ++i) S[i] = f32x16{};
    u32x4 pq[2], pk[2], pv[4]; u32x2 prg[8];
    const int er = tid >> 3, es = tid & 7;
#ifdef USE_RSB
#define RSB() __builtin_amdgcn_sched_barrier(0)
#else
#define RSB() do {} while (0)
#endif
#define R_PREFETCH(ci) do { const size_t t0 = row0 + (size_t)(ci) * 64; \
        _Pragma("unroll") for (int i = 0; i < 2; ++i) { const int idx = tid + 512 * i, rr = idx >> 4, ch = idx & 15; \
            pq[i] = *(const u32x4*)(RQK + (t0 + rr) * DM + h * 128 + ch * 8); pk[i] = *(const u32x4*)(RQK + (t0 + rr) * DM + 512 + h * 128 + ch * 8); } \
        _Pragma("unroll") for (int i = 0; i < 4; ++i) { const int idx = tid + 512 * i, rr = idx >> 5, ch = idx & 31; pv[i] = *(const u32x4*)(RV + (t0 + rr) * DM + h * 256 + ch * 8); } } while (0)
#define R_STORE() do { \
        _Pragma("unroll") for (int i = 0; i < 2; ++i) { const int idx = tid + 512 * i, rr = idx >> 4, ch = idx & 15; \
            *(LAS u32x4*)(lds + R_Q + rr * 272 + ch * 16) = pq[i]; *(LAS u32x4*)(lds + R_K + rr * 272 + ch * 16) = pk[i]; \
            const float fqd = exp2f(lg * (float)rr); u32x4 qd; \
            qd.x = pk2(bflo(pq[i].x) * fqd, bfhi(pq[i].x) * fqd); qd.y = pk2(bflo(pq[i].y) * fqd, bfhi(pq[i].y) * fqd); qd.z = pk2(bflo(pq[i].z) * fqd, bfhi(pq[i].z) * fqd); qd.w = pk2(bflo(pq[i].w) * fqd, bfhi(pq[i].w) * fqd); \
            *(LAS u32x4*)(lds + R_QD + rr * 272 + ch * 16) = qd; \
            const float f = sc_qk * exp2f(lg * (float)(64 - rr)); u32x4 kd; \
            kd.x = pk2(bflo(pk[i].x) * f, bfhi(pk[i].x) * f); kd.y = pk2(bflo(pk[i].y) * f, bfhi(pk[i].y) * f); kd.z = pk2(bflo(pk[i].z) * f, bfhi(pk[i].z) * f); kd.w = pk2(bflo(pk[i].w) * f, bfhi(pk[i].w) * f); \
            *(LAS u32x4*)(lds + R_KD + rr * 320 + ch * 16) = kd; } \
        _Pragma("unroll") for (int i = 0; i < 4; ++i) { const int idx = tid + 512 * i, rr = idx >> 5, ch = idx & 31; *(LAS u32x4*)(lds + R_V + rr * 576 + ch * 16) = pv[i]; } } while (0)
    R_PREFETCH(0);
    if (tid < 64) *(LAS float*)(lds + R_DEC + tid * 4) = sc_qk * exp2f(lg * (float)tid);
    R_STORE();
    LDS_BARRIER();
    for (int ci = 0; ci < SEQ / 64; ++ci) {
        const size_t t0 = row0 + (size_t)ci * 64;
        float lgl = lg;
#ifdef LGL
        asm volatile("" : "+v"(lgl));
#endif
        if (ci + 1 < SEQ / 64) R_PREFETCH(ci + 1);
#ifndef RG_LATE
#pragma unroll
        for (int j = 0; j < 8; ++j) prg[j] = *(const u32x2*)(RG + (t0 + er) * DM + h * 256 + 4 * (es + 8 * j));
#endif
        RSB();
        if (wave < 4) {
            const int qb = wave >> 1, kb = wave & 1; f32x16 x = f32x16{};
#pragma unroll
            for (int ks = 0; ks < 8; ++ks) { const bf16x8 af = *(const LAS bf16x8*)(lds + R_Q + (32 * qb + r32) * 272 + (16 * ks + 8 * hh) * 2);
                const bf16x8 bfr = *(const LAS bf16x8*)(lds + R_K + (32 * kb + r32) * 272 + (16 * ks + 8 * hh) * 2); x = MFMA32(af, bfr, x); }
#pragma unroll
            for (int i = 0; i < 16; ++i) { const int q = 32 * qb + crow(i, hh), k = 32 * kb + r32; const int d = q > k ? q - k : k - q;
                const float v = x[i] * *(const LAS float*)(lds + R_DEC + d * 4); *(LAS unsigned short*)(lds + R_SC + q * 144 + k * 2) = (unsigned short)f2bf(v); }
        }
        RSB();
        f32x16 y[2]; y[0] = f32x16{}; y[1] = f32x16{};
#pragma unroll
        for (int dkb = 0; dkb < 4; ++dkb)
#pragma unroll
            for (int s = 0; s < 2; ++s) { const bf16x8 sp = pack8(S[dkb], s);
#pragma unroll
                for (int qb = 0; qb < 2; ++qb) { const LAS unsigned char* qp = lds + R_QD + (32 * qb + r32) * 272 + (32 * dkb + 16 * s + 4 * hh) * 2;
                    const s16x4 lo = *(const LAS s16x4*)qp, hi = *(const LAS s16x4*)(qp + 16); y[qb] = MFMA32(cat8(lo, hi), sp, y[qb]); } }
        RSB();
        LDS_BARRIER();
        bf16x8 vf[4];
#pragma unroll
        for (int ks = 0; ks < 4; ++ks) { const LAS unsigned char* vp = lds + R_V + (16 * ks + 8 * hh + q4) * 576 + (32 * wave + 16 * g1) * 2 + 8 * p4; vf[ks] = cat8(tr_read(vp), tr_read(vp + 4 * 576)); }
#pragma unroll
        for (int ks = 0; ks < 4; ++ks)
#pragma unroll
            for (int qb = 0; qb < 2; ++qb) { const bf16x8 af = *(const LAS bf16x8*)(lds + R_SC + (32 * qb + r32) * 144 + (16 * ks + 8 * hh) * 2); y[qb] = MFMA32(af, vf[ks], y[qb]); }
        RSB();
#pragma unroll
        for (int dkb = 0; dkb < 4; ++dkb) {
#pragma unroll
            for (int i = 0; i < 16; ++i) S[dkb][i] *= cdec;
#pragma unroll
            for (int ks = 0; ks < 4; ++ks) { const LAS unsigned char* kp = lds + R_KD + (16 * ks + 8 * hh + q4) * 320 + (32 * dkb + 16 * g1) * 2 + 8 * p4;
                S[dkb] = MFMA32(cat8(tr_read(kp), tr_read(kp + 4 * 320)), vf[ks], S[dkb]); } }
        LDS_BARRIER();
#ifdef RG_LATE
#pragma unroll
        for (int j = 0; j < 8; ++j) prg[j] = *(const u32x2*)(RG + (t0 + er) * DM + h * 256 + 4 * (es + 8 * j));
#endif
#pragma unroll
        for (int qb = 0; qb < 2; ++qb)
#pragma unroll
            for (int i = 0; i < 16; ++i) *(LAS float*)(lds + (32 * qb + crow(i, hh)) * 1040 + (32 * wave + r32) * 4) = y[qb][i];
        LDS_BARRIER();
        { f32x4 yv[8]; float ss = 0.f;
#pragma unroll
            for (int j = 0; j < 8; ++j) { yv[j] = *(const LAS f32x4*)(lds + er * 1040 + 16 * (es + 8 * j)); ss += (yv[j].x * yv[j].x + yv[j].y * yv[j].y) + (yv[j].z * yv[j].z + yv[j].w * yv[j].w); }
            ss += shx(ss, 1, lane); ss += shx(ss, 2, lane); ss += shx(ss, 4, lane);
            const float rstd = 1.0f / sqrtf(ss * (1.f / 256.f) + NORM_EPS);
#pragma unroll
            for (int j = 0; j < 8; ++j) { const int c = 4 * (es + 8 * j); const f32x4 w = *(const f32x4*)(gn + c);
                const float g0 = bflo(prg[j].x), g1v = bfhi(prg[j].x), g2 = bflo(prg[j].y), g3 = bfhi(prg[j].y);
                u32x2 o; o.x = pk2(yv[j].x * rstd * w.x * g0 * pg8::sigmoid_f(g0), yv[j].y * rstd * w.y * g1v * pg8::sigmoid_f(g1v));
                o.y = pk2(yv[j].z * rstd * w.z * g2 * pg8::sigmoid_f(g2), yv[j].w * rstd * w.w * g3 * pg8::sigmoid_f(g3));
                if (!dummy || rstd == -12345.f) *(u32x2*)(RG + (t0 + er) * DM + h * 256 + c) = o; } }
        LDS_BARRIER();
        if (ci + 1 < SEQ / 64) R_STORE();
        LDS_BARRIER();
    }
#undef R_PREFETCH
#undef R_STORE
}

constexpr int A_KS = 272, A_VS = 320, A_KB = 64 * A_KS, A_VB = 64 * A_VS, A_BUF = A_KB + A_VB, A_X = 0;
static_assert(2 * A_BUF <= 131072 && 4 * 64 * 64 * 4 <= 131072, "attention LDS");
__device__ __forceinline__ void attn_unit(const Args& a, int l, int b, int h, int qb, float lam, float post, LAS unsigned char* lds, const int wave_s, const bool dummy = false) {
    asm volatile("" : "+s"(h));
    const int lane = hw_lane(), wave = wave_s, tid = wave_s * 64 + lane, r32 = lane & 31, hh = lane >> 5;
    const int q4 = (lane & 15) >> 2, p4 = lane & 3, g1 = (lane >> 4) & 1;
    const int sub = wave >> 2, wq = wave & 3;
    bf16* DQ = (bf16*)(a.ws + WS_B0 + 3 * ACT); const bf16* DK = (const bf16*)(a.ws + WS_B0 + 4 * ACT); const bf16* DV = (const bf16*)(a.ws + WS_B0 + 5 * ACT);
    const size_t row0 = (size_t)b * SEQ; const int q0 = qb * 128;
    const int NT = 2 * qb + 2;
    const float sl2 = sgpr_f(exp2f(-(float)(h + 1)) * LOG2E);
    bf16x8 qf[4];
    { const bf16* qp = DQ + (row0 + q0 + 32 * wq + r32) * DM + h * 128 + sub * 64 + 8 * hh;
#pragma unroll
        for (int ks = 0; ks < 4; ++ks) qf[ks] = *(const bf16x8*)(qp + 16 * ks); }
    u32x4 pk[2], pv[2];
#define A_PREFETCH(t) do { const size_t t0 = row0 + (size_t)(t) * 64; \
        _Pragma("unroll") for (int i = 0; i < 2; ++i) { const int idx = tid + 512 * i, rr = idx >> 4, ch = idx & 15; \
            pk[i] = *(const u32x4*)(DK + (t0 + rr) * DM + h * 128 + ch * 8); pv[i] = *(const u32x4*)(DV + (t0 + rr) * DM + h * 128 + ch * 8); } } while (0)
#define A_STORE(bufo) do { \
        _Pragma("unroll") for (int i = 0; i < 2; ++i) { const int idx = tid + 512 * i, rr = idx >> 4, ch = idx & 15; \
            *(LAS u32x4*)(lds + (bufo) + rr * A_KS + ch * 16) = pk[i]; *(LAS u32x4*)(lds + (bufo) + A_KB + rr * A_VS + ch * 16) = pv[i]; } } while (0)
    f32x16 o[4];
#pragma unroll
    for (int i = 0; i < 4; ++i) o[i] = f32x16{};
    float mrun = -1e30f, lrun = 0.f;
    f32x16 cb;
#pragma unroll
    for (int i = 0; i < 16; ++i) cb[i] = sl2 * (float)((i & 3) + 8 * (i >> 2) + 4 * hh);
    const float c32 = sgpr_f(32.f * sl2);
    const int tq = NT - 2 + (wq >> 1);
    const float qin = (float)(32 * (wq & 1) + r32), qs = sl2 * qin;
    const int tmin = max(0, (int)ceilf((128.f * (float)qb - 63.f - 220.f / sl2) * (1.f / 64.f)));
    A_PREFETCH(NT - 1);
    A_STORE(0);
    LDS_BARRIER();
    for (int it = 0; it < NT - tmin; ++it) {
        const int t = NT - 1 - it, bufo = (it & 1) * A_BUF;
        if (t > tmin) A_PREFETCH(t - 1);
        if (t <= tq) {
            f32x16 s[2];
            s[0] = cb;
#pragma unroll
            for (int i = 0; i < 16; ++i) s[1][i] = cb[i] + c32;
#pragma unroll
            for (int kb = 0; kb < 2; ++kb)
#pragma unroll
                for (int ks = 0; ks < 4; ++ks) { const bf16x8 kf = *(const LAS bf16x8*)(lds + bufo + (32 * kb + r32) * A_KS + (sub * 64 + 16 * ks + 8 * hh) * 2); s[kb] = MFMA32(kf, qf[ks], s[kb]); }
            float ut = -sl2 * (qin + 64.f * (float)(tq - t));
            if (t == tq) {
                ut = 0.f;
#pragma unroll
                for (int i = 0; i < 16; ++i) { const float c0 = cb[i], c1 = cb[i] + c32; s[0][i] = s[0][i] - c0 - fabsf(qs - c0); s[1][i] = s[1][i] - c1 - fabsf(qs - c1); }
            }
            float mt = fmaxf(s[0][0], s[1][0]);
#pragma unroll
            for (int i = 1; i < 16; ++i) mt = fmaxf(fmaxf(mt, s[0][i]), s[1][i]);
            mt = fmaxf(mt, shx(mt, 32, lane)) + ut;
            if (__any(mt > mrun)) {
                const float mnew = fmaxf(mrun, mt), alpha = __builtin_amdgcn_exp2f(mrun - mnew); mrun = mnew; lrun *= alpha;
#pragma unroll
                for (int d4 = 0; d4 < 4; ++d4)
#pragma unroll
                    for (int i = 0; i < 16; ++i) o[d4][i] *= alpha;
            }
            const float ml = mrun - ut;
            float ps = 0.f;
#pragma unroll
            for (int kb = 0; kb < 2; ++kb)
#pragma unroll
                for (int i = 0; i < 16; ++i) { s[kb][i] = __builtin_amdgcn_exp2f(s[kb][i] - ml); ps += s[kb][i]; }
            lrun += ps;
            __builtin_amdgcn_sched_barrier(0);
            {
                const LAS unsigned char* vbase = lds + bufo + A_KB + (4 * hh + q4) * A_VS + (16 * g1) * 2 + 8 * p4;
                bf16x8 vcur[4], vnxt[4];
#pragma unroll
                for (int d4 = 0; d4 < 4; ++d4) vcur[d4] = cat8(tr_read(vbase + 64 * d4), tr_read(vbase + 64 * d4 + 8 * A_VS));
#pragma unroll
                for (int g = 0; g < 4; ++g) {
                    if (g < 3) {
#pragma unroll
                        for (int d4 = 0; d4 < 4; ++d4) vnxt[d4] = cat8(tr_read(vbase + (g + 1) * 16 * A_VS + 64 * d4), tr_read(vbase + (g + 1) * 16 * A_VS + 64 * d4 + 8 * A_VS)); }
                    const bf16x8 pf = pack8v(s[g >> 1], g & 1);
#pragma unroll
                    for (int d4 = 0; d4 < 4; ++d4) o[d4] = MFMA32(vcur[d4], pf, o[d4]);
                    __builtin_amdgcn_sched_barrier(0);
#pragma unroll
                    for (int d4 = 0; d4 < 4; ++d4) vcur[d4] = vnxt[d4];
                }
            }
        }
        if (t > tmin) A_STORE(((it + 1) & 1) * A_BUF);
        LDS_BARRIER();
    }
    lrun += shx(lrun, 32, lane);
    const float rl = 1.0f / lrun;
    if (sub == 1) {
#pragma unroll
        for (int d4 = 0; d4 < 4; ++d4)
#pragma unroll
            for (int i = 0; i < 16; ++i) *(LAS float*)(lds + A_X + ((wq * 64 + d4 * 16 + i) * 64 + lane) * 4) = o[d4][i] * rl;
    }
    __syncthreads();
    if (sub == 0) {
        float ss = 0.f;
#pragma unroll
        for (int d4 = 0; d4 < 4; ++d4)
#pragma unroll
            for (int i = 0; i < 16; ++i) { const float v = o[d4][i] * rl - lam * *(const LAS float*)(lds + A_X + ((wq * 64 + d4 * 16 + i) * 64 + lane) * 4); o[d4][i] = v; ss += v * v; }
        ss += shx(ss, 32, lane);
        const float rstd = post / sqrtf(ss * (1.f / 128.f) + NORM_EPS);
        const float* sw = a.in[13] + (size_t)l * 128;
        bf16* op = DQ + (row0 + q0 + 32 * wq + r32) * DM + h * 128;
#pragma unroll
        for (int d4 = 0; d4 < 4; ++d4)
#pragma unroll
            for (int g = 0; g < 4; ++g) { const int dv = 32 * d4 + 8 * g + 4 * hh; const f32x4 w = *(const f32x4*)(sw + dv);
                u32x2 pkd; pkd.x = pk2(o[d4][4 * g] * rstd * w.x, o[d4][4 * g + 1] * rstd * w.y); pkd.y = pk2(o[d4][4 * g + 2] * rstd * w.z, o[d4][4 * g + 3] * rstd * w.w);
                if (!dummy || rstd == -12345.f) *(u32x2*)(op + dv) = pkd; }
    }
    __syncthreads();
#undef A_PREFETCH
#undef A_STORE
}


#define XB_TMO      128
#define XB_XCNT(j)  (256  + 64 * (j))
#define XB_XSUB(j)  (1280 + 64 * (j))
#define XB_XGEN(j)  (2304 + 64 * (j))
#define XB_TOP      3328
#define XB_TOPGEN   3392
#define XCD_BAR_WORDS 3456
#define XB_SPIN_CAP (1u << 24)

__device__ __forceinline__ unsigned xb_ld(unsigned* p)              { return __hip_atomic_load(p, __ATOMIC_RELAXED, __HIP_MEMORY_SCOPE_AGENT); }
__device__ __forceinline__ unsigned xb_add(unsigned* p, unsigned v) { return __hip_atomic_fetch_add(p, v, __ATOMIC_RELAXED, __HIP_MEMORY_SCOPE_AGENT); }
__device__ __forceinline__ unsigned xb_xcc_id() { return (unsigned)__builtin_amdgcn_s_getreg((3 << 11) | 20) & 0xFu; }
#define XB_SPIN(cond, bar) do { unsigned _sp = 0; while (cond) { __builtin_amdgcn_s_sleep(1); \
    if ((++_sp & 255u) == 0u) { if (xb_ld(&(bar)[XB_TMO])) break; if (_sp > XB_SPIN_CAP) { atomicAdd(&(bar)[XB_TMO], 1u); break; } } } } while (0)

struct XcdBarrier {
    unsigned* bar; unsigned x;
    volatile LAS unsigned* st;
};

__device__ __forceinline__ XcdBarrier xcd_barrier_post(unsigned* bar, volatile LAS unsigned* st, bool first) {
    XcdBarrier b; b.bar = bar; b.x = xb_xcc_id(); b.st = st;
    if (first) (void)xb_add(&bar[XB_XCNT(b.x)], 1u);
    return b;
}
__device__ __forceinline__ void xcd_barrier_complete(unsigned* bar, unsigned x, unsigned& nloc, unsigned& nx) {
    const unsigned G = gridDim.x * gridDim.y * gridDim.z;
    unsigned sum, cnt, mine, sp = 0u;
    for (;;) {
        sum = 0u; cnt = 0u; mine = 0u;
#pragma unroll
        for (unsigned j = 0; j < 16; ++j) { const unsigned c = xb_ld(&bar[XB_XCNT(j)]); sum += c; cnt += (c > 0u) ? 1u : 0u; mine = (j == x) ? c : mine; }
        if (sum == G) break;
        __builtin_amdgcn_s_sleep(1);
        if ((++sp & 255u) == 0u) { if (xb_ld(&bar[XB_TMO])) break; if (sp > XB_SPIN_CAP) { atomicAdd(&bar[XB_TMO], 1u); break; } }
    }
    nloc = mine > 0u ? mine : 1u; nx = cnt > 0u ? cnt : 1u;
}

__device__ __forceinline__ void xcd_barrier(const XcdBarrier& b, const bool first) {
    asm volatile("s_waitcnt vmcnt(0)" ::: "memory");
    __syncthreads();
    if (first) {
        unsigned* bar = b.bar;
        __builtin_amdgcn_s_waitcnt(0);
        unsigned nloc = b.st[0], nx = b.st[1];
        if (nloc == 0u) { xcd_barrier_complete(bar, b.x, nloc, nx); b.st[0] = nloc; b.st[1] = nx; }
        const unsigned old = xb_add(&bar[XB_XSUB(b.x)], 1u);
        const unsigned gen = old / nloc;
        if (old + 1u == (gen + 1u) * nloc) {
            __builtin_amdgcn_fence(__ATOMIC_RELEASE, "agent");
            asm volatile("s_waitcnt vmcnt(0)" ::: "memory");
            const unsigned og = xb_add(&bar[XB_TOP], 1u);
            const unsigned tg = og / nx;
            if (og + 1u == (tg + 1u) * nx) xb_add(&bar[XB_TOPGEN], 1u);
            else XB_SPIN(xb_ld(&bar[XB_TOPGEN]) == tg, bar);
            __builtin_amdgcn_fence(__ATOMIC_ACQUIRE, "agent");
            xb_add(&bar[XB_XGEN(b.x)], 1u);
            asm volatile("s_waitcnt vmcnt(0)" ::: "memory");
        } else {
            XB_SPIN(xb_ld(&bar[XB_XGEN(b.x)]) == gen, bar);
            __builtin_amdgcn_fence(__ATOMIC_ACQUIRE, "agent");
            asm volatile("s_waitcnt vmcnt(0)" ::: "memory");
        }
    }
    __syncthreads();
}

#define CG_SYNC() do { asm volatile("s_waitcnt vmcnt(0) lgkmcnt(0)" ::: "memory"); __syncthreads(); grid.sync(); \
    __builtin_amdgcn_fence(__ATOMIC_ACQUIRE, "agent"); asm volatile("s_waitcnt vmcnt(0)" ::: "memory"); __syncthreads(); } while (0)
#define IS_T0 (wave_s == 0 && hw_lane() == 0)
#define GRID_SYNC() xcd_barrier(xbar, IS_T0)
constexpr int CW_BAR = 4096;
typedef const __attribute__((address_space(4))) Args* KArgsPtr;
#define PHASE_BEGIN Args a; { KArgsPtr ka_ = (KArgsPtr)__builtin_amdgcn_kernarg_segment_ptr(); asm volatile("" : "+s"(ka_)); _Pragma("unroll") for (int i_ = 0; i_ < 18; ++i_) a.in[i_] = ka_->in[i_]; a.out = ka_->out; a.ws = ka_->ws; } \
    const int lane = hw_lane(), wave = wave_s, tid = wave_s * 64 + lane; const int G = gridDim.x, gw = blockIdx.x * NWAVES + wave, ngw = G * NWAVES; \
    unsigned* ctl = (unsigned*)(a.ws + WS_CTL); const float* mod = (const float*)(a.ws + WS_MOD); bf16* WT = (bf16*)(a.ws + WS_WT); bf16* H = (bf16*)(a.ws + WS_H); bf16* HID = (bf16*)(a.ws + WS_HID); bf16* B0 = (bf16*)(a.ws + WS_B0); \
    (void)tid; (void)lane; (void)wave; (void)G; (void)gw; (void)ngw; (void)ctl; (void)mod; (void)WT; (void)H; (void)HID; (void)B0;
#define GEMM_RUN(EPI, ...) do { pg8::StaticOrder S; S.init(MROWS, g.N, G, (int)blockIdx.x, grev); EPI E{__VA_ARGS__}; pg8::gemm_phase<EPI, pg8::StaticOrder, true, true>(lds, g, S, E, wave_s); } while (0)

__global__ void __launch_bounds__(NTHR, 2) hybrid_fwd(Args args_unused) {
    extern __shared__ __attribute__((aligned(16))) unsigned char lds_raw[];
    LAS unsigned char* lds = (LAS unsigned char*)lds_raw;
    cg::grid_group grid = cg::this_grid();
    const int wave_s = __builtin_amdgcn_readfirstlane((int)threadIdx.x >> 6);
    LAS unsigned* qslot = (LAS unsigned*)(lds + 131072);

    {
        PHASE_BEGIN
        if (blockIdx.x == 0) { if (tid < 64) ctl[tid] = 0u; for (int i = tid; i < XCD_BAR_WORDS; i += NTHR) ctl[CW_BAR + i] = 0u; }
        ada_phase(a, lds, wave, lane);
        convert_weights(a, 0, lds, gw, ngw, wave, lane);
    }
    CG_SYNC();
    XcdBarrier xbar;
    {   PHASE_BEGIN
        volatile LAS unsigned* st = (volatile LAS unsigned*)(lds + 131072 + 16);
        if (tid < 2) st[tid] = 0u;
        __syncthreads();
        xbar = xcd_barrier_post(ctl + CW_BAR, st, tid == 0);
    }

    int grev = 0;
    for (int l = 0; l < DEPTH; ++l) {
        const int d = (l & 1) ^ 1;
        {
            PHASE_BEGIN
            if (l > 0) convert_weights(a, l, lds, gw, ngw, wave, lane);
            norm_phase(a, (l == 0) ? a.in[0] : a.out, l, 0, gw, ngw, lane, d);
        }
        GRID_SYNC();
        grev = d ^ 1;
        { PHASE_BEGIN pg8::Gemm g{H, WT + W_UPA, MROWS, 2 * DFF, DM}; GEMM_RUN(pg8::EpiSwiGLU, HID, DFF); }
        GRID_SYNC();
        grev = d;
        { PHASE_BEGIN pg8::Gemm g{HID, WT + W_DNA, MROWS, DM, DFF}; GEMM_RUN(pg8::EpiResid, (l == 0) ? a.in[0] : a.out, a.out, mod + (size_t)l * NB * NMOD + 0 * 3 * DM + 2 * DM, NMOD, 0.5f, DM); }
        GRID_SYNC();
        { PHASE_BEGIN norm_phase(a, a.out, l, 1, gw, ngw, lane, d ^ 1); }
        GRID_SYNC();
        grev = d;
        { PHASE_BEGIN pg8::Gemm g{H, WT + W_IN, MROWS, 6 * DM, DM}; GEMM_RUN(pg8::EpiBf<0>, B0, DM, DM, (size_t)MROWS * DM, 3, 0.125f * LOG2E, nullptr); }
        GRID_SYNC();
        {
            PHASE_BEGIN
            if (blockIdx.x < 32) retention_unit(a, l, blockIdx.x & 7, blockIdx.x >> 3, lds, wave_s);
            const float s1 = wave_sum(a.in[9][l * 64 + lane] * a.in[10][l * 64 + lane], lane), s2 = wave_sum(a.in[11][l * 64 + lane] * a.in[12][l * 64 + lane], lane);
            const float lam_init = sgpr_f(0.8f - 0.6f * expf(-0.3f * (float)l)), lam = sgpr_f(expf(s1) - expf(s2) + lam_init);
            const int q0 = (int)(xb_xcc_id() & 7u);
            for (int k = 0; k < NB; ++k) {
                const int bq = (q0 + k) & 7;
                for (;;) {
                    if (tid == 0) *qslot = atomicAdd(ctl + l * NB + bq, 1u);
                    __syncthreads();
                    const unsigned item = *qslot;
                    __syncthreads();
                    if (item >= 8u * 64u) break;
                    attn_unit(a, l, bq, 7 - (int)(item >> 6), 63 - (int)(item & 63u), lam, 1.0f - lam_init, lds, wave_s);
                }
            }
        }
        GRID_SYNC();
        grev = d;
        {
            PHASE_BEGIN pg8::Gemm g{H, WT + W_IN + (size_t)6 * DM * DM, MROWS, DM, DM, H, WT + W_IN + (size_t)7 * DM * DM, B0 + (size_t)2 * MROWS * DM, WT + W_RET, B0 + (size_t)3 * MROWS * DM, WT + W_DIF};
            pg8::SegOrderN<2> S; S.init(MROWS, g.N, G, (int)blockIdx.x, grev); pg8::EpiMerge E{B0 + (size_t)1 * MROWS * DM, DM, B0, B0 + (size_t)4 * MROWS * DM};
            pg8::gemm_phase<pg8::EpiMerge, pg8::SegOrderN<2>, true, true>(lds, g, S, E, wave_s); }
        GRID_SYNC();
        grev = d ^ 1;
        { PHASE_BEGIN pg8::Gemm g{B0 + (size_t)1 * MROWS * DM, WT + W_OUT, MROWS, DM, DM}; GEMM_RUN(pg8::EpiResid, a.out, a.out, mod + (size_t)l * NB * NMOD + 1 * 3 * DM + 2 * DM, NMOD, 1.0f, DM); }
        GRID_SYNC();
        { PHASE_BEGIN norm_phase(a, a.out, l, 2, gw, ngw, lane, d); }
        GRID_SYNC();
        grev = d ^ 1;
        { PHASE_BEGIN pg8::Gemm g{H, WT + W_UPB, MROWS, 2 * DFF, DM}; GEMM_RUN(pg8::EpiSwiGLU, HID, DFF); }
        GRID_SYNC();
        grev = d;
        { PHASE_BEGIN pg8::Gemm g{HID, WT + W_DNB, MROWS, DM, DFF}; GEMM_RUN(pg8::EpiResid, a.out, a.out, mod + (size_t)l * NB * NMOD + 2 * 3 * DM + 2 * DM, NMOD, 0.5f, DM); }
        GRID_SYNC();
    }
    { PHASE_BEGIN final_norm_phase(a, gw, ngw, lane); }
}

constexpr int LDS_BYTES = 147456;
extern "C" void kernel_launch(void* const* d_in, const int* in_sizes, int n_in, void* d_out, int out_size, void* d_ws, size_t ws_size, hipStream_t stream) {
    static int grid = 0;
    if (grid == 0) {
        if (n_in != 18 || ws_size < WS_END) { fprintf(stderr, "kernel_launch: unexpected n_in %d / ws_size %zu (need %zu)\n", n_in, ws_size, (size_t)WS_END); grid = -1; return; }
        int dev = 0, cus = 0, per_cu = 0;
        (void)hipGetDevice(&dev); (void)hipDeviceGetAttribute(&cus, hipDeviceAttributeMultiprocessorCount, dev);
        if (hipFuncSetAttribute((const void*)hybrid_fwd, hipFuncAttributeMaxDynamicSharedMemorySize, LDS_BYTES) != hipSuccess) { fprintf(stderr, "kernel_launch: hipFuncSetAttribute failed\n"); grid = -1; return; }
        if (hipOccupancyMaxActiveBlocksPerMultiprocessor(&per_cu, (const void*)hybrid_fwd, NTHR, LDS_BYTES) != hipSuccess || per_cu < 1) { fprintf(stderr, "kernel_launch: occupancy query says %d\n", per_cu); per_cu = 1; }
        (void)hipGetLastError();
        grid = cus * 1;
    }
    if (grid < 0) return;
    Args a{};
    for (int i = 0; i < 18; ++i) a.in[i] = (const float*)d_in[i];
    a.out = (float*)d_out; a.ws = (unsigned char*)d_ws;
    void* kargs[] = {&a};
    hipError_t e = hipLaunchCooperativeKernel((const void*)hybrid_fwd, dim3(grid), dim3(NTHR), kargs, LDS_BYTES, stream);
    if (e != hipSuccess) fprintf(stderr, "cooperative launch failed: %s (grid %d)\n", hipGetErrorString(e), grid);
}
```
